# Optimizing an MI355X kernel written in HIP

```python
import math
import jax, jax.numpy as jnp
from jax import lax
import numpy as np

D_MODEL = 1024
BATCH = 8
SEQ = 2048
DEPTH = 1

HEAD_DIM = 64
N_HEADS_MOBA = D_MODEL // HEAD_DIM // 2
N_HEADS_SWA = D_MODEL // HEAD_DIM // 2
N_KV_SWA = 2
N_HEADS = N_HEADS_MOBA + N_HEADS_SWA
D_MOBA = N_HEADS_MOBA * HEAD_DIM
D_SWA_Q = N_HEADS_SWA * HEAD_DIM
D_SWA_KV = N_KV_SWA * HEAD_DIM
D_MIX = D_MOBA + D_SWA_Q
D_IN = 3 * D_MOBA + D_SWA_Q + 2 * D_SWA_KV
MOBA_BLOCK = 256
MOBA_TOPK = 3
MOBA_QCHUNK = 32
SWA_WINDOW = 128
SWA_BLOCK = 128
REL_BUCKETS = 32
REL_MAX_DIST = 1024
N_EXPERTS = 32
TOP_K = 4
D_FF = 1024
SWIGLU_LIMIT = 7.0
SWIGLU_ALPHA = 1.702
EPS = 1e-5
NEG = -1e30

kernel_name = "hymba_moba_swa_sink_moe_adaln"


def rmsnorm(x, g):
    xf = x.astype(jnp.float32)
    y = xf * lax.rsqrt(jnp.mean(xf * xf, axis=-1, keepdims=True) + EPS)
    return (y * g.astype(jnp.float32)).astype(x.dtype)


def rel_bucket(dist):
    max_exact = REL_BUCKETS // 2
    n = jnp.maximum(dist, 0)
    nf = jnp.maximum(n, 1).astype(jnp.float32)
    large = max_exact + (jnp.log(nf / max_exact) / math.log(REL_MAX_DIST / max_exact)
                         * (REL_BUCKETS - max_exact)).astype(jnp.int32)
    large = jnp.minimum(large, REL_BUCKETS - 1)
    return jnp.where(n < max_exact, n, large)


def moba_attention(q, k, v, rel_table):
    B, S, H, Dh = q.shape
    L = MOBA_BLOCK
    Sp = -(-S // L) * L
    pad = Sp - S
    if pad:
        q, k, v = [jnp.pad(a, ((0, 0), (0, pad), (0, 0), (0, 0))) for a in (q, k, v)]
    nb = Sp // L
    kbh = k.reshape(B, nb, L, H, Dh).transpose(0, 3, 1, 2, 4)
    vbh = v.reshape(B, nb, L, H, Dh).transpose(0, 3, 1, 2, 4)
    kmean = jnp.mean(kbh.astype(jnp.float32), axis=3)
    gate = jnp.einsum('bshd,bhnd->bhsn', q.astype(jnp.float32), kmean)
    qblk = jnp.arange(Sp) // L
    past = jnp.arange(nb)[None, :] < qblk[:, None]
    gate = jnp.where(past, gate, NEG)
    kk = min(MOBA_TOPK, nb)
    _, sel = lax.top_k(gate, kk)
    QC = MOBA_QCHUNK
    nc = Sp // QC
    q_all = q.reshape(B, nc, QC, H, Dh).transpose(1, 0, 2, 3, 4)
    sel_all = sel.reshape(B, H, nc, QC, kk).transpose(2, 0, 1, 3, 4)
    table_h = rel_table.T
    b_ix = jnp.arange(B)[:, None, None, None]
    h_ix = jnp.arange(H)[None, :, None, None]
    offs = jnp.arange(L)
    scale = Dh ** -0.5

    def chunk(args):
        qc, selc, ci = args
        start = ci * QC
        qpos = start + jnp.arange(QC)
        own = start // L
        kg = kbh[b_ix, h_ix, selc]
        vg = vbh[b_ix, h_ix, selc]
        s_past = jnp.einsum('bqhd,bhqjld->bhqjl', qc, kg,
                            preferred_element_type=jnp.float32) * scale
        kpos = selc[..., None] * L + offs
        s_past = s_past + table_h[h_ix[..., None], rel_bucket(qpos[:, None, None] - kpos)].astype(jnp.float32)
        valid = jnp.arange(kk) < own
        s_past = jnp.where(valid[:, None], s_past, NEG)
        kown = lax.dynamic_index_in_dim(kbh, own, axis=2, keepdims=False)
        vown = lax.dynamic_index_in_dim(vbh, own, axis=2, keepdims=False)
        s_own = jnp.einsum('bqhd,bhld->bhql', qc, kown,
                           preferred_element_type=jnp.float32) * scale
        dist_own = qpos[:, None] - (own * L + offs)[None, :]
        s_own = jnp.where(dist_own >= 0,
                          s_own + table_h[:, rel_bucket(dist_own)][None].astype(jnp.float32), NEG)
        logits = jnp.concatenate([s_past.reshape(B, H, QC, kk * L), s_own], axis=-1)
        p = jax.nn.softmax(logits, axis=-1)
        p_past = p[..., :kk * L].reshape(B, H, QC, kk, L).astype(v.dtype)
        p_own = p[..., kk * L:].astype(v.dtype)
        return (jnp.einsum('bhqjl,bhqjld->bqhd', p_past, vg)
                + jnp.einsum('bhql,bhld->bqhd', p_own, vown))

    out = lax.map(chunk, (q_all, sel_all, jnp.arange(nc)))
    return out.transpose(1, 0, 2, 3, 4).reshape(B, Sp, H, Dh)[:, :S]


def swa_attention(q, k, v, sinks, rel_table):
    B, S, Hq, Dh = q.shape
    Hkv = k.shape[2]
    G = Hq // Hkv
    W = SWA_BLOCK
    nq = S // W
    qb = q.reshape(B, nq, W, Hkv, G, Dh)

    def band(a):
        prev = jnp.pad(a, ((0, 0), (W, 0), (0, 0), (0, 0)))[:, :S]
        return jnp.concatenate([prev.reshape(B, nq, W, Hkv, Dh),
                                a.reshape(B, nq, W, Hkv, Dh)], axis=2)

    kw, vw = band(k), band(v)
    s = jnp.einsum('bnqhgd,bnkhd->bnhgqk', qb, kw,
                   preferred_element_type=jnp.float32) * Dh ** -0.5
    qi = jnp.arange(W)
    ki = jnp.arange(2 * W)
    dist = qi[:, None] + W - ki[None, :]
    kpos = jnp.arange(nq)[:, None] * W - W + ki[None, :]
    allowed = (dist >= 0) & (dist < SWA_WINDOW) & (kpos[:, None, :] >= 0)
    bias = rel_table[rel_bucket(dist)].astype(jnp.float32).transpose(2, 0, 1).reshape(Hkv, G, W, 2 * W)
    s = jnp.where(allowed[None, :, None, None], s + bias, NEG)
    sink = jnp.broadcast_to(sinks.astype(jnp.float32).reshape(Hkv, G, 1, 1), s.shape[:-1] + (1,))
    p = jax.nn.softmax(jnp.concatenate([s, sink], axis=-1), axis=-1)[..., :-1].astype(v.dtype)
    o = jnp.einsum('bnhgqk,bnkhd->bnqhgd', p, vw)
    return o.reshape(B, S, Hq, Dh)


def moe_ffn(h, w_router, b_router, w_gate_up, b_gate_up, w_down, b_down):
    B, S, D = h.shape
    t = h.reshape(B * S, D)
    logits = (t @ w_router + b_router).astype(jnp.float32)
    top_val, top_idx = lax.top_k(logits, TOP_K)
    top_w = jax.nn.softmax(top_val, axis=-1)
    combine = jnp.sum(jax.nn.one_hot(top_idx, N_EXPERTS, dtype=jnp.float32) * top_w[..., None], axis=1)
    out = jnp.zeros((B * S, D), jnp.float32)
    for e in range(N_EXPERTS):
        gu = t @ w_gate_up[e] + b_gate_up[e]
        g = jnp.minimum(gu[:, :D_FF], SWIGLU_LIMIT)
        u = jnp.clip(gu[:, D_FF:], -SWIGLU_LIMIT, SWIGLU_LIMIT)
        y = ((u + 1) * (g * jax.nn.sigmoid(SWIGLU_ALPHA * g))) @ w_down[e] + b_down[e]
        out = out + combine[:, e:e + 1] * y
    return out.astype(h.dtype).reshape(B, S, D)


def setup_inputs(seed: int = 0) -> dict:
    key = jax.random.key(seed)
    ks = jax.random.split(key, 20)
    f32 = jnp.float32

    def nrm(k, shape, s):
        return jax.random.normal(k, shape, f32) * s

    return {
        "x": nrm(ks[0], (BATCH, SEQ, D_MODEL), 1.0),
        "c": nrm(ks[1], (BATCH, D_MODEL), 1.0),
        "g_attn": 1.0 + nrm(ks[2], (DEPTH, D_MODEL), 0.02),
        "w_ada": nrm(ks[3], (DEPTH, D_MODEL, 6 * D_MODEL), 0.5 * D_MODEL ** -0.5),
        "b_ada": nrm(ks[4], (DEPTH, 6 * D_MODEL), 0.02),
        "w_in": nrm(ks[5], (DEPTH, D_MODEL, D_IN), D_MODEL ** -0.5),
        "b_in": nrm(ks[6], (DEPTH, D_IN), 0.02),
        "w_out": nrm(ks[7], (DEPTH, D_MIX, D_MODEL), D_MIX ** -0.5),
        "b_out": nrm(ks[8], (DEPTH, D_MODEL), 0.02),
        "rel_table": nrm(ks[9], (REL_BUCKETS, N_HEADS), 0.5),
        "sinks": nrm(ks[10], (DEPTH, N_HEADS_SWA), 1.0),
        "g_ffn": 1.0 + nrm(ks[11], (DEPTH, D_MODEL), 0.02),
        "w_router": nrm(ks[12], (DEPTH, D_MODEL, N_EXPERTS), D_MODEL ** -0.5),
        "b_router": nrm(ks[13], (DEPTH, N_EXPERTS), 0.01),
        "w_gate_up": nrm(ks[14], (DEPTH, N_EXPERTS, D_MODEL, 2 * D_FF), D_MODEL ** -0.5),
        "b_gate_up": nrm(ks[15], (DEPTH, N_EXPERTS, 2 * D_FF), 0.02),
        "w_down": nrm(ks[16], (DEPTH, N_EXPERTS, D_FF, D_MODEL), D_FF ** -0.5),
        "b_down": nrm(ks[17], (DEPTH, N_EXPERTS, D_MODEL), 0.02),
        "g_final": 1.0 + nrm(ks[18], (D_MODEL,), 0.02),
    }


def reference(x, c, g_attn, w_ada, b_ada, w_in, b_in, w_out, b_out, rel_table, sinks,
              g_ffn, w_router, b_router, w_gate_up, b_gate_up, w_down, b_down, g_final):
    B, S, D = x.shape
    sc = jax.nn.silu(c)
    for l in range(DEPTH):
        mod = sc @ w_ada[l] + b_ada[l]
        shift_a, scale_a, gate_a, shift_f, scale_f, gate_f = [m[:, None, :] for m in jnp.split(mod, 6, axis=-1)]

        h = rmsnorm(x, g_attn[l]) * (1 + scale_a) + shift_a
        proj = h @ w_in[l] + b_in[l]
        i0 = D_MOBA
        i1 = 2 * D_MOBA
        i2 = 3 * D_MOBA
        i3 = i2 + D_SWA_Q
        i4 = i3 + D_SWA_KV
        q_m = proj[..., :i0].reshape(B, S, N_HEADS_MOBA, HEAD_DIM)
        k_m = proj[..., i0:i1].reshape(B, S, N_HEADS_MOBA, HEAD_DIM)
        v_m = proj[..., i1:i2].reshape(B, S, N_HEADS_MOBA, HEAD_DIM)
        q_s = proj[..., i2:i3].reshape(B, S, N_HEADS_SWA, HEAD_DIM)
        k_s = proj[..., i3:i4].reshape(B, S, N_KV_SWA, HEAD_DIM)
        v_s = proj[..., i4:].reshape(B, S, N_KV_SWA, HEAD_DIM)
        o_m = moba_attention(q_m, k_m, v_m, rel_table[:, :N_HEADS_MOBA])
        o_s = swa_attention(q_s, k_s, v_s, sinks[l], rel_table[:, N_HEADS_MOBA:])
        o = jnp.concatenate([o_m.reshape(B, S, D_MOBA), o_s.reshape(B, S, D_SWA_Q)], axis=-1)
        x = x + gate_a * (o @ w_out[l] + b_out[l])

        h = rmsnorm(x, g_ffn[l]) * (1 + scale_f) + shift_f
        x = x + gate_f * moe_ffn(h, w_router[l], b_router[l], w_gate_up[l], b_gate_up[l],
                                 w_down[l], b_down[l])
    return rmsnorm(x, g_final)
```

```cpp
#include <hip/hip_runtime.h>
#include <hip/hip_bf16.h>
#include <cstdio>
#include <cstdint>
#include <cmath>

constexpr int D = 1024, BATCH = 8, SEQ = 2048, NTOK = BATCH * SEQ;
constexpr int HD = 64, NH_M = 8, NH_S = 8, NKV_S = 2;
constexpr int D_MOBA = 512, D_SWA_Q = 512, D_SWA_KV = 128, D_IN = 2304;
constexpr int MB_L = 256, MB_NB = SEQ / MB_L, MB_TOPK = 3;
constexpr int SWA_W = 128;
constexpr int NE = 32, TOPK = 4, DFF = 1024;
constexpr float EPS = 1e-5f, NEGF = -1e30f;
constexpr int MAXTILES = 288;
constexpr int MAXSLOTS = MAXTILES * 256;
constexpr float LOG2E = 1.4426950408889634f;
constexpr float QSCALE = 0.125f * LOG2E;

namespace pg8 {
#define PG8_LAS __attribute__((address_space(3)))
typedef unsigned short bf16_t;
typedef short bf16x8 __attribute__((ext_vector_type(8)));
typedef float f32x4 __attribute__((ext_vector_type(4)));
typedef unsigned u32x4 __attribute__((ext_vector_type(4)));
constexpr int BM = 256, BK = 64, HALF = 128, HTB = HALF * BK * 2  , STAGE_BYTES = 8 * HTB, NXCD = 8, WGM = 8;

__host__ __device__ __forceinline__ int lds_byte(int r, int c) { const int st = (r >> 4) * 2 + (c >> 5), rr = r & 15, cc = c & 31, ob = rr * 64 + cc * 2; return st * 1024 + (ob ^ (((ob >> 9) & 1) << 5)); }
__host__ __device__ __forceinline__ void stage_rc(int b, int& R, int& C) { const int st = b / 1024, sb = b % 1024, swz = sb ^ (((sb >> 9) & 1) << 5); R = (st >> 1) * 16 + swz / 64; C = (st & 1) * 32 + (swz % 64) / 2; }
__host__ __device__ __forceinline__ int perm32(int rho) { const int n = rho >> 4, i = rho & 15; return 8 * (i >> 2) + 4 * n + (i & 3); }

struct Unit { int pm, pn, e; };
struct Gemm { const bf16_t* A; const bf16_t* Bt; int M, N, K; };

struct StaticOrder {
    int nM, nN, nwg, G, c;
    __host__ __device__ void init(int M, int N, int G_, int c_) { nM = M / BM; nN = N / BM; nwg = nM * nN; G = G_; c = c_; }
    __host__ __device__ bool next(int i, Unit& u) const {
        const long L = (long)i * G + c; if (L >= nwg) return false;
        int wgid = (int)L; { const int q = nwg / NXCD, r = nwg % NXCD, xcd = wgid % NXCD, off = wgid / NXCD; wgid = (xcd < r ? xcd * (q + 1) : r * (q + 1) + (xcd - r) * q) + off; }
        const int nig = WGM * nN, gid = wgid / nig, fm = gid * WGM, gsz = (nM - fm) < WGM ? (nM - fm) : WGM;
        u.pm = fm + ((wgid % nig) % gsz); u.pn = (wgid % nig) / gsz; u.e = 0; return true;
    }
    __device__ __forceinline__ int arow(int, const Unit& u, int r) const { return u.pm * BM + r; }
    __device__ __forceinline__ size_t bbase(const Unit& u, size_t tstep) const { return (size_t)u.pn * tstep; }
    __device__ __forceinline__ void a_ready(const Unit&) const {}
    __device__ __forceinline__ void done(const Unit&) const {}
};
struct GroupedOrder {
    int nN, G, c, ntiles; const PG8_LAS int* tile_e; const PG8_LAS int* ridx; size_t bstride;
    __device__ __forceinline__ bool next(int i, Unit& u) const {
        const int L = i * G + c, t = L / nN; if (t >= ntiles) return false;
        u.pm = t; u.pn = L - t * nN; u.e = __builtin_amdgcn_readfirstlane(tile_e[t]); return true;
    }
    __device__ __forceinline__ int arow(int ui, const Unit& u, int r) const { return ridx ? ridx[ui * BM + r] : u.pm * BM + r; }
    __device__ __forceinline__ size_t bbase(const Unit& u, size_t tstep) const { return (size_t)u.e * bstride + (size_t)u.pn * tstep; }
    __device__ __forceinline__ void a_ready(const Unit&) const {}
    __device__ __forceinline__ void done(const Unit&) const {}
};

__device__ __forceinline__ unsigned cvt_pk_bf16(float lo, float hi) { unsigned r; asm volatile("v_cvt_pk_bf16_f32 %0, %1, %2" : "=v"(r) : "v"(lo), "v"(hi)); return r; }

struct EpiProj {
    static constexpr bool PERM = true, AFTER_DRAIN = false;
    bf16_t* O; const float* bias; float* ksum;
    __device__ __forceinline__ void operator()(const f32x4 (&acc)[2][2][4][2], const Unit& u, int wr, int wc, int fr, int fq) const {
        const int row0 = u.pm * BM + wr * 64 + fr, col0 = u.pn * BM + wc * 32 + 8 * fq;
        const float sc = (u.pn < 2 || u.pn == 6 || u.pn == 7) ? QSCALE : 1.0f;
        f32x4 bv[2][2];
#pragma unroll
        for (int bj = 0; bj < 2; ++bj)
#pragma unroll
            for (int n = 0; n < 2; ++n) bv[bj][n] = *(const f32x4*)(bias + col0 + bj * HALF + 4 * n);
#pragma unroll
        for (int ai = 0; ai < 2; ++ai)
#pragma unroll
            for (int m = 0; m < 4; ++m) { bf16_t* rowp = O + (size_t)(row0 + ai * HALF + m * 16) * D_IN + col0;
#pragma unroll
                for (int bj = 0; bj < 2; ++bj) { f32x4 v0 = (acc[ai][bj][m][0] + bv[bj][0]) * sc, v1 = (acc[ai][bj][m][1] + bv[bj][1]) * sc;
                    u32x4 w; w.x = cvt_pk_bf16(v0[0], v0[1]); w.y = cvt_pk_bf16(v0[2], v0[3]); w.z = cvt_pk_bf16(v1[0], v1[1]); w.w = cvt_pk_bf16(v1[2], v1[3]);
                    *(u32x4*)(rowp + bj * HALF) = w; } }
        if (u.pn == 2 || u.pn == 3) {
#pragma unroll
            for (int bj = 0; bj < 2; ++bj)
#pragma unroll
                for (int n = 0; n < 2; ++n) {
                    f32x4 s = bv[bj][n] * 8.0f;
#pragma unroll
                    for (int ai = 0; ai < 2; ++ai)
#pragma unroll
                        for (int m = 0; m < 4; ++m) s += acc[ai][bj][m][n];
#pragma unroll
                    for (int j = 0; j < 4; ++j) { float t = s[j]; t += __shfl_xor(t, 1); t += __shfl_xor(t, 2); t += __shfl_xor(t, 4); t += __shfl_xor(t, 8);
                        if (fr == 0) atomicAdd(ksum + (size_t)u.pm * D_MOBA + (u.pn - 2) * BM + bj * HALF + wc * 32 + 8 * fq + 4 * n + j, t); }
                }
        }
    }
};
struct EpiX1 {
    static constexpr bool PERM = false, AFTER_DRAIN = false;
    const float* x; float* x1; const float* bias; const float* modf;
    __device__ __forceinline__ void operator()(const f32x4 (&acc)[2][2][4][2], const Unit& u, int wr, int wc, int fr, int fq) const {
        const int row0 = u.pm * BM + wr * 64 + fr, col0 = u.pn * BM + wc * 32 + 4 * fq;
        const float* ga = modf + (size_t)(u.pm >> 3) * 6 * D + 2 * D;
        f32x4 bv[2][2], gv[2][2];
#pragma unroll
        for (int bj = 0; bj < 2; ++bj)
#pragma unroll
            for (int n = 0; n < 2; ++n) { bv[bj][n] = *(const f32x4*)(bias + col0 + bj * HALF + n * 16); gv[bj][n] = *(const f32x4*)(ga + col0 + bj * HALF + n * 16); }
#pragma unroll
        for (int ai = 0; ai < 2; ++ai)
#pragma unroll
            for (int m = 0; m < 4; ++m) { const size_t off = (size_t)(row0 + ai * HALF + m * 16) * D + col0;
#pragma unroll
                for (int bj = 0; bj < 2; ++bj)
#pragma unroll
                    for (int n = 0; n < 2; ++n) { const f32x4 xr = *(const f32x4*)(x + off + bj * HALF + n * 16);
                        *(f32x4*)(x1 + off + bj * HALF + n * 16) = xr + gv[bj][n] * (acc[ai][bj][m][n] + bv[bj][n]); }
                if (m & 1) asm volatile("" ::: "memory"); }
    }
};
struct EpiSwiglu {
    static constexpr bool PERM = true, AFTER_DRAIN = false;
    bf16_t* act; const float* bias;
    __device__ __forceinline__ void operator()(const f32x4 (&acc)[2][2][4][2], const Unit& u, int wr, int wc, int fr, int fq) const {
        const int row0 = u.pm * BM + wr * 64 + fr, ff0 = u.pn * HALF + wc * 32 + 8 * fq;
        const float* bg = bias + (size_t)u.e * 2 * DFF + ff0;
        f32x4 bgv[2], buv[2];
#pragma unroll
        for (int n = 0; n < 2; ++n) { bgv[n] = *(const f32x4*)(bg + 4 * n); buv[n] = *(const f32x4*)(bg + DFF + 4 * n); }
#pragma unroll
        for (int ai = 0; ai < 2; ++ai)
#pragma unroll
            for (int m = 0; m < 4; ++m) {
                f32x4 o[2];
#pragma unroll
                for (int n = 0; n < 2; ++n) { const f32x4 gq = acc[ai][0][m][n] + bgv[n], uq = acc[ai][1][m][n] + buv[n];
#pragma unroll
                    for (int j = 0; j < 4; ++j) { const float g = fminf(gq[j], 7.0f), uu = fminf(fmaxf(uq[j], -7.0f), 7.0f);
                        const float sg = __builtin_amdgcn_rcpf(1.0f + __builtin_amdgcn_exp2f(-1.702f * LOG2E * g)); o[n][j] = (uu + 1.0f) * (g * sg); } }
                u32x4 w; w.x = cvt_pk_bf16(o[0][0], o[0][1]); w.y = cvt_pk_bf16(o[0][2], o[0][3]); w.z = cvt_pk_bf16(o[1][0], o[1][1]); w.w = cvt_pk_bf16(o[1][2], o[1][3]);
                *(u32x4*)(act + (size_t)(row0 + ai * HALF + m * 16) * DFF + ff0) = w; }
    }
};
struct EpiDown {
    static constexpr bool PERM = true, AFTER_DRAIN = false;
    bf16_t* y; const float* bias;
    __device__ __forceinline__ void operator()(const f32x4 (&acc)[2][2][4][2], const Unit& u, int wr, int wc, int fr, int fq) const {
        const int row0 = u.pm * BM + wr * 64 + fr, col0 = u.pn * BM + wc * 32 + 8 * fq;
        const float* bb = bias + (size_t)u.e * D + col0;
        f32x4 bv[2][2];
#pragma unroll
        for (int bj = 0; bj < 2; ++bj)
#pragma unroll
            for (int n = 0; n < 2; ++n) bv[bj][n] = *(const f32x4*)(bb + bj * HALF + 4 * n);
#pragma unroll
        for (int ai = 0; ai < 2; ++ai)
#pragma unroll
            for (int m = 0; m < 4; ++m) { bf16_t* rowp = y + (size_t)(row0 + ai * HALF + m * 16) * D + col0;
#pragma unroll
                for (int bj = 0; bj < 2; ++bj) { const f32x4 v0 = acc[ai][bj][m][0] + bv[bj][0], v1 = acc[ai][bj][m][1] + bv[bj][1];
                    u32x4 w; w.x = cvt_pk_bf16(v0[0], v0[1]); w.y = cvt_pk_bf16(v0[2], v0[3]); w.z = cvt_pk_bf16(v1[0], v1[1]); w.w = cvt_pk_bf16(v1[2], v1[3]);
                    *(u32x4*)(rowp + bj * HALF) = w; } }
    }
};

template <class Epi, class Sched, bool ALIGN_EPI = false, bool SP2 = false>
__device__ __forceinline__ void gemm_phase(PG8_LAS unsigned char* lds, const Gemm g, const Sched& S, const Epi& E) {
    const int tid = threadIdx.x, wid = __builtin_amdgcn_readfirstlane(tid >> 6), lane = tid & 63, wr = wid >> 2, wc = wid & 3, fr = lane & 15, fq = lane >> 4;
    const int K = g.K, nt = K / BK;
    unsigned voffB[2]; int RA[2], CA[2];
#pragma unroll
    for (int i = 0; i < 2; ++i) { int R, C; stage_rc(tid * 16 + i * 8192, R, C); const int Rb = Epi::PERM ? ((R & ~31) + perm32(R & 31)) : R;
        RA[i] = R; CA[i] = C; voffB[i] = (unsigned)(Rb * K + C) * 2u; }
#define PG8_AOFF(dst, ui_, u_) do { _Pragma("unroll") for (int _h = 0; _h < 2; ++_h) _Pragma("unroll") for (int _i = 0; _i < 2; ++_i) \
        dst[_h][_i] = ((unsigned)S.arow(ui_, u_, _h * HALF + RA[_i]) * (unsigned)K + (unsigned)CA[_i]) * 2u; } while (0)
    const size_t kstep = (size_t)(BK * 2);
    const size_t hstep = (size_t)HALF * K * 2;
    const size_t tstep = 2 * hstep;
    const unsigned ldsw = (unsigned)wid * 1024u;
    const int aoff = lds_byte(wr * 64 + fr, fq * 8), boff = lds_byte(wc * 32 + fr, fq * 8);
#define PG8_SA(b, h) (((b) * 2 + (h)) * HTB)
#define PG8_SB(b, h) ((4 + (b) * 2 + (h)) * HTB)
#define PG8_STAGE(bufoff, gbase, voff) do { _Pragma("unroll") for (int _i = 0; _i < 2; ++_i) \
        __builtin_amdgcn_global_load_lds((const unsigned*)((const char*)(gbase) + (voff)[_i]), (PG8_LAS unsigned*)(lds + (bufoff) + ldsw + _i * 8192), 16, 0, 0); } while (0)
#define PG8_LDA(dst, b, h) do { _Pragma("unroll") for (int m = 0; m < 4; ++m) _Pragma("unroll") for (int k = 0; k < 2; ++k) dst[m][k] = *(const PG8_LAS bf16x8*)(lds + PG8_SA(b, h) + aoff + m * 2048 + k * 1024); } while (0)
#define PG8_LDB(dst, b, h) do { _Pragma("unroll") for (int n = 0; n < 2; ++n) _Pragma("unroll") for (int k = 0; k < 2; ++k) dst[n][k] = *(const PG8_LAS bf16x8*)(lds + PG8_SB(b, h) + boff + n * 2048 + k * 1024); } while (0)
#define PG8_MMA(ai, bj, At, Bt) do { __builtin_amdgcn_s_setprio(1); _Pragma("unroll") for (int m = 0; m < 4; ++m) _Pragma("unroll") for (int n = 0; n < 2; ++n) _Pragma("unroll") for (int k = 0; k < 2; ++k) \
        acc[ai][bj][m][n] = __builtin_amdgcn_mfma_f32_16x16x32_bf16(Bt[n][k], At[m][k], acc[ai][bj][m][n], 0, 0, 0); __builtin_amdgcn_s_setprio(0); } while (0)
#define PG8_WAIT_V(n) asm volatile("s_waitcnt vmcnt(" #n ")" ::: "memory")
#define PG8_WAIT_L(n) asm volatile("s_waitcnt lgkmcnt(" #n ")" ::: "memory")
#define PG8_BAR __builtin_amdgcn_s_barrier()
#define PG8_SCHED __builtin_amdgcn_sched_barrier(0)
    Unit cur, nxt; int ui = 0;
    if (!S.next(0, cur)) return;
    f32x4 acc[2][2][4][2];
#pragma unroll
    for (int a = 0; a < 2; ++a)
#pragma unroll
        for (int b = 0; b < 2; ++b)
#pragma unroll
            for (int m = 0; m < 4; ++m)
#pragma unroll
                for (int n = 0; n < 2; ++n) acc[a][b][m][n] = (f32x4){0.f, 0.f, 0.f, 0.f};
    bf16x8 At[4][2], B0[2][2], B1[2][2];
    const char* const A0 = (const char*)g.A; const char* cB = (const char*)g.Bt + S.bbase(cur, tstep);
    unsigned vA[2][2], vN[2][2]; PG8_AOFF(vA, 0, cur);
    S.a_ready(cur);
    if constexpr (SP2) {
        PG8_STAGE(PG8_SB(0, 0), cB, voffB); PG8_STAGE(PG8_SB(0, 1), cB + hstep, voffB); PG8_STAGE(PG8_SA(0, 0), A0, vA[0]); PG8_STAGE(PG8_SA(0, 1), A0, vA[1]);
        if (wr == 1) PG8_BAR;
        PG8_WAIT_V(2); PG8_BAR;
        PG8_STAGE(PG8_SB(1, 0), cB + kstep, voffB); PG8_STAGE(PG8_SA(1, 0), A0 + kstep, vA[0]); PG8_STAGE(PG8_SB(1, 1), cB + hstep + kstep, voffB);
        PG8_WAIT_V(6); PG8_BAR;
    } else {
        PG8_STAGE(PG8_SB(0, 0), cB, voffB); PG8_STAGE(PG8_SA(0, 0), A0, vA[0]); PG8_STAGE(PG8_SB(0, 1), cB + hstep, voffB); PG8_STAGE(PG8_SA(0, 1), A0, vA[1]);
        if (wr == 1) PG8_BAR;
        PG8_WAIT_V(4); PG8_BAR;
        PG8_STAGE(PG8_SB(1, 0), cB + kstep, voffB); PG8_STAGE(PG8_SA(1, 0), A0 + kstep, vA[0]); PG8_STAGE(PG8_SB(1, 1), cB + hstep + kstep, voffB);
        PG8_WAIT_V(6); PG8_BAR;
    }
    for (;;) {
        const bool has_next = S.next(ui + 1, nxt);
        const char* nB = has_next ? (const char*)g.Bt + S.bbase(nxt, tstep) : cB;
        if (has_next) { PG8_AOFF(vN, ui + 1, nxt); } else { vN[0][0] = vA[0][0]; vN[0][1] = vA[0][1]; vN[1][0] = vA[1][0]; vN[1][1] = vA[1][1]; }
        for (int t = 0; t < nt; t += 2) {
            const bool last = (t == nt - 2);
            const char* a1 = A0 + (size_t)(t + 1) * kstep;
            const char* a2 = last ? A0 : A0 + (size_t)(t + 2) * kstep; const char* b2 = last ? nB : cB + (size_t)(t + 2) * kstep;
            unsigned w0[2], w1[2]; w0[0] = last ? vN[0][0] : vA[0][0]; w0[1] = last ? vN[0][1] : vA[0][1]; w1[0] = last ? vN[1][0] : vA[1][0]; w1[1] = last ? vN[1][1] : vA[1][1];
            const char* a3 = a2 + kstep; const char* b3 = b2 + kstep;
            if (last && has_next) S.a_ready(nxt);
            if constexpr (SP2) {
            PG8_LDB(B0, 0, 0); PG8_LDB(B1, 0, 1); PG8_SCHED; PG8_LDA(At, 0, 0); PG8_STAGE(PG8_SA(1, 1), a1, vA[1]);
            PG8_WAIT_V(8); PG8_WAIT_L(0); PG8_BAR; PG8_MMA(0, 0, At, B0); PG8_MMA(0, 1, At, B1); PG8_BAR; PG8_SCHED;
            PG8_LDA(At, 0, 1); PG8_STAGE(PG8_SB(0, 0), b2, voffB); PG8_STAGE(PG8_SB(0, 1), b2 + hstep, voffB); PG8_STAGE(PG8_SA(0, 0), a2, w0);
            PG8_WAIT_V(8); PG8_WAIT_L(0); PG8_BAR; PG8_MMA(1, 0, At, B0); PG8_MMA(1, 1, At, B1); PG8_BAR; PG8_SCHED;
            PG8_LDB(B0, 1, 0); PG8_LDB(B1, 1, 1); PG8_SCHED; PG8_LDA(At, 1, 0); PG8_STAGE(PG8_SA(0, 1), a2, w1);
            PG8_WAIT_V(8); PG8_WAIT_L(0); PG8_BAR; PG8_MMA(0, 0, At, B0); PG8_MMA(0, 1, At, B1); PG8_BAR; PG8_SCHED;
            PG8_LDA(At, 1, 1); PG8_STAGE(PG8_SB(1, 0), b3, voffB); PG8_STAGE(PG8_SB(1, 1), b3 + hstep, voffB); PG8_STAGE(PG8_SA(1, 0), a3, w0);
            PG8_WAIT_V(8); PG8_WAIT_L(0); PG8_BAR; PG8_MMA(1, 0, At, B0); PG8_MMA(1, 1, At, B1); PG8_BAR; PG8_SCHED;
            } else {
            PG8_LDB(B0, 0, 0); PG8_SCHED; PG8_LDA(At, 0, 0); PG8_STAGE(PG8_SA(1, 1), a1, vA[1]);
            PG8_WAIT_L(8); PG8_BAR; PG8_WAIT_L(0); PG8_MMA(0, 0, At, B0); PG8_BAR; PG8_SCHED;
            PG8_LDB(B1, 0, 1); PG8_STAGE(PG8_SB(0, 0), b2, voffB);
            PG8_BAR; PG8_WAIT_L(0); PG8_MMA(0, 1, At, B1); PG8_BAR;
            PG8_LDA(At, 0, 1); PG8_STAGE(PG8_SA(0, 0), a2, w0);
            PG8_BAR; PG8_WAIT_L(0); PG8_MMA(1, 0, At, B0); PG8_BAR; PG8_SCHED;
            PG8_STAGE(PG8_SB(0, 1), b2 + hstep, voffB);
            PG8_WAIT_V(6); PG8_BAR; PG8_MMA(1, 1, At, B1); PG8_BAR;
            PG8_LDB(B0, 1, 0); PG8_SCHED; PG8_LDA(At, 1, 0); PG8_STAGE(PG8_SA(0, 1), a2, w1);
            PG8_WAIT_L(8); PG8_BAR; PG8_WAIT_L(0); PG8_MMA(0, 0, At, B0); PG8_BAR; PG8_SCHED;
            PG8_LDB(B1, 1, 1); PG8_STAGE(PG8_SB(1, 0), b3, voffB);
            PG8_BAR; PG8_WAIT_L(0); PG8_MMA(0, 1, At, B1); PG8_BAR;
            PG8_LDA(At, 1, 1); PG8_STAGE(PG8_SA(1, 0), a3, w0);
            PG8_BAR; PG8_WAIT_L(0); PG8_MMA(1, 0, At, B0); PG8_BAR; PG8_SCHED;
            PG8_STAGE(PG8_SB(1, 1), b3 + hstep, voffB);
            PG8_WAIT_V(6); PG8_BAR; PG8_MMA(1, 1, At, B1); PG8_BAR;
            }
        }
        if constexpr (ALIGN_EPI) { if (wr == 0) PG8_BAR; }
        if constexpr (!Epi::AFTER_DRAIN) { E(acc, cur, wr, wc, fr, fq); S.done(cur); }
        if (!has_next) break;
#pragma unroll
        for (int a = 0; a < 2; ++a)
#pragma unroll
            for (int b = 0; b < 2; ++b)
#pragma unroll
                for (int m = 0; m < 4; ++m)
#pragma unroll
                    for (int n = 0; n < 2; ++n) acc[a][b][m][n] = (f32x4){0.f, 0.f, 0.f, 0.f};
        cur = nxt; vA[0][0] = vN[0][0]; vA[0][1] = vN[0][1]; vA[1][0] = vN[1][0]; vA[1][1] = vN[1][1]; cB = nB; ++ui;
        if constexpr (ALIGN_EPI) { if (wr == 1) PG8_BAR; }
    }
    PG8_WAIT_V(0);
    if constexpr (!ALIGN_EPI) { if (wr == 0) PG8_BAR; }
    PG8_BAR;
    if constexpr (Epi::AFTER_DRAIN) { E.fused(acc, cur, wr, wc, fr, fq, lds, wid, lane); S.done(cur); }
#undef PG8_AOFF
#undef PG8_SA
#undef PG8_SB
#undef PG8_STAGE
#undef PG8_LDA
#undef PG8_LDB
#undef PG8_MMA
#undef PG8_WAIT_V
#undef PG8_WAIT_L
#undef PG8_BAR
#undef PG8_SCHED
}
}

constexpr size_t MiB = 1u << 20;
constexpr size_t WS_CTL = 0, CTL_ZERO_BYTES = 1 * MiB;
constexpr size_t WS_MODP = 1 * MiB;
constexpr size_t WS_MODF = 3 * MiB;
constexpr size_t WS_BIAS = 4 * MiB;
constexpr size_t WS_TOKE = 5 * MiB;
constexpr size_t WS_TOKP = 6 * MiB;
constexpr size_t WS_TOKW = 7 * MiB;
constexpr size_t WS_INV = 8 * MiB;
constexpr size_t WS_WIN = 10 * MiB;
constexpr size_t WS_WOUT = 15 * MiB;
constexpr size_t WS_X1 = 32 * MiB;
constexpr size_t WS_XN = 96 * MiB;
constexpr size_t WS_H2 = 128 * MiB;
constexpr size_t WS_PROJ = 160 * MiB;
constexpr size_t WS_O = 232 * MiB;
constexpr size_t WS_WGU = 264 * MiB;
constexpr size_t WS_WD = 392 * MiB;
constexpr size_t WS_ACT = 456 * MiB;
constexpr size_t WS_Y = 600 * MiB;
constexpr size_t WS_END = 744 * MiB;
constexpr int CW_TMO = 0, CW_CODE = 1;
constexpr int CW_CNT = 64;
constexpr int CW_BAR = 4096;
constexpr int CW_KSUM = 16384;
static_assert((CW_KSUM + 64 * 512) * 4 <= (int)CTL_ZERO_BYTES, "CTL region");
constexpr int RING_OFF = 0, RING_BYTES = 131072;
constexpr int LDSCTL_OFF = RING_BYTES, MISC_OFF = LDSCTL_OFF + 320;
constexpr int LDS_TILE_E = LDSCTL_OFF + 512;
constexpr int LDS_NT = LDS_TILE_E + MAXTILES * 4;
constexpr int LDS_TBASE = LDS_NT + 16;
constexpr int LDS_RIDX = LDS_TBASE + 128;
constexpr int LDS_BYTES = 147456;
static_assert(LDS_RIDX % 16 == 0 && LDS_RIDX + 10 * 1024 <= LDS_BYTES, "LDS map");
constexpr int NWAVES = 8;

#define GAS __attribute__((address_space(1)))
#define LAS __attribute__((address_space(3)))
typedef unsigned short bf16;
typedef unsigned v4u __attribute__((ext_vector_type(4)));
typedef float f32x4 __attribute__((ext_vector_type(4)));
typedef short bf16x8 __attribute__((ext_vector_type(8)));
typedef GAS unsigned gu32;
typedef GAS unsigned long long gu64;
#define RLX_AGENT __ATOMIC_RELAXED, __HIP_MEMORY_SCOPE_AGENT
#define LDS_WAIT() asm volatile("s_waitcnt lgkmcnt(0)" ::: "memory")
#define VM_WAIT() asm volatile("s_waitcnt vmcnt(0)" ::: "memory")
__device__ __forceinline__ unsigned long long rt() { return __builtin_amdgcn_s_memrealtime(); }
__device__ __forceinline__ unsigned f2bf(float f) { unsigned u = __builtin_bit_cast(unsigned, f); return (u + 0x7fffu + ((u >> 16) & 1u)) >> 16; }
__device__ __forceinline__ unsigned pk2(float lo, float hi) { return f2bf(lo) | (f2bf(hi) << 16); }

#define XB_TMO      128
#define XB_XCNT(j)  (256  + 64 * (j))
#define XB_XSUB(j)  (1280 + 64 * (j))
#define XB_XGEN(j)  (2304 + 64 * (j))
#define XB_TOP      3328
#define XB_TOPGEN   3392
#define XCD_BAR_WORDS 3456
#define XB_SPIN_CAP (1u << 18)

__device__ __forceinline__ unsigned xb_ld(unsigned* p)              { return __hip_atomic_load(p, __ATOMIC_RELAXED, __HIP_MEMORY_SCOPE_AGENT); }
__device__ __forceinline__ unsigned xb_add(unsigned* p, unsigned v) { return __hip_atomic_fetch_add(p, v, __ATOMIC_RELAXED, __HIP_MEMORY_SCOPE_AGENT); }
__device__ __forceinline__ unsigned xb_xcc_id() { return (unsigned)__builtin_amdgcn_s_getreg((3 << 11) | 20) & 0xFu; }
#define XB_SPIN(cond, bar) do { unsigned _sp = 0; while (cond) { __builtin_amdgcn_s_sleep(1); \
    if ((++_sp & 255u) == 0u) { if (xb_ld(&(bar)[XB_TMO])) break; if (_sp > XB_SPIN_CAP) { atomicAdd(&(bar)[XB_TMO], 1u); break; } } } } while (0)

struct XcdBarrier {
    unsigned* bar; unsigned x;
    volatile LAS unsigned* st;
};

__device__ __forceinline__ XcdBarrier xcd_barrier_post(unsigned* bar, volatile LAS unsigned* st) {
    XcdBarrier b; b.bar = bar; b.x = xb_xcc_id(); b.st = st;
    if (threadIdx.x == 0) (void)xb_add(&bar[XB_XCNT(b.x)], 1u);
    return b;
}
__device__ __forceinline__ void xcd_barrier_complete(unsigned* bar, unsigned x, unsigned& nloc, unsigned& nx) {
    const unsigned G = gridDim.x * gridDim.y * gridDim.z;
    unsigned sum, cnt, mine, sp = 0u;
    for (;;) {
        sum = 0u; cnt = 0u; mine = 0u;
#pragma unroll
        for (unsigned j = 0; j < 16; ++j) { const unsigned c = xb_ld(&bar[XB_XCNT(j)]); sum += c; cnt += (c > 0u) ? 1u : 0u; mine = (j == x) ? c : mine; }
        if (sum == G) break;
        __builtin_amdgcn_s_sleep(1);
        if ((++sp & 255u) == 0u) { if (xb_ld(&bar[XB_TMO])) break; if (sp > XB_SPIN_CAP) { atomicAdd(&bar[XB_TMO], 1u); break; } }
    }
    nloc = mine > 0u ? mine : 1u; nx = cnt > 0u ? cnt : 1u;
}

__device__ __forceinline__ void xcd_barrier(const XcdBarrier& b) {
    asm volatile("s_waitcnt vmcnt(0)" ::: "memory");
    __syncthreads();
    if (threadIdx.x == 0) {
        unsigned* bar = b.bar;
        __builtin_amdgcn_s_waitcnt(0);
        unsigned nloc = b.st[0], nx = b.st[1];
        if (nloc == 0u) { xcd_barrier_complete(bar, b.x, nloc, nx); b.st[0] = nloc; b.st[1] = nx; }
        const unsigned old = xb_add(&bar[XB_XSUB(b.x)], 1u);
        const unsigned gen = old / nloc;
        if (old + 1u == (gen + 1u) * nloc) {
            __builtin_amdgcn_fence(__ATOMIC_RELEASE, "agent");
            asm volatile("s_waitcnt vmcnt(0)" ::: "memory");
            const unsigned og = xb_add(&bar[XB_TOP], 1u);
            const unsigned tg = og / nx;
            if (og + 1u == (tg + 1u) * nx) xb_add(&bar[XB_TOPGEN], 1u);
            else XB_SPIN(xb_ld(&bar[XB_TOPGEN]) == tg, bar);
            __builtin_amdgcn_fence(__ATOMIC_ACQUIRE, "agent");
            xb_add(&bar[XB_XGEN(b.x)], 1u);
            asm volatile("s_waitcnt vmcnt(0)" ::: "memory");
        } else {
            XB_SPIN(xb_ld(&bar[XB_XGEN(b.x)]) == gen, bar);
            __builtin_amdgcn_fence(__ATOMIC_ACQUIRE, "agent");
            asm volatile("s_waitcnt vmcnt(0)" ::: "memory");
        }
    }
    __syncthreads();
}

namespace att {
using bf16x8 = __attribute__((ext_vector_type(8))) short;
using s16x4 = __attribute__((ext_vector_type(4))) short;
using f32x16 = __attribute__((ext_vector_type(16))) float;
using u32x4 = __attribute__((ext_vector_type(4))) unsigned;
typedef unsigned short bf16;
constexpr int PITCH = D_IN, OPITCH = D;
constexpr int NSLOT = 3, SLOTB = 8192;
constexpr int TAB_PAD = 96;
constexpr int LDS_K = 0, LDS_V = NSLOT * SLOTB, LDS_WS = 2 * NSLOT * SLOTB, LDS_OST = LDS_WS + 8 * 64 * 4, LDS_TAB = LDS_OST + 8 * 4096, LDS_KMS = LDS_TAB + (TAB_PAD + SEQ) * 4, LDS_END = LDS_KMS + 8 * 64 * 4;
static_assert(LDS_END <= 131072, "attention LDS");
__device__ __forceinline__ int crow(int r, int hi) { return (r & 3) + 8 * (r >> 2) + 4 * hi; }
__device__ __forceinline__ void glds16(const void* gsrc, unsigned lds_dst) { unsigned keep;
  asm volatile("s_mov_b32 %0, m0\n\ts_mov_b32 m0, %2\n\ts_nop 0\n\tglobal_load_lds_dwordx4 %1, off\n\ts_mov_b32 m0, %0" : "=&s"(keep) : "v"(gsrc), "s"(lds_dst) : "memory"); }
typedef float f32x2_t __attribute__((ext_vector_type(2))); typedef __bf16 bf16x2_t __attribute__((ext_vector_type(2)));
__device__ __forceinline__ unsigned cvtpk_s(float lo, float hi) { f32x2_t v = {lo, hi}; bf16x2_t b = __builtin_convertvector(v, bf16x2_t); return __builtin_bit_cast(unsigned, b); }
#define ATT_WAIT_BAR(N) asm volatile("s_waitcnt vmcnt(" #N ") lgkmcnt(0)\n\ts_barrier" ::: "memory")
#define ATT_LBAR() asm volatile("s_waitcnt lgkmcnt(0)\n\ts_barrier" ::: "memory")
__device__ __forceinline__ void qkt(f32x16& p0, f32x16& p1, const char* Kslot, const bf16x8* qr, int r32, int hi) {
  const char* kb = Kslot + hi * 1024 + r32 * 16;
  const f32x16 z = {};
#pragma unroll
  for (int d0 = 0; d0 < 4; ++d0) {
    const bf16x8 b0 = *reinterpret_cast<const bf16x8*>(kb + d0 * 2048);
    const bf16x8 b1 = *reinterpret_cast<const bf16x8*>(kb + d0 * 2048 + 512);
    if (d0 == 0) { p0 = __builtin_amdgcn_mfma_f32_32x32x16_bf16(b0, qr[0], z, 0, 0, 0); p1 = __builtin_amdgcn_mfma_f32_32x32x16_bf16(b1, qr[0], z, 0, 0, 0); }
    else { p0 = __builtin_amdgcn_mfma_f32_32x32x16_bf16(b0, qr[d0], p0, 0, 0, 0); p1 = __builtin_amdgcn_mfma_f32_32x32x16_bf16(b1, qr[d0], p1, 0, 0, 0); } }
}
__device__ __forceinline__ void pv(f32x16* o, int vb, bf16x8 pa0, bf16x8 pa1, bf16x8 pa2, bf16x8 pa3) {
#pragma unroll
  for (int d0 = 0; d0 < 2; ++d0) { s16x4 lo[4], hi[4];
#pragma unroll
    for (int ks = 0; ks < 4; ++ks) {
      asm volatile("ds_read_b64_tr_b16 %0,%1 offset:%c2" : "=&v"(lo[ks]) : "v"(vb), "i"(d0 * 4096 + ks * 1024) : "memory");
      asm volatile("ds_read_b64_tr_b16 %0,%1 offset:%c2" : "=&v"(hi[ks]) : "v"(vb), "i"(d0 * 4096 + ks * 1024 + 512) : "memory"); }
    asm volatile("s_waitcnt lgkmcnt(0)" ::: "memory"); __builtin_amdgcn_sched_barrier(0);
#define ATT_PK(k) (bf16x8){lo[k][0], lo[k][1], lo[k][2], lo[k][3], hi[k][0], hi[k][1], hi[k][2], hi[k][3]}
    o[d0] = __builtin_amdgcn_mfma_f32_32x32x16_bf16(pa0, ATT_PK(0), o[d0], 0, 0, 0);
    o[d0] = __builtin_amdgcn_mfma_f32_32x32x16_bf16(pa1, ATT_PK(1), o[d0], 0, 0, 0);
    o[d0] = __builtin_amdgcn_mfma_f32_32x32x16_bf16(pa2, ATT_PK(2), o[d0], 0, 0, 0);
    o[d0] = __builtin_amdgcn_mfma_f32_32x32x16_bf16(pa3, ATT_PK(3), o[d0], 0, 0, 0);
#undef ATT_PK
  }
}
struct UnitDesc { int b, qb, moba, qcol, kcol, vcol, ocol, head; float sink2; };

__device__ __forceinline__ void attn_unit(const UnitDesc& u, const bf16* P, bf16* O, const float* biasT, const float* ksum, char* shm) {
  const int tid = threadIdx.x, lane = tid & 63, r32 = lane & 31, hi = lane >> 5; const int wid = __builtin_amdgcn_readfirstlane(tid >> 6);
  const long rowbase = (long)u.b * SEQ; const int q0 = u.qb * 256;
  const unsigned lds0 = (unsigned)(uintptr_t)shm;
  float* wsf = (float*)(shm + LDS_WS) + wid * 64;
  float* tab = (float*)(shm + LDS_TAB); float* kms = (float*)(shm + LDS_KMS);
  const int tlo = u.moba ? 0 : (u.qb == 0 ? 0 : u.qb * 4 - 2), thi = u.qb * 4 + 3;
  const bf16* ksrc = P + (rowbase + lane) * PITCH + u.kcol + wid * 8;
  const bf16* vsrc = P + (rowbase + 16 * (wid & 3) + (lane >> 2)) * PITCH + u.vcol + (wid >> 2) * 32 + (lane & 3) * 8;
  const unsigned kdst = lds0 + LDS_K + wid * 1024, vdst = lds0 + LDS_V + wid * 1024;
#define ATT_DMA(t, slot) do { glds16(ksrc + (long)(t) * 64 * PITCH, (unsigned)__builtin_amdgcn_readfirstlane(kdst + (slot))); glds16(vsrc + (long)(t) * 64 * PITCH, (unsigned)__builtin_amdgcn_readfirstlane(vdst + (slot))); } while (0)
  const int vb0 = (int)(lds0 + LDS_V) + ((lane >> 4) & 1) * 32 + (lane & 3) * 8 + (4 * hi + ((lane & 15) >> 2)) * 64;
  ATT_DMA(tlo, 0); ATT_DMA(tlo + 1, SLOTB);
  for (int i = tid; i < TAB_PAD + SEQ; i += 512) tab[i] = (i < TAB_PAD) ? 0.f : biasT[u.head * SEQ + i - TAB_PAD];
  if (u.moba) kms[tid] = ksum[(size_t)(u.b * 8 + (tid >> 6)) * D_MOBA + u.head * HD + (tid & 63)];
  const bf16* Qw = P + (rowbase + q0 + wid * 32) * PITCH + u.qcol;
  bf16x8 qr[4];
#pragma unroll
  for (int d0 = 0; d0 < 4; ++d0) qr[d0] = *reinterpret_cast<const bf16x8*>(&Qw[(long)r32 * PITCH + d0 * 16 + hi * 8]);
  ATT_LBAR();
  unsigned selmask = 0u;
  if (u.moba) {
    if (u.qb <= MB_TOPK) selmask = (1u << u.qb) - 1u;
    else {
      float gate[MB_NB - 1];
#pragma unroll
      for (int n = 0; n < MB_NB - 1; ++n) { float s = 0.f;
        if (n < u.qb) {
#pragma unroll
          for (int d0 = 0; d0 < 4; ++d0)
#pragma unroll
            for (int j = 0; j < 8; ++j) s += __uint_as_float((unsigned)(unsigned short)qr[d0][j] << 16) * kms[n * 64 + d0 * 16 + hi * 8 + j];
          s += __shfl_xor(s, 32); }
        gate[n] = s; }
#pragma unroll
      for (int r = 0; r < MB_TOPK; ++r) { int best = -1; float bv = 0.f;
#pragma unroll
        for (int n = 0; n < MB_NB - 1; ++n) if (n < u.qb && !((selmask >> n) & 1u) && (best < 0 || gate[n] > bv)) { best = n; bv = gate[n]; }
        selmask |= 1u << best; }
    }
  }
  const int qrel = wid * 32 + r32, qpos = q0 + qrel;
  const float* tabq = tab + TAB_PAD + qpos - 63 - 4 * hi;
  float m = -1e30f, l = 0.f; f32x16 o[2]; o[0] = f32x16{}; o[1] = f32x16{};
  int slot = 0, slot2 = 2 * SLOTB;
  for (int t = tlo; t <= thi; ++t) {
    if (t + 1 <= thi) ATT_WAIT_BAR(2); else ATT_WAIT_BAR(0);
    if (t + 2 <= thi) ATT_DMA(t + 2, slot2);
    const int wq0 = q0 + wid * 32;
    bool need;
    int lim;
    if (u.moba) { const int n = t >> 2;
      if (n < u.qb) { lim = ((selmask >> n) & 1u) ? 0x7fffffff : 0; need = __any(lim != 0); }
      else { lim = 0x7fffffff; need = (64 * t <= wq0 + 31); } }
    else { lim = SWA_W; need = (64 * t <= wq0 + 31) && (64 * t + 63 >= wq0 - (SWA_W - 1)); }
    if (need) {
      f32x16 p0, p1;
      qkt(p0, p1, shm + LDS_K + slot, qr, r32, hi);
      const float* tb = tabq - 64 * t; const int dq = qpos - 64 * t - 4 * hi;
#pragma unroll
      for (int r = 0; r < 16; ++r) { const int c = (r & 3) + 8 * (r >> 2);
        const float s0 = p0[r] + tb[63 - c], s1 = p1[r] + tb[31 - c];
        p0[r] = ((unsigned)(dq - c) < (unsigned)lim) ? s0 : -INFINITY; p1[r] = ((unsigned)(dq - c - 32) < (unsigned)lim) ? s1 : -INFINITY; }
      float rm = p0[0];
#pragma unroll
      for (int r = 1; r < 16; ++r) rm = fmaxf(rm, p0[r]);
#pragma unroll
      for (int r = 0; r < 16; ++r) rm = fmaxf(rm, p1[r]);
      rm = fmaxf(rm, __shfl_xor(rm, 32));
      const float mnew = fmaxf(m, rm), alpha = __builtin_amdgcn_exp2f(m - mnew);
      float ls = 0.f;
#pragma unroll
      for (int r = 0; r < 16; ++r) { p0[r] = __builtin_amdgcn_exp2f(p0[r] - mnew); p1[r] = __builtin_amdgcn_exp2f(p1[r] - mnew); ls += p0[r] + p1[r]; }
      l = l * alpha + ls; m = mnew;
      if (!__all(alpha == 1.0f)) {
        if (hi == 0) wsf[r32] = alpha;
        asm volatile("s_waitcnt lgkmcnt(0)" ::: "memory");
#pragma unroll
        for (int r = 0; r < 16; ++r) { const float f = wsf[crow(r, hi)]; o[0][r] *= f; o[1][r] *= f; }
      }
      u32x4 pw0, pw1, pw2, pw3;
#define ATT_PKW(Pv, B) cvtpk_s(Pv[B], Pv[B + 1])
      pw0 = (u32x4){ATT_PKW(p0, 0), ATT_PKW(p0, 2), ATT_PKW(p0, 4), ATT_PKW(p0, 6)}; pw1 = (u32x4){ATT_PKW(p0, 8), ATT_PKW(p0, 10), ATT_PKW(p0, 12), ATT_PKW(p0, 14)};
      pw2 = (u32x4){ATT_PKW(p1, 0), ATT_PKW(p1, 2), ATT_PKW(p1, 4), ATT_PKW(p1, 6)}; pw3 = (u32x4){ATT_PKW(p1, 8), ATT_PKW(p1, 10), ATT_PKW(p1, 12), ATT_PKW(p1, 14)};
#undef ATT_PKW
      pv(o, vb0 + slot, __builtin_bit_cast(bf16x8, pw0), __builtin_bit_cast(bf16x8, pw1), __builtin_bit_cast(bf16x8, pw2), __builtin_bit_cast(bf16x8, pw3));
    }
    slot2 = slot; slot = (slot == (NSLOT - 1) * SLOTB) ? 0 : slot + SLOTB;
  }
  l += __shfl_xor(l, 32);
  if (!u.moba) l += __builtin_amdgcn_exp2f(u.sink2 - m);
  if (hi == 0) wsf[32 + r32] = l;
  asm volatile("s_waitcnt lgkmcnt(0)" ::: "memory");
  float rli[16];
#pragma unroll
  for (int r = 0; r < 16; ++r) rli[r] = __builtin_amdgcn_rcpf(wsf[32 + crow(r, hi)]);
  bf16* Ow = O + (rowbase + q0 + wid * 32) * OPITCH + u.ocol;
  { bf16* stg = (bf16*)(shm + LDS_OST) + wid * 2048;
#pragma unroll
    for (int r = 0; r < 16; ++r) { const int orow = crow(r, hi);
#pragma unroll
      for (int d0 = 0; d0 < 2; ++d0) stg[orow * 64 + d0 * 32 + r32] = (bf16)(cvtpk_s(o[d0][r] * rli[r], 0.f) & 0xffffu); }
    asm volatile("s_waitcnt lgkmcnt(0)" ::: "memory");
#pragma unroll
    for (int i = 0; i < 4; ++i) { const int row = i * 8 + (lane >> 3), ch = lane & 7; const u32x4 v = *(const u32x4*)(stg + row * 64 + ch * 8); *(u32x4*)(Ow + (long)row * OPITCH + ch * 8) = v; } }
  ATT_LBAR();
#undef ATT_DMA
}
}

struct Frame {
    LAS unsigned char* lds;
    volatile LAS unsigned* MISC;
    gu32* ctl;
    int tid, lane, wave, vcu, G;
};
__device__ __forceinline__ float wave_sum(float v) {
#pragma unroll
    for (int o = 1; o < 64; o <<= 1) v += __shfl_xor(v, o);
    return v;
}
__device__ __forceinline__ int rel_bucket(int dist) {
    const int n = dist > 0 ? dist : 0;
    if (n < 16) return n;
    const int th[15] = {21, 27, 35, 46, 59, 77, 99, 128, 166, 216, 280, 363, 470, 609, 790};
    int bk = 16;
#pragma unroll
    for (int i = 0; i < 15; ++i) bk += (n >= th[i]) ? 1 : 0;
    return bk;
}
__device__ __forceinline__ void p0_transpose_item(const float* W, int K, int N, bf16* WT, int k0, int n0, int dst_row0, LAS float* scr, int lane) {
#pragma unroll 8
    for (int i = 0; i < 32; ++i) { const int kk = 2 * i + (lane >> 5); scr[kk * 33 + (lane & 31)] = W[(size_t)(k0 + kk) * N + n0 + (lane & 31)]; }
    LDS_WAIT(); asm volatile("" ::: "memory");
    const int c = lane & 7;
#pragma unroll
    for (int j = 0; j < 4; ++j) { const int n = (lane >> 3) + 8 * j; const LAS float* s = scr + (8 * c) * 33 + n;
        v4u o; o.x = pk2(s[0 * 33], s[1 * 33]); o.y = pk2(s[2 * 33], s[3 * 33]); o.z = pk2(s[4 * 33], s[5 * 33]); o.w = pk2(s[6 * 33], s[7 * 33]);
        *(GAS v4u*)(WT + (size_t)(dst_row0 + n) * K + k0 + 8 * c) = o; }
    LDS_WAIT(); asm volatile("" ::: "memory");
}
struct Args { const float* in[19]; float* out; unsigned char* ws; int ph_lo, ph_hi; };

__device__ __forceinline__ void p0_prologue(Frame& F, const Args& a) {
    LAS float* scr = (LAS float*)(F.lds + RING_OFF + F.wave * 16384);
    const int gw = F.vcu * NWAVES + F.wave, NGW = F.G * NWAVES;
    const float* w_in = a.in[5]; const float* w_out = a.in[7]; const float* w_gu = a.in[14]; const float* w_down = a.in[16];
    bf16* Win_t = (bf16*)(a.ws + WS_WIN); bf16* Wout_t = (bf16*)(a.ws + WS_WOUT); bf16* Wgu_t = (bf16*)(a.ws + WS_WGU); bf16* Wd_t = (bf16*)(a.ws + WS_WD);
    constexpr int I_IN = 16 * (D_IN / 32), I_OUT = 16 * (D / 32), I_GU = NE * 16 * (2 * DFF / 32), I_DN = NE * 16 * (D / 32), I_MOD = 96 * 8, I_BIAS = 16 * SEQ / 64;
    constexpr int NITEMS = I_IN + I_OUT + I_GU + I_DN + I_MOD + I_BIAS;
    for (int it = gw; it < NITEMS; it += NGW) {
        int r = it;
        if (r < I_MOD) {
            const int cc = r % 96, ks = r / 96, j = cc * 64 + F.lane;
            const float* c = a.in[1]; const float* w_ada = a.in[3];
            float acc[BATCH];
#pragma unroll
            for (int b = 0; b < BATCH; ++b) acc[b] = 0.f;
            for (int k = ks * 128; k < ks * 128 + 128; ++k) {
                const float w = w_ada[(size_t)k * (6 * D) + j];
#pragma unroll
                for (int b = 0; b < BATCH; ++b) { const float cv = c[b * D + k]; acc[b] += (cv / (1.f + expf(-cv))) * w; }
            }
            float* mp = (float*)(a.ws + WS_MODP) + (size_t)ks * BATCH * 6 * D;
#pragma unroll
            for (int b = 0; b < BATCH; ++b) mp[(size_t)b * 6 * D + j] = acc[b];
            continue;
        }
        r -= I_MOD;
        if (r < I_BIAS) { const int i = r * 64 + F.lane, h = i / SEQ, d = i % SEQ; ((float*)(a.ws + WS_BIAS))[i] = a.in[9][rel_bucket(d) * 16 + h] * LOG2E; continue; }
        r -= I_BIAS;
        if (r < I_IN) { const int nb = r % (D_IN / 32), kb = r / (D_IN / 32); p0_transpose_item(w_in, D, D_IN, Win_t, kb * 64, nb * 32, nb * 32, scr, F.lane); continue; }
        r -= I_IN;
        if (r < I_OUT) { const int nb = r % (D / 32), kb = r / (D / 32); p0_transpose_item(w_out, D, D, Wout_t, kb * 64, nb * 32, nb * 32, scr, F.lane); continue; }
        r -= I_OUT;
        if (r < I_GU) { const int per = 16 * (2 * DFF / 32), e = r / per, q = r % per, nb = q % (2 * DFF / 32), kb = q / (2 * DFF / 32), n0 = nb * 32;
            const int dst = (n0 < DFF) ? ((n0 >> 7) * 256 + (n0 & 127)) : (((n0 - DFF) >> 7) * 256 + 128 + ((n0 - DFF) & 127));
            p0_transpose_item(w_gu + (size_t)e * D * 2 * DFF, D, 2 * DFF, Wgu_t + (size_t)e * 2 * DFF * D, kb * 64, n0, dst, scr, F.lane); continue; }
        r -= I_GU;
        { const int per = 16 * (D / 32), e = r / per, q = r % per, nb = q % (D / 32), kb = q / (D / 32);
            p0_transpose_item(w_down + (size_t)e * DFF * D, DFF, D, Wd_t + (size_t)e * D * DFF, kb * 64, nb * 32, nb * 32, scr, F.lane); }
    }
}
__device__ __forceinline__ void p1_xn(Frame& F, const Args& a) {
    const float* modp = (const float*)(a.ws + WS_MODP); const float* b_ada = a.in[4]; float* modf = (float*)(a.ws + WS_MODF);
    for (int i = blockIdx.x * 512 + F.tid; i < BATCH * 6 * D; i += F.G * 512) { float s = b_ada[i % (6 * D)];
#pragma unroll
        for (int ks = 0; ks < 8; ++ks) s += modp[(size_t)ks * BATCH * 6 * D + i];
        modf[i] = s; }
    LAS float* tab = (LAS float*)(F.lds + RING_OFF);
    const float* x = a.in[0]; const float* g = a.in[2]; bf16* XN = (bf16*)(a.ws + WS_XN);
    for (int chunk = blockIdx.x; chunk < NTOK / 64; chunk += F.G) {
        const int b = chunk / (SEQ / 64);
        __syncthreads();
        for (int i = F.tid; i < 2 * D; i += 512) { const int col = i & (D - 1), chunkid = (i < D) ? 1 : 0; float s = b_ada[chunkid * D + col];
#pragma unroll
            for (int ks = 0; ks < 8; ++ks) s += modp[(size_t)ks * BATCH * 6 * D + (size_t)b * 6 * D + chunkid * D + col];
            tab[i] = (i < D) ? g[col] * (1.f + s) : s; }
        __syncthreads();
        for (int rr = F.wave; rr < 64; rr += NWAVES) {
            const int row = chunk * 64 + rr;
            const GAS f32x4* xr = (const GAS f32x4*)(x + (size_t)row * D) + F.lane;
            f32x4 v[4]; float s = 0.f;
#pragma unroll
            for (int j = 0; j < 4; ++j) { v[j] = xr[64 * j]; s += (v[j].x * v[j].x + v[j].y * v[j].y) + (v[j].z * v[j].z + v[j].w * v[j].w); }
            const float rstd = 1.f / sqrtf(wave_sum(s) * (1.f / D) + EPS);
            GAS unsigned long long* o8 = (GAS unsigned long long*)(XN + (size_t)row * D) + F.lane;
#pragma unroll
            for (int j = 0; j < 4; ++j) { const int col = 4 * F.lane + 256 * j; const f32x4 gs = *(const LAS f32x4*)(tab + col), sh = *(const LAS f32x4*)(tab + D + col);
                const f32x4 h = v[j] * rstd * gs + sh;
                o8[64 * j] = (unsigned long long)pk2(h.x, h.y) | ((unsigned long long)pk2(h.z, h.w) << 32); }
        }
    }
}

__device__ __forceinline__ void p5_router(Frame& F, const Args& a) {
    typedef __attribute__((ext_vector_type(8))) short bx8; typedef __attribute__((ext_vector_type(16))) float fx16;
    const float* x1 = (const float*)(a.ws + WS_X1); const float* modf = (const float*)(a.ws + WS_MODF); const float* g_ffn = a.in[11]; const float* w_router = a.in[12]; const float* b_router = a.in[13];
    bf16* H2 = (bf16*)(a.ws + WS_H2); int* inv = (int*)(a.ws + WS_INV); int* tok_e = (int*)(a.ws + WS_TOKE); int* tok_p = (int*)(a.ws + WS_TOKP); float* tok_w = (float*)(a.ws + WS_TOKW);
    LAS float* part = (LAS float*)(F.lds + RING_OFF);
    LAS float* ssq = (LAS float*)(F.lds + RING_OFF + 32768);
    LAS float* cpart = (LAS float*)(F.lds + RING_OFF + 32768 + 1024);
    LAS float* lg = (LAS float*)(F.lds + RING_OFF + 32768 + 3072);
    LAS float* rs = (LAS float*)(F.lds + RING_OFF + 32768 + 3072 + 4352);
    LAS float* gsl = (LAS float*)(F.lds + RING_OFF + 49152);
    LAS float* shl = (LAS float*)(F.lds + RING_OFF + 49152 + 4096);
    const int lane = F.lane, w = F.wave, r32 = lane & 31, hi = lane >> 5;
#pragma unroll 1
    for (int chunk = blockIdx.x; chunk < NTOK / 64; chunk += F.G) {
        const int b = chunk / (SEQ / 64);
        __syncthreads();
        for (int i = F.tid; i < D; i += NWAVES * 64) { gsl[i] = g_ffn[i] * (1.f + modf[(size_t)b * 6 * D + 4 * D + i]); shl[i] = modf[(size_t)b * 6 * D + 3 * D + i]; }
        __syncthreads();
        bx8 ahi[8], alo[8]; float cp = 0.f;
        const float* wrp = w_router + (size_t)(128 * w + 8 * hi) * NE + r32; const LAS float* gsp = gsl + 128 * w + 8 * hi; const LAS float* shp = shl + 128 * w + 8 * hi;
#pragma unroll
        for (int s = 0; s < 8; ++s) {
            unsigned ph[4], pl[4];
#pragma unroll
            for (int j2 = 0; j2 < 4; ++j2) { float v[2];
#pragma unroll
                for (int q = 0; q < 2; ++q) { const int kk = 16 * s + 2 * j2 + q; const float wr_ = wrp[kk * NE]; cp += shp[kk] * wr_; v[q] = gsp[kk] * wr_; }
                const unsigned h0 = f2bf(v[0]), h1 = f2bf(v[1]); ph[j2] = h0 | (h1 << 16);
                pl[j2] = f2bf(v[0] - __uint_as_float(h0 << 16)) | (f2bf(v[1] - __uint_as_float(h1 << 16)) << 16); }
            ahi[s] = __builtin_bit_cast(bx8, (v4u){ph[0], ph[1], ph[2], ph[3]}); alo[s] = __builtin_bit_cast(bx8, (v4u){pl[0], pl[1], pl[2], pl[3]});
        }
        cpart[(w * 2 + hi) * 32 + r32] = cp;
#pragma unroll 1
        for (int pass = 0; pass < 2; ++pass) {
            const int tok = chunk * 64 + pass * 32 + r32;
            const float* xr = x1 + (size_t)tok * D + 128 * w + 8 * hi;
            float ss = 0.f; fx16 acc = {};
#pragma unroll
            for (int s = 0; s < 8; ++s) {
                const f32x4 x0 = *(const GAS f32x4*)(xr + 16 * s), x1v = *(const GAS f32x4*)(xr + 16 * s + 4);
                unsigned ph[4], pl[4];
#pragma unroll
                for (int q = 0; q < 2; ++q) { const f32x4 v = q ? x1v : x0; ss += (v.x * v.x + v.y * v.y) + (v.z * v.z + v.w * v.w);
                    const unsigned h0 = f2bf(v.x), h1 = f2bf(v.y), h2_ = f2bf(v.z), h3 = f2bf(v.w);
                    ph[2 * q] = h0 | (h1 << 16); ph[2 * q + 1] = h2_ | (h3 << 16);
                    pl[2 * q] = f2bf(v.x - __uint_as_float(h0 << 16)) | (f2bf(v.y - __uint_as_float(h1 << 16)) << 16);
                    pl[2 * q + 1] = f2bf(v.z - __uint_as_float(h2_ << 16)) | (f2bf(v.w - __uint_as_float(h3 << 16)) << 16); }
                const bx8 bhi = __builtin_bit_cast(bx8, (v4u){ph[0], ph[1], ph[2], ph[3]}), blo = __builtin_bit_cast(bx8, (v4u){pl[0], pl[1], pl[2], pl[3]});
                acc = __builtin_amdgcn_mfma_f32_32x32x16_bf16(ahi[s], bhi, acc, 0, 0, 0);
                acc = __builtin_amdgcn_mfma_f32_32x32x16_bf16(ahi[s], blo, acc, 0, 0, 0);
                acc = __builtin_amdgcn_mfma_f32_32x32x16_bf16(alo[s], bhi, acc, 0, 0, 0);
            }
            ss += __shfl_xor(ss, 32);
            __syncthreads();
#pragma unroll
            for (int r = 0; r < 16; ++r) part[(w * 32 + ((r & 3) + 8 * (r >> 2) + 4 * hi)) * 32 + r32] = acc[r];
            if (hi == 0) ssq[w * 32 + r32] = ss;
            __syncthreads();
            { const int tk = F.tid & 31, eg = F.tid >> 5;
                float sq = 0.f;
#pragma unroll
                for (int ww = 0; ww < 8; ++ww) sq += ssq[ww * 32 + tk];
                const float rstd = 1.f / sqrtf(sq * (1.f / D) + EPS);
                if (eg == 0) rs[tk] = rstd;
#pragma unroll
                for (int q = 0; q < 2; ++q) { const int e = 2 * eg + q; float sum = 0.f, c = b_router[e];
#pragma unroll
                    for (int ww = 0; ww < 8; ++ww) sum += part[(ww * 32 + e) * 32 + tk];
#pragma unroll
                    for (int ww = 0; ww < 16; ++ww) c += cpart[ww * 32 + e];
                    lg[tk * 33 + e] = rstd * sum + c; } }
            __syncthreads();
            { const float rstd = rs[r32]; bf16* hr = H2 + (size_t)tok * D + 128 * w + 8 * hi;
#pragma unroll
                for (int s = 0; s < 8; ++s) { unsigned pk[4];
#pragma unroll
                    for (int q = 0; q < 2; ++q) { const f32x4 xv = *(const GAS f32x4*)(xr + 16 * s + 4 * q), g4 = *(const LAS f32x4*)(gsp + 16 * s + 4 * q), h4 = *(const LAS f32x4*)(shp + 16 * s + 4 * q);
                        const f32x4 hv = xv * rstd * g4 + h4; pk[2 * q] = pk2(hv.x, hv.y); pk[2 * q + 1] = pk2(hv.z, hv.w); }
                    *(GAS v4u*)(hr + 16 * s) = (v4u){pk[0], pk[1], pk[2], pk[3]}; } }
            if (w == 0 && lane < 32) {
                float lgv[NE];
#pragma unroll
                for (int i = 0; i < NE; ++i) lgv[i] = lg[lane * 33 + i];
                int idx[TOPK]; float val[TOPK]; unsigned used = 0;
#pragma unroll
                for (int r = 0; r < TOPK; ++r) { int best = -1; float bv = 0.f;
#pragma unroll
                    for (int i = 0; i < NE; ++i) if (!((used >> i) & 1u) && (best < 0 || lgv[i] > bv)) { best = i; bv = lgv[i]; }
                    used |= 1u << best; idx[r] = best; val[r] = bv; }
                float wsum = 0.f, wv[TOPK];
#pragma unroll
                for (int r = 0; r < TOPK; ++r) { wv[r] = __expf(val[r] - val[0]); wsum += wv[r]; }
                const int tk = chunk * 64 + pass * 32 + lane; const float inv_ws = 1.f / wsum;
#pragma unroll
                for (int r = 0; r < TOPK; ++r) { const int pos = (int)__hip_atomic_fetch_add(F.ctl + CW_CNT + idx[r], 1u, RLX_AGENT);
                    inv[(size_t)idx[r] * NTOK + pos] = tk; tok_e[tk * 4 + r] = idx[r]; tok_p[tk * 4 + r] = pos; tok_w[tk * 4 + r] = wv[r] * inv_ws; }
            }
        }
    }
}
__device__ __forceinline__ void build_tiles(Frame& F) {
    LAS int* tile_e = (LAS int*)(F.lds + LDS_TILE_E); LAS int* ntl = (LAS int*)(F.lds + LDS_NT); LAS int* tbase = (LAS int*)(F.lds + LDS_TBASE);
    __syncthreads();
    if (F.tid == 0) { int base = 0;
        for (int e = 0; e < NE; ++e) { const int c = (int)__hip_atomic_load(F.ctl + CW_CNT + e, RLX_AGENT); const int nt = (c + 255) >> 8; tbase[e] = base; for (int j = 0; j < nt; ++j) tile_e[base + j] = e; base += nt; }
        ntl[0] = base; }
    __syncthreads();
}
__device__ __forceinline__ void p8_final(Frame& F, const Args& a) {
    build_tiles(F);
    const LAS int* tbase = (const LAS int*)(F.lds + LDS_TBASE);
    const float* x1 = (const float*)(a.ws + WS_X1); const bf16* Y = (const bf16*)(a.ws + WS_Y); const float* modf = (const float*)(a.ws + WS_MODF);
    const int* tok_e = (const int*)(a.ws + WS_TOKE); const int* tok_p = (const int*)(a.ws + WS_TOKP); const float* tok_w = (const float*)(a.ws + WS_TOKW);
    const float* gfin = a.in[18];
    const int gw = F.vcu * NWAVES + F.wave, NGW = F.G * NWAVES;
    for (int row = gw; row < NTOK; row += NGW) {
        const int b = row / SEQ; const float* gf = modf + (size_t)b * 6 * D + 5 * D;
        f32x4 acc[4];
#pragma unroll
        for (int j = 0; j < 4; ++j) acc[j] = (f32x4){0.f, 0.f, 0.f, 0.f};
#pragma unroll
        for (int k = 0; k < TOPK; ++k) {
            const int e = __builtin_amdgcn_readfirstlane(tok_e[row * 4 + k]), p = __builtin_amdgcn_readfirstlane(tok_p[row * 4 + k]); const float wk = tok_w[row * 4 + k];
            const GAS unsigned long long* yr = (const GAS unsigned long long*)(Y + (size_t)(tbase[e] * 256 + p) * D) + F.lane;
#pragma unroll
            for (int j = 0; j < 4; ++j) { const unsigned long long q = yr[64 * j]; const unsigned lo = (unsigned)q, hi = (unsigned)(q >> 32);
                acc[j].x += wk * __uint_as_float(lo << 16); acc[j].y += wk * __uint_as_float(lo & 0xffff0000u); acc[j].z += wk * __uint_as_float(hi << 16); acc[j].w += wk * __uint_as_float(hi & 0xffff0000u); }
        }
        const GAS f32x4* xr = (const GAS f32x4*)(x1 + (size_t)row * D) + F.lane;
        float s = 0.f; f32x4 v[4];
#pragma unroll
        for (int j = 0; j < 4; ++j) { const f32x4 g4 = *(const GAS f32x4*)(gf + 4 * F.lane + 256 * j); v[j] = xr[64 * j] + g4 * acc[j]; s += (v[j].x * v[j].x + v[j].y * v[j].y) + (v[j].z * v[j].z + v[j].w * v[j].w); }
        const float rstd = 1.f / sqrtf(wave_sum(s) * (1.f / D) + EPS);
        GAS f32x4* orow = (GAS f32x4*)(a.out + (size_t)row * D) + F.lane;
#pragma unroll
        for (int j = 0; j < 4; ++j) { const f32x4 g4 = *(const GAS f32x4*)(gfin + 4 * F.lane + 256 * j); orow[64 * j] = v[j] * rstd * g4; }
    }
}
__device__ __forceinline__ void build_ridx(Frame& F, const Args& a, int nN) {
    const LAS int* tile_e = (const LAS int*)(F.lds + LDS_TILE_E); const LAS int* tbase = (const LAS int*)(F.lds + LDS_TBASE); const int ntiles = *(const LAS int*)(F.lds + LDS_NT);
    LAS int* ridx = (LAS int*)(F.lds + LDS_RIDX); const int* inv = (const int*)(a.ws + WS_INV);
    for (int i = 0; i < 10; ++i) { const int L = i * F.G + (int)blockIdx.x, t = L / nN; if (t >= ntiles) break;
        const int e = tile_e[t], j = t - tbase[e], c = (int)__hip_atomic_load(F.ctl + CW_CNT + e, RLX_AGENT);
        for (int r = F.tid; r < 256; r += NWAVES * 64) { const int pos = j * 256 + r; ridx[i * 256 + r] = inv[(size_t)e * NTOK + (pos < c ? pos : 0)]; } }
    __syncthreads();
}

__global__ void __launch_bounds__(NWAVES * 64, 2) mega_fwd(Args args) {
    extern __shared__ __attribute__((aligned(16))) unsigned char lds[];
    Frame F;
    F.lds = (LAS unsigned char*)lds;
    F.MISC = (volatile LAS unsigned*)(F.lds + MISC_OFF);
    F.tid = threadIdx.x; F.lane = F.tid & 63; F.wave = __builtin_amdgcn_readfirstlane(F.tid >> 6);
    F.G = gridDim.x; { const int bx = blockIdx.x; F.vcu = (F.G % 8 == 0) ? (bx % 8) * (F.G / 8) + bx / 8 : bx; }
    unsigned char* ws = args.ws;
    F.ctl = (gu32*)(ws + WS_CTL);
    for (int u = F.tid; u < 512 / 4; u += NWAVES * 64) ((LAS unsigned*)(F.lds + LDSCTL_OFF))[u] = 0u;
    __syncthreads();
    XcdBarrier bar = xcd_barrier_post((unsigned*)(F.ctl + CW_BAR), F.MISC + 8);
    const int lo = args.ph_lo, hi = args.ph_hi;
#define IN(k) (lo <= (k) && (k) < hi)
#define BOTH(k) (IN(k) && IN((k) + 1))
#define GRID_BAR() xcd_barrier(bar)
    if (IN(0)) { p0_prologue(F, args); if (BOTH(0)) GRID_BAR(); }
    if (IN(1)) { p1_xn(F, args); if (BOTH(1)) GRID_BAR(); }
    if (IN(2)) {
        pg8::Gemm g{(const bf16*)(ws + WS_XN), (const bf16*)(ws + WS_WIN), NTOK, D_IN, D}; pg8::StaticOrder S; S.init(NTOK, D_IN, F.G, (int)blockIdx.x);
        pg8::EpiProj E{(bf16*)(ws + WS_PROJ), args.in[6], (float*)(F.ctl + CW_KSUM)};
        pg8::gemm_phase<pg8::EpiProj, pg8::StaticOrder, true, true>(F.lds + RING_OFF, g, S, E);
        if (BOTH(2)) GRID_BAR();
    }
    if (IN(3)) {
        const float* sinks = args.in[10];
        for (int uidx = F.vcu; uidx < 1024; uidx += F.G) {
            const int v = uidx & 255, round = uidx >> 8, bh = v >> 2, s = v & 3, h = bh & 7;
            att::UnitDesc u; u.b = bh >> 3;
            if (round < 2) { u.moba = 1; u.qb = (round == 0) ? s : 7 - s; u.qcol = h * 64; u.kcol = 512 + h * 64; u.vcol = 1024 + h * 64; u.ocol = h * 64; u.head = h; u.sink2 = 0.f; }
            else { u.moba = 0; u.qb = 2 * s + (round - 2); u.qcol = 1536 + h * 64; u.kcol = 2048 + (h >> 2) * 64; u.vcol = 2176 + (h >> 2) * 64; u.ocol = 512 + h * 64; u.head = 8 + h; u.sink2 = sinks[h] * LOG2E; }
            att::attn_unit(u, (const bf16*)(ws + WS_PROJ), (bf16*)(ws + WS_O), (const float*)(ws + WS_BIAS), (const float*)(F.ctl + CW_KSUM), (char*)lds + RING_OFF);
        }
        if (BOTH(3)) GRID_BAR();
    }
    if (IN(4)) {
        pg8::Gemm g{(const bf16*)(ws + WS_O), (const bf16*)(ws + WS_WOUT), NTOK, D, D}; pg8::StaticOrder S; S.init(NTOK, D, F.G, (int)blockIdx.x);
        pg8::EpiX1 E{args.in[0], (float*)(ws + WS_X1), args.in[8], (const float*)(ws + WS_MODF)};
        pg8::gemm_phase<pg8::EpiX1, pg8::StaticOrder, false, true>(F.lds + RING_OFF, g, S, E);
        if (BOTH(4)) GRID_BAR();
    }
    if (IN(5)) { p5_router(F, args); if (BOTH(5)) GRID_BAR(); }
    if (IN(6)) {
        build_tiles(F); build_ridx(F, args, 2 * DFF / 256);
        pg8::Gemm g{(const bf16*)(ws + WS_H2), (const bf16*)(ws + WS_WGU), MAXSLOTS, 2 * DFF, D};
        pg8::GroupedOrder S{2 * DFF / 256, F.G, (int)blockIdx.x, *(const LAS int*)(F.lds + LDS_NT), (const LAS int*)(F.lds + LDS_TILE_E), (const LAS int*)(F.lds + LDS_RIDX), (size_t)2 * DFF * D * 2};
        pg8::EpiSwiglu E{(bf16*)(ws + WS_ACT), args.in[15]};
        pg8::gemm_phase<pg8::EpiSwiglu, pg8::GroupedOrder, true, true>(F.lds + RING_OFF, g, S, E);
        if (BOTH(6)) GRID_BAR();
    }
    if (IN(7)) {
        build_tiles(F);
        pg8::Gemm g{(const bf16*)(ws + WS_ACT), (const bf16*)(ws + WS_WD), MAXSLOTS, D, DFF};
        pg8::GroupedOrder S{D / 256, F.G, (int)blockIdx.x, *(const LAS int*)(F.lds + LDS_NT), (const LAS int*)(F.lds + LDS_TILE_E), (const LAS int*)nullptr, (size_t)D * DFF * 2};
        pg8::EpiDown E{(bf16*)(ws + WS_Y), args.in[17]};
        pg8::gemm_phase<pg8::EpiDown, pg8::GroupedOrder, true, true>(F.lds + RING_OFF, g, S, E);
        if (BOTH(7)) GRID_BAR();
    }
    if (IN(8)) { p8_final(F, args); }
#undef IN
#undef BOTH
}

#ifndef MK_PER_PHASE
#define MK_PER_PHASE 0
#endif
extern "C" void kernel_launch(void* const* d_in, const int* in_sizes, int n_in, void* d_out, int out_size, void* d_ws, size_t ws_size, hipStream_t stream) {
    static int grid = 0;
    if (grid == 0) {
        if (n_in != 19 || ws_size < WS_END) { fprintf(stderr, "kernel_launch: unexpected n_in %d / ws %zu\n", n_in, ws_size); grid = -1; return; }
        int dev = 0, cus = 0, per_cu = 0;
        if (hipGetDevice(&dev) != hipSuccess || hipDeviceGetAttribute(&cus, hipDeviceAttributeMultiprocessorCount, dev) != hipSuccess) { grid = -1; return; }
        if (hipFuncSetAttribute((const void*)mega_fwd, hipFuncAttributeMaxDynamicSharedMemorySize, LDS_BYTES) != hipSuccess) { fprintf(stderr, "kernel_launch: hipFuncSetAttribute failed\n"); grid = -1; return; }
        if (hipOccupancyMaxActiveBlocksPerMultiprocessor(&per_cu, (const void*)mega_fwd, NWAVES * 64, LDS_BYTES) != hipSuccess || per_cu < 1) fprintf(stderr, "kernel_launch: occupancy query reports %d\n", per_cu);
        (void)hipGetLastError();
        grid = cus;
    }
    if (grid < 0) return;
    unsigned char* ws = (unsigned char*)d_ws;
    (void)hipMemsetAsync(ws + WS_CTL, 0, CTL_ZERO_BYTES, stream);
    Args a{};
    for (int i = 0; i < 19; ++i) a.in[i] = (const float*)d_in[i];
    a.out = (float*)d_out; a.ws = ws;
#if MK_PER_PHASE
    for (int ph = 0; ph < 9; ++ph) { a.ph_lo = ph; a.ph_hi = ph + 1; hipLaunchKernelGGL(mega_fwd, dim3(grid), dim3(NWAVES * 64), LDS_BYTES, stream, a); }
#else
    a.ph_lo = 0; a.ph_hi = 9; hipLaunchKernelGGL(mega_fwd, dim3(grid), dim3(NWAVES * 64), LDS_BYTES, stream, a);
#endif
}
```

```cpp
#include <hip/hip_runtime.h>
#include <hip/hip_bf16.h>
#include <cstdio>
#include <cstdint>
#include <cmath>

constexpr int D = 1024, BATCH = 8, SEQ = 2048, NTOK = BATCH * SEQ;
constexpr int HD = 64, NH_M = 8, NH_S = 8, NKV_S = 2;
constexpr int D_MOBA = 512, D_SWA_Q = 512, D_SWA_KV = 128, D_IN = 2304;
constexpr int MB_L = 256, MB_NB = SEQ / MB_L, MB_TOPK = 3;
constexpr int SWA_W = 128;
constexpr int NE = 32, TOPK = 4, DFF = 1024;
constexpr float EPS = 1e-5f, NEGF = -1e30f;
constexpr int MAXTILES = 288;
constexpr int MAXSLOTS = MAXTILES * 256;
constexpr float LOG2E = 1.4426950408889634f;
constexpr float YSCALE = 16.0f;
constexpr float WSCALE = 32.0f;
constexpr float QSCALE = 0.125f * LOG2E;

namespace pg8 {
#define PG8_LAS __attribute__((address_space(3)))
typedef unsigned short bf16_t;
typedef short bf16x8 __attribute__((ext_vector_type(8)));
typedef float f32x4 __attribute__((ext_vector_type(4)));
typedef unsigned u32x4 __attribute__((ext_vector_type(4)));
typedef int v4i_t __attribute__((ext_vector_type(4)));
constexpr int BM = 256, BK = 64, HALF = 128, HTB = HALF * BK * 2  , STAGE_BYTES = 8 * HTB, NXCD = 8, WGM = 8;

__host__ __device__ __forceinline__ int lds_byte(int r, int c) { const int st = (r >> 4) * 2 + (c >> 5), rr = r & 15, cc = c & 31, ob = rr * 64 + cc * 2; return st * 1024 + (ob ^ (((ob >> 9) & 1) << 5)); }
__host__ __device__ __forceinline__ void stage_rc(int b, int& R, int& C) { const int st = b / 1024, sb = b % 1024, swz = sb ^ (((sb >> 9) & 1) << 5); R = (st >> 1) * 16 + swz / 64; C = (st & 1) * 32 + (swz % 64) / 2; }
__host__ __device__ __forceinline__ int perm32(int rho) { const int n = rho >> 4, i = rho & 15; return 8 * (i >> 2) + 4 * n + (i & 3); }

struct Unit { int pm, pn, e; };
struct Gemm { const bf16_t* A; const bf16_t* Bt; int M, N, K; };

struct StaticOrder {
    int nM, nN, nwg, G, c;
    __host__ __device__ void init(int M, int N, int G_, int c_) { nM = M / BM; nN = N / BM; nwg = nM * nN; G = G_; c = c_; }
    __host__ __device__ bool next(int i, Unit& u) const {
        const long L = (long)i * G + c; if (L >= nwg) return false;
        int wgid = (int)L; { const int q = nwg / NXCD, r = nwg % NXCD, xcd = wgid % NXCD, off = wgid / NXCD; wgid = (xcd < r ? xcd * (q + 1) : r * (q + 1) + (xcd - r) * q) + off; }
        const int nig = WGM * nN, gid = wgid / nig, fm = gid * WGM, gsz = (nM - fm) < WGM ? (nM - fm) : WGM;
        u.pm = fm + ((wgid % nig) % gsz); u.pn = (wgid % nig) / gsz; u.e = 0; return true;
    }
    __device__ __forceinline__ size_t abase(const Unit& u, int h, int K) const { return (size_t)(u.pm * BM + h * HALF) * K * 2; }
    __device__ __forceinline__ unsigned alane(int, const Unit&, int, int, unsigned voff, int) const { return voff; }
    __device__ __forceinline__ size_t bbase(const Unit& u, size_t tstep) const { return (size_t)u.pn * tstep; }
    __device__ __forceinline__ void a_ready(const Unit&) const {}
    __device__ __forceinline__ void done(const Unit&) const {}
};
__device__ __forceinline__ bool moe_unit(int i, int c, int G, int nN, const PG8_LAS int* cnte, const PG8_LAS int* tbase, int ntiles, int& t, int& pn) {
    if ((G & 7) == 0) {
        const int x = c & 7, rank = c >> 3, W = G >> 3, lo = (x * ntiles) >> 3, hi = ((x + 1) * ntiles) >> 3, v = i * W + rank;
        if (v >= (hi - lo) * nN) return false;
        const int j = v / nN; t = lo + j; pn = v - j * nN; return true;
    }
    const int L = i * G + c; t = L / nN; if (t >= ntiles) return false; pn = L - t * nN; return true;
}
struct GroupedOrder {
    int nN, G, c, ntiles; const PG8_LAS int* tile_e; const PG8_LAS int* ridx; size_t bstride; const PG8_LAS int* cnte; const PG8_LAS int* tbase;
    __device__ __forceinline__ bool next(int i, Unit& u) const {
        int t, pn; if (!moe_unit(i, c, G, nN, cnte, tbase, ntiles, t, pn)) return false;
        u.pm = __builtin_amdgcn_readfirstlane(t); u.pn = __builtin_amdgcn_readfirstlane(pn); u.e = __builtin_amdgcn_readfirstlane(tile_e[t]); return true;
    }
    __device__ __forceinline__ size_t abase(const Unit& u, int h, int K) const { return ridx ? (size_t)0 : (size_t)(u.pm * BM + h * HALF) * K * 2; }
    __device__ __forceinline__ unsigned alane(int ui, const Unit&, int h, int piece, unsigned voff, int K) const {
        if (!ridx) return voff;
        int t_ = (int)threadIdx.x; asm volatile("" : "+v"(t_));
        int R, C; stage_rc(t_ * 16 + piece * 8192, R, C);
        return (unsigned)ridx[ui * BM + h * HALF + R] * (unsigned)K * 2u + (unsigned)C * 2u; }
    __device__ __forceinline__ size_t bbase(const Unit& u, size_t tstep) const { return (size_t)u.e * bstride + (size_t)u.pn * tstep; }
    __device__ __forceinline__ void a_ready(const Unit&) const {}
    __device__ __forceinline__ void done(const Unit&) const {}
};

__device__ __forceinline__ unsigned cvt_pk_bf16(float lo, float hi) { unsigned r; asm volatile("v_cvt_pk_bf16_f32 %0, %1, %2" : "=v"(r) : "v"(lo), "v"(hi)); return r; }

struct EpiProj {
    static constexpr bool PERM = true, AFTER_DRAIN = false;
    bf16_t* O; const float* bias; float* ksum;
    __device__ __forceinline__ void operator()(const f32x4 (&acc)[2][2][4][2], const Unit& u, int wr, int wc, int fr, int fq) const {
        const int row0 = u.pm * BM + wr * 64 + fr, col0 = u.pn * BM + wc * 32 + 8 * fq;
        const float sc = (u.pn < 2 || u.pn == 6 || u.pn == 7) ? QSCALE : 1.0f;
        f32x4 bv[2][2];
#pragma unroll
        for (int bj = 0; bj < 2; ++bj)
#pragma unroll
            for (int n = 0; n < 2; ++n) bv[bj][n] = *(const f32x4*)(bias + col0 + bj * HALF + 4 * n);
#pragma unroll
        for (int ai = 0; ai < 2; ++ai)
#pragma unroll
            for (int m = 0; m < 4; ++m) { bf16_t* rowp = O + (size_t)(row0 + ai * HALF + m * 16) * D_IN + col0;
#pragma unroll
                for (int bj = 0; bj < 2; ++bj) { f32x4 v0 = (acc[ai][bj][m][0] + bv[bj][0]) * sc, v1 = (acc[ai][bj][m][1] + bv[bj][1]) * sc;
                    u32x4 w; w.x = cvt_pk_bf16(v0[0], v0[1]); w.y = cvt_pk_bf16(v0[2], v0[3]); w.z = cvt_pk_bf16(v1[0], v1[1]); w.w = cvt_pk_bf16(v1[2], v1[3]);
                    *(u32x4*)(rowp + bj * HALF) = w; } }
        if (u.pn == 2 || u.pn == 3) {
#pragma unroll
            for (int bj = 0; bj < 2; ++bj)
#pragma unroll
                for (int n = 0; n < 2; ++n) {
                    f32x4 s = bv[bj][n] * 8.0f;
#pragma unroll
                    for (int ai = 0; ai < 2; ++ai)
#pragma unroll
                        for (int m = 0; m < 4; ++m) s += acc[ai][bj][m][n];
#pragma unroll
                    for (int j = 0; j < 4; ++j) { float t = s[j]; t += __shfl_xor(t, 1); t += __shfl_xor(t, 2); t += __shfl_xor(t, 4); t += __shfl_xor(t, 8);
                        if (fr == 0) atomicAdd(ksum + (size_t)u.pm * D_MOBA + (u.pn - 2) * BM + bj * HALF + wc * 32 + 8 * fq + 4 * n + j, t); }
                }
        }
    }
};
struct EpiX1 {
    static constexpr bool PERM = true, AFTER_DRAIN = false;
    const float* x; bf16_t* x1; const float* bias; const float* modf;
    __device__ __forceinline__ void operator()(const f32x4 (&acc)[2][2][4][2], const Unit& u, int wr, int wc, int fr, int fq) const {
        const int row0 = u.pm * BM + wr * 64 + fr, col0 = u.pn * BM + wc * 32 + 8 * fq;
        const float* ga = modf + (size_t)(u.pm >> 3) * 6 * D + 2 * D;
        f32x4 bv[2][2], gv[2][2];
#pragma unroll
        for (int bj = 0; bj < 2; ++bj)
#pragma unroll
            for (int n = 0; n < 2; ++n) { bv[bj][n] = *(const f32x4*)(bias + col0 + bj * HALF + 4 * n); gv[bj][n] = *(const f32x4*)(ga + col0 + bj * HALF + 4 * n); }
#pragma unroll
        for (int ai = 0; ai < 2; ++ai)
#pragma unroll
            for (int m = 0; m < 4; ++m) { const size_t off = (size_t)(row0 + ai * HALF + m * 16) * D + col0;
#pragma unroll
                for (int bj = 0; bj < 2; ++bj) { const f32x4 xr0 = *(const f32x4*)(x + off + bj * HALF), xr1 = *(const f32x4*)(x + off + bj * HALF + 4);
                    const f32x4 v0 = xr0 + gv[bj][0] * (acc[ai][bj][m][0] + bv[bj][0]), v1 = xr1 + gv[bj][1] * (acc[ai][bj][m][1] + bv[bj][1]);
                    u32x4 w; w.x = cvt_pk_bf16(v0[0], v0[1]); w.y = cvt_pk_bf16(v0[2], v0[3]); w.z = cvt_pk_bf16(v1[0], v1[1]); w.w = cvt_pk_bf16(v1[2], v1[3]);
                    *(u32x4*)(x1 + off + bj * HALF) = w; }
                if (m == 3) asm volatile("" ::: "memory"); }
    }
};
struct EpiSwiglu {
    static constexpr bool PERM = true, AFTER_DRAIN = false;
    bf16_t* act; const float* bias;
    __device__ __forceinline__ void operator()(const f32x4 (&acc)[2][2][4][2], const Unit& u, int wr, int wc, int fr, int fq) const {
        const int row0 = u.pm * BM + wr * 64 + fr, ff0 = u.pn * HALF + wc * 32 + 8 * fq;
        const float* bg = bias + (size_t)u.e * 2 * DFF + ff0;
        f32x4 bgv[2], buv[2];
#pragma unroll
        for (int n = 0; n < 2; ++n) { bgv[n] = *(const f32x4*)(bg + 4 * n); buv[n] = *(const f32x4*)(bg + DFF + 4 * n); }
#pragma unroll
        for (int ai = 0; ai < 2; ++ai)
#pragma unroll
            for (int m = 0; m < 4; ++m) {
                f32x4 o[2];
#pragma unroll
                for (int n = 0; n < 2; ++n) { const f32x4 gq = acc[ai][0][m][n] + bgv[n], uq = acc[ai][1][m][n] + buv[n];
#pragma unroll
                    for (int j = 0; j < 4; ++j) { const float g = fminf(gq[j], 7.0f), uu = fminf(fmaxf(uq[j], -7.0f), 7.0f);
                        const float sg = __builtin_amdgcn_rcpf(1.0f + __builtin_amdgcn_exp2f(-1.702f * LOG2E * g)); o[n][j] = (uu + 1.0f) * (g * sg); } }
                u32x4 w; w.x = cvt_pk_bf16(o[0][0], o[0][1]); w.y = cvt_pk_bf16(o[0][2], o[0][3]); w.z = cvt_pk_bf16(o[1][0], o[1][1]); w.w = cvt_pk_bf16(o[1][2], o[1][3]);
                *(u32x4*)(act + (size_t)(row0 + ai * HALF + m * 16) * DFF + ff0) = w; }
    }
};
struct EpiDown {
    static constexpr bool PERM = true, AFTER_DRAIN = false;
    bf16_t* y; const float* bias;
    __device__ __forceinline__ void operator()(const f32x4 (&acc)[2][2][4][2], const Unit& u, int wr, int wc, int fr, int fq) const {
        const int row0 = u.pm * BM + wr * 64 + fr, col0 = u.pn * BM + wc * 32 + 8 * fq;
        const float* bb = bias + (size_t)u.e * D + col0;
        f32x4 bv[2][2];
#pragma unroll
        for (int bj = 0; bj < 2; ++bj)
#pragma unroll
            for (int n = 0; n < 2; ++n) bv[bj][n] = *(const f32x4*)(bb + bj * HALF + 4 * n);
#pragma unroll
        for (int ai = 0; ai < 2; ++ai)
#pragma unroll
            for (int m = 0; m < 4; ++m) { bf16_t* rowp = y + (size_t)(row0 + ai * HALF + m * 16) * D + col0;
#pragma unroll
                for (int bj = 0; bj < 2; ++bj) { const f32x4 v0 = acc[ai][bj][m][0] + bv[bj][0], v1 = acc[ai][bj][m][1] + bv[bj][1];
                    u32x4 w; w.x = cvt_pk_bf16(v0[0], v0[1]); w.y = cvt_pk_bf16(v0[2], v0[3]); w.z = cvt_pk_bf16(v1[0], v1[1]); w.w = cvt_pk_bf16(v1[2], v1[3]);
                    *(u32x4*)(rowp + bj * HALF) = w; } }
    }
};

__device__ __forceinline__ unsigned pk4_f8(float a, float b, float c, float d) { int r = __builtin_amdgcn_cvt_pk_fp8_f32(a, b, 0, false); r = __builtin_amdgcn_cvt_pk_fp8_f32(c, d, r, true); return (unsigned)r; }
typedef unsigned u32x2 __attribute__((ext_vector_type(2)));
struct EpiSwiglu8 {
    static constexpr bool PERM = true, AFTER_DRAIN = false;
    unsigned char* act; const float* bias;
    __device__ __forceinline__ void operator()(const f32x4 (&acc)[2][2][4][2], const Unit& u, int wr, int wc, int fr, int fq) const {
        const int row0 = u.pm * BM + wr * 64 + fr, ff0 = u.pn * HALF + wc * 32 + 8 * fq;
        const float* bg = bias + (size_t)u.e * 2 * DFF + ff0;
        f32x4 bgv[2], buv[2];
#pragma unroll
        for (int n = 0; n < 2; ++n) { bgv[n] = *(const f32x4*)(bg + 4 * n); buv[n] = *(const f32x4*)(bg + DFF + 4 * n); }
#pragma unroll
        for (int ai = 0; ai < 2; ++ai)
#pragma unroll
            for (int m = 0; m < 4; ++m) {
                f32x4 o[2];
#pragma unroll
                for (int n = 0; n < 2; ++n) { const f32x4 gq = acc[ai][0][m][n] * (1.0f / WSCALE) + bgv[n], uq = acc[ai][1][m][n] * (1.0f / WSCALE) + buv[n];
#pragma unroll
                    for (int j = 0; j < 4; ++j) { const float g = fminf(gq[j], 7.0f), uu = fminf(fmaxf(uq[j], -7.0f), 7.0f);
                        const float sg = __builtin_amdgcn_rcpf(1.0f + __builtin_amdgcn_exp2f(-1.702f * LOG2E * g)); o[n][j] = (uu + 1.0f) * (g * sg); } }
                u32x2 w; w.x = pk4_f8(o[0][0], o[0][1], o[0][2], o[0][3]); w.y = pk4_f8(o[1][0], o[1][1], o[1][2], o[1][3]);
                *(u32x2*)(act + (size_t)(row0 + ai * HALF + m * 16) * DFF + ff0) = w;
                asm volatile("" ::: "memory"); }
    }
};
struct EpiDown8 {
    static constexpr bool PERM = true, AFTER_DRAIN = false;
    unsigned char* y; const float* bias;
    __device__ __forceinline__ void operator()(const f32x4 (&acc)[2][2][4][2], const Unit& u, int wr, int wc, int fr, int fq) const {
        const int row0 = u.pm * BM + wr * 64 + fr, col0 = u.pn * BM + wc * 32 + 8 * fq;
        const float* bb = bias + (size_t)u.e * D + col0;
        f32x4 bv[2][2];
#pragma unroll
        for (int bj = 0; bj < 2; ++bj)
#pragma unroll
            for (int n = 0; n < 2; ++n) bv[bj][n] = *(const f32x4*)(bb + bj * HALF + 4 * n) * YSCALE;
#pragma unroll
        for (int ai = 0; ai < 2; ++ai)
#pragma unroll
            for (int m = 0; m < 4; ++m) { unsigned char* rowp = y + (size_t)(row0 + ai * HALF + m * 16) * D + col0;
#pragma unroll
                for (int bj = 0; bj < 2; ++bj) { const f32x4 v0 = acc[ai][bj][m][0] * (YSCALE / WSCALE) + bv[bj][0], v1 = acc[ai][bj][m][1] * (YSCALE / WSCALE) + bv[bj][1];
                    u32x2 w; w.x = pk4_f8(v0[0], v0[1], v0[2], v0[3]); w.y = pk4_f8(v1[0], v1[1], v1[2], v1[3]);
                    *(u32x2*)(rowp + bj * HALF) = w; }
                asm volatile("" ::: "memory"); }
    }
};

__device__ __forceinline__ void glds16_s(const char* sbase, unsigned voff, unsigned lds_dst) { unsigned keep;
    asm volatile("s_mov_b32 %0, m0\n\ts_mov_b32 m0, %3\n\ts_nop 0\n\tglobal_load_lds_dwordx4 %1, %2\n\ts_mov_b32 m0, %0" : "=&s"(keep) : "v"(voff), "s"(sbase), "s"(lds_dst) : "memory"); }
template <class Epi, class Sched, bool ALIGN_EPI = false, bool SP2 = false, bool F8 = false>
__device__ __forceinline__ void gemm_phase(PG8_LAS unsigned char* lds, const Gemm g, const Sched& S, const Epi& E) {
    int tid_ = threadIdx.x; asm volatile("" : "+v"(tid_));
    const int tid = tid_, wid = __builtin_amdgcn_readfirstlane(tid >> 6), lane = tid & 63, wr = wid >> 2, wc = wid & 3, fr = lane & 15, fq = lane >> 4;
    const int K = g.K, nt = K / BK;
    unsigned voffA[2], voffB[2];
#pragma unroll
    for (int i = 0; i < 2; ++i) { int R, C; stage_rc(tid * 16 + i * 8192, R, C); const int Rb = Epi::PERM ? ((R & ~31) + perm32(R & 31)) : R;
        voffA[i] = (unsigned)(R * K + C) * 2u; voffB[i] = (unsigned)(Rb * K + C) * 2u; }
#define PG8_STAGE_A(bufoff, kptr, UI, U, H) do { const char* _gb = (kptr) + S.abase(U, H, K); _Pragma("unroll") for (int _i = 0; _i < 2; ++_i) \
        glds16_s(_gb, S.alane(UI, U, H, _i, voffA[_i], K), ldsbase + (unsigned)((bufoff) + _i * 8192)); } while (0)
    const size_t kstep = (size_t)(BK * 2);
    const size_t hstep = (size_t)HALF * K * 2;
    const size_t tstep = 2 * hstep;
    const unsigned ldsw = (unsigned)wid * 1024u;
    const unsigned ldsbase = (unsigned)__builtin_amdgcn_readfirstlane((int)((unsigned)(size_t)lds + ldsw));
    const int aoff = lds_byte(wr * 64 + fr, fq * 8), boff = lds_byte(wc * 32 + fr, fq * 8);
#define PG8_SA(b, h) (((b) * 2 + (h)) * HTB)
#define PG8_SB(b, h) ((4 + (b) * 2 + (h)) * HTB)
#define PG8_STAGE(bufoff, gbase, voff) do { _Pragma("unroll") for (int _i = 0; _i < 2; ++_i) \
        glds16_s((const char*)(gbase), (voff)[_i], ldsbase + (unsigned)((bufoff) + _i * 8192)); } while (0)
#define PG8_LDA(dst, b, h) do { _Pragma("unroll") for (int m = 0; m < 4; ++m) _Pragma("unroll") for (int k = 0; k < 2; ++k) dst[m][k] = *(const PG8_LAS bf16x8*)(lds + PG8_SA(b, h) + aoff + m * 2048 + k * 1024); } while (0)
#define PG8_LDB(dst, b, h) do { _Pragma("unroll") for (int n = 0; n < 2; ++n) _Pragma("unroll") for (int k = 0; k < 2; ++k) dst[n][k] = *(const PG8_LAS bf16x8*)(lds + PG8_SB(b, h) + boff + n * 2048 + k * 1024); } while (0)
#define PG8_CAT(x) __builtin_shufflevector(__builtin_bit_cast(v4i_t, x[0]), __builtin_bit_cast(v4i_t, x[1]), 0, 1, 2, 3, 4, 5, 6, 7)
#define PG8_MMA(ai, bj, At, Bt) do { __builtin_amdgcn_s_setprio(1); _Pragma("unroll") for (int m = 0; m < 4; ++m) _Pragma("unroll") for (int n = 0; n < 2; ++n) { \
        if constexpr (F8) { acc[ai][bj][m][n] = __builtin_amdgcn_mfma_scale_f32_16x16x128_f8f6f4(PG8_CAT(Bt[n]), PG8_CAT(At[m]), acc[ai][bj][m][n], 0, 0, 0, 0, 0, 0); } \
        else { _Pragma("unroll") for (int k = 0; k < 2; ++k) acc[ai][bj][m][n] = __builtin_amdgcn_mfma_f32_16x16x32_bf16(Bt[n][k], At[m][k], acc[ai][bj][m][n], 0, 0, 0); } } \
        __builtin_amdgcn_s_setprio(0); } while (0)
#define PG8_WAIT_V(n) asm volatile("s_waitcnt vmcnt(" #n ")" ::: "memory")
#define PG8_WAIT_L(n) asm volatile("s_waitcnt lgkmcnt(" #n ")" ::: "memory")
#define PG8_BAR __builtin_amdgcn_s_barrier()
#define PG8_SCHED __builtin_amdgcn_sched_barrier(0)
    Unit cur, nxt; int ui = 0;
    if (!S.next(0, cur)) return;
    f32x4 acc[2][2][4][2];
#pragma unroll
    for (int a = 0; a < 2; ++a)
#pragma unroll
        for (int b = 0; b < 2; ++b)
#pragma unroll
            for (int m = 0; m < 4; ++m)
#pragma unroll
                for (int n = 0; n < 2; ++n) acc[a][b][m][n] = (f32x4){0.f, 0.f, 0.f, 0.f};
    bf16x8 At[4][2], B0[2][2], B1[2][2];
    const char* const A0 = (const char*)g.A; const char* cB = (const char*)g.Bt + S.bbase(cur, tstep);

    S.a_ready(cur);
    if constexpr (SP2) {
        PG8_STAGE(PG8_SB(0, 0), cB, voffB); PG8_STAGE(PG8_SB(0, 1), cB + hstep, voffB); PG8_STAGE_A(PG8_SA(0, 0), A0, 0, cur, 0); PG8_STAGE_A(PG8_SA(0, 1), A0, 0, cur, 1);
        if (wr == 1) PG8_BAR;
        PG8_WAIT_V(2); PG8_BAR;
        PG8_STAGE(PG8_SB(1, 0), cB + kstep, voffB); PG8_STAGE_A(PG8_SA(1, 0), A0 + kstep, 0, cur, 0); PG8_STAGE(PG8_SB(1, 1), cB + hstep + kstep, voffB);
        PG8_WAIT_V(6); PG8_BAR;
    } else {
        PG8_STAGE(PG8_SB(0, 0), cB, voffB); PG8_STAGE_A(PG8_SA(0, 0), A0, 0, cur, 0); PG8_STAGE(PG8_SB(0, 1), cB + hstep, voffB); PG8_STAGE_A(PG8_SA(0, 1), A0, 0, cur, 1);
        if (wr == 1) PG8_BAR;
        PG8_WAIT_V(4); PG8_BAR;
        PG8_STAGE(PG8_SB(1, 0), cB + kstep, voffB); PG8_STAGE_A(PG8_SA(1, 0), A0 + kstep, 0, cur, 0); PG8_STAGE(PG8_SB(1, 1), cB + hstep + kstep, voffB);
        PG8_WAIT_V(6); PG8_BAR;
    }
    for (;;) {
        const bool has_next = S.next(ui + 1, nxt);
        const char* nB = has_next ? (const char*)g.Bt + S.bbase(nxt, tstep) : cB;
        if (!has_next) nxt = cur;
        const int nui = has_next ? ui + 1 : ui;
#pragma unroll 1
        for (int t = 0; t < nt; t += 2) {
            const bool last = (t == nt - 2);
            const char* a1 = A0 + (size_t)(t + 1) * kstep;
            const char* a2 = last ? A0 : A0 + (size_t)(t + 2) * kstep; const char* b2 = last ? nB : cB + (size_t)(t + 2) * kstep;
            const int lui = last ? nui : ui; Unit lu; lu.pm = last ? nxt.pm : cur.pm; lu.pn = last ? nxt.pn : cur.pn; lu.e = last ? nxt.e : cur.e;
            const char* a3 = a2 + kstep; const char* b3 = b2 + kstep;
            if (last && has_next) S.a_ready(nxt);
            if constexpr (SP2) {
            PG8_LDB(B0, 0, 0); PG8_LDB(B1, 0, 1); PG8_SCHED; PG8_LDA(At, 0, 0); PG8_STAGE_A(PG8_SA(1, 1), a1, ui, cur, 1);
            PG8_WAIT_V(8); PG8_WAIT_L(0); PG8_BAR; PG8_MMA(0, 0, At, B0); PG8_MMA(0, 1, At, B1); PG8_BAR; PG8_SCHED;
            PG8_LDA(At, 0, 1); PG8_STAGE(PG8_SB(0, 0), b2, voffB); PG8_STAGE(PG8_SB(0, 1), b2 + hstep, voffB); PG8_STAGE_A(PG8_SA(0, 0), a2, lui, lu, 0);
            PG8_WAIT_V(8); PG8_WAIT_L(0); PG8_BAR; PG8_MMA(1, 0, At, B0); PG8_MMA(1, 1, At, B1); PG8_BAR; PG8_SCHED;
            PG8_LDB(B0, 1, 0); PG8_LDB(B1, 1, 1); PG8_SCHED; PG8_LDA(At, 1, 0); PG8_STAGE_A(PG8_SA(0, 1), a2, lui, lu, 1);
            PG8_WAIT_V(8); PG8_WAIT_L(0); PG8_BAR; PG8_MMA(0, 0, At, B0); PG8_MMA(0, 1, At, B1); PG8_BAR; PG8_SCHED;
            PG8_LDA(At, 1, 1); PG8_STAGE(PG8_SB(1, 0), b3, voffB); PG8_STAGE(PG8_SB(1, 1), b3 + hstep, voffB); PG8_STAGE_A(PG8_SA(1, 0), a3, lui, lu, 0);
            PG8_WAIT_V(8); PG8_WAIT_L(0); PG8_BAR; PG8_MMA(1, 0, At, B0); PG8_MMA(1, 1, At, B1); PG8_BAR; PG8_SCHED;
            } else {
            PG8_LDB(B0, 0, 0); PG8_SCHED; PG8_LDA(At, 0, 0); PG8_STAGE_A(PG8_SA(1, 1), a1, ui, cur, 1);
            PG8_WAIT_L(8); PG8_BAR; PG8_WAIT_L(0); PG8_MMA(0, 0, At, B0); PG8_BAR; PG8_SCHED;
            PG8_LDB(B1, 0, 1); PG8_STAGE(PG8_SB(0, 0), b2, voffB);
            PG8_BAR; PG8_WAIT_L(0); PG8_MMA(0, 1, At, B1); PG8_BAR;
            PG8_LDA(At, 0, 1); PG8_STAGE_A(PG8_SA(0, 0), a2, lui, lu, 0);
            PG8_BAR; PG8_WAIT_L(0); PG8_MMA(1, 0, At, B0); PG8_BAR; PG8_SCHED;
            PG8_STAGE(PG8_SB(0, 1), b2 + hstep, voffB);
            PG8_WAIT_V(6); PG8_BAR; PG8_MMA(1, 1, At, B1); PG8_BAR;
            PG8_LDB(B0, 1, 0); PG8_SCHED; PG8_LDA(At, 1, 0); PG8_STAGE_A(PG8_SA(0, 1), a2, lui, lu, 1);
            PG8_WAIT_L(8); PG8_BAR; PG8_WAIT_L(0); PG8_MMA(0, 0, At, B0); PG8_BAR; PG8_SCHED;
            PG8_LDB(B1, 1, 1); PG8_STAGE(PG8_SB(1, 0), b3, voffB);
            PG8_BAR; PG8_WAIT_L(0); PG8_MMA(0, 1, At, B1); PG8_BAR;
            PG8_LDA(At, 1, 1); PG8_STAGE_A(PG8_SA(1, 0), a3, lui, lu, 0);
            PG8_BAR; PG8_WAIT_L(0); PG8_MMA(1, 0, At, B0); PG8_BAR; PG8_SCHED;
            PG8_STAGE(PG8_SB(1, 1), b3 + hstep, voffB);
            PG8_WAIT_V(6); PG8_BAR; PG8_MMA(1, 1, At, B1); PG8_BAR;
            }
        }
        if constexpr (ALIGN_EPI) { if (wr == 0) PG8_BAR; }
        if constexpr (!Epi::AFTER_DRAIN) { E(acc, cur, wr, wc, fr, fq); S.done(cur); }
        if (!has_next) break;
#pragma unroll
        for (int a = 0; a < 2; ++a)
#pragma unroll
            for (int b = 0; b < 2; ++b)
#pragma unroll
                for (int m = 0; m < 4; ++m)
#pragma unroll
                    for (int n = 0; n < 2; ++n) acc[a][b][m][n] = (f32x4){0.f, 0.f, 0.f, 0.f};
        cur = nxt; cB = nB; ++ui;
        if constexpr (ALIGN_EPI) { if (wr == 1) PG8_BAR; }
    }
    PG8_WAIT_V(0);
    if constexpr (!ALIGN_EPI) { if (wr == 0) PG8_BAR; }
    PG8_BAR;
    if constexpr (Epi::AFTER_DRAIN) { E.fused(acc, cur, wr, wc, fr, fq, lds, wid, lane); S.done(cur); }
#undef PG8_STAGE_A
#undef PG8_SA
#undef PG8_SB
#undef PG8_STAGE
#undef PG8_LDA
#undef PG8_LDB
#undef PG8_MMA
#undef PG8_CAT
#undef PG8_WAIT_V
#undef PG8_WAIT_L
#undef PG8_BAR
#undef PG8_SCHED
}
}

constexpr size_t MiB = 1u << 20;
constexpr size_t WS_CTL = 0, CTL_ZERO_BYTES = 1 * MiB;
constexpr size_t WS_MODP = 1 * MiB;
constexpr size_t WS_MODF = 3 * MiB;
constexpr size_t WS_BIAS = 4 * MiB;
constexpr size_t WS_TOKE = 5 * MiB;
constexpr size_t WS_TOKP = 6 * MiB;
constexpr size_t WS_CNTC = 5 * MiB + 512 * 1024;
constexpr size_t WS_TOKW = 7 * MiB;
constexpr size_t WS_INV = 8 * MiB;
constexpr size_t WS_WIN = 10 * MiB;
constexpr size_t WS_WOUT = 15 * MiB;
constexpr size_t WS_X1 = 32 * MiB;
constexpr size_t WS_XN = 96 * MiB;
constexpr size_t WS_H2 = 128 * MiB;
constexpr size_t WS_PROJ = 160 * MiB;
constexpr size_t WS_O = 232 * MiB;
constexpr size_t WS_WGU = 264 * MiB;
constexpr size_t WS_WD = 392 * MiB;
constexpr size_t WS_ACT = 456 * MiB;
constexpr size_t WS_Y = 600 * MiB;
constexpr size_t WS_END = 744 * MiB;
constexpr int CW_TMO = 0, CW_CODE = 1;
constexpr int CW_CNT = 64;
constexpr int CW_BAR = 4096;
constexpr int CW_KSUM = 16384;
static_assert((CW_KSUM + 64 * 512) * 4 <= (int)CTL_ZERO_BYTES, "CTL region");
constexpr int RING_OFF = 0, RING_BYTES = 131072;
constexpr int LDSCTL_OFF = RING_BYTES, MISC_OFF = LDSCTL_OFF + 320;
constexpr int LDS_TILE_E = LDSCTL_OFF + 512;
constexpr int LDS_NT = LDS_TILE_E + MAXTILES * 4;
constexpr int LDS_TBASE = LDS_NT + 16;
constexpr int LDS_CNTE = LDS_TBASE + 128;
constexpr int LDS_RIDX = LDS_CNTE + 128;
constexpr int LDS_BYTES = 147456;
static_assert(LDS_RIDX % 16 == 0 && LDS_RIDX + 10 * 1024 <= LDS_BYTES, "LDS map");
constexpr int NWAVES = 8;

#define GAS __attribute__((address_space(1)))
#define LAS __attribute__((address_space(3)))
typedef unsigned short bf16;
typedef unsigned v4u __attribute__((ext_vector_type(4)));
typedef float f32x4 __attribute__((ext_vector_type(4)));
typedef short bf16x8 __attribute__((ext_vector_type(8)));
typedef GAS unsigned gu32;
typedef GAS unsigned long long gu64;
#define RLX_AGENT __ATOMIC_RELAXED, __HIP_MEMORY_SCOPE_AGENT
#define LDS_WAIT() asm volatile("s_waitcnt lgkmcnt(0)" ::: "memory")
#define VM_WAIT() asm volatile("s_waitcnt vmcnt(0)" ::: "memory")
__device__ __forceinline__ unsigned long long rt() { return __builtin_amdgcn_s_memrealtime(); }
__device__ __forceinline__ unsigned f2bf(float f) { unsigned u = __builtin_bit_cast(unsigned, f); return (u + 0x7fffu + ((u >> 16) & 1u)) >> 16; }
__device__ __forceinline__ unsigned pk2(float lo, float hi) { return f2bf(lo) | (f2bf(hi) << 16); }

#define XB_TMO      128
#define XB_XCNT(j)  (256  + 64 * (j))
#define XB_XSUB(j)  (1280 + 64 * (j))
#define XB_XGEN(j)  (2304 + 64 * (j))
#define XB_TOP      3328
#define XB_TOPGEN   3392
#define XCD_BAR_WORDS 3456
#define XB_SPIN_CAP (1u << 18)

__device__ __forceinline__ unsigned xb_ld(unsigned* p)              { return __hip_atomic_load(p, __ATOMIC_RELAXED, __HIP_MEMORY_SCOPE_AGENT); }
__device__ __forceinline__ unsigned xb_add(unsigned* p, unsigned v) { return __hip_atomic_fetch_add(p, v, __ATOMIC_RELAXED, __HIP_MEMORY_SCOPE_AGENT); }
__device__ __forceinline__ unsigned xb_xcc_id() { return (unsigned)__builtin_amdgcn_s_getreg((3 << 11) | 20) & 0xFu; }
#define XB_SPIN(cond, bar) do { unsigned _sp = 0; while (cond) { __builtin_amdgcn_s_sleep(1); \
    if ((++_sp & 255u) == 0u) { if (xb_ld(&(bar)[XB_TMO])) break; if (_sp > XB_SPIN_CAP) { atomicAdd(&(bar)[XB_TMO], 1u); break; } } } } while (0)

struct XcdBarrier {
    unsigned* bar; unsigned x;
    volatile LAS unsigned* st;
};

__device__ __forceinline__ XcdBarrier xcd_barrier_post(unsigned* bar, volatile LAS unsigned* st) {
    XcdBarrier b; b.bar = bar; b.x = xb_xcc_id(); b.st = st;
    if (threadIdx.x == 0) (void)xb_add(&bar[XB_XCNT(b.x)], 1u);
    return b;
}
__device__ __forceinline__ void xcd_barrier_complete(unsigned* bar, unsigned x, unsigned& nloc, unsigned& nx) {
    const unsigned G = gridDim.x * gridDim.y * gridDim.z;
    unsigned sum, cnt, mine, sp = 0u;
    for (;;) {
        sum = 0u; cnt = 0u; mine = 0u;
#pragma unroll
        for (unsigned j = 0; j < 16; ++j) { const unsigned c = xb_ld(&bar[XB_XCNT(j)]); sum += c; cnt += (c > 0u) ? 1u : 0u; mine = (j == x) ? c : mine; }
        if (sum == G) break;
        __builtin_amdgcn_s_sleep(1);
        if ((++sp & 255u) == 0u) { if (xb_ld(&bar[XB_TMO])) break; if (sp > XB_SPIN_CAP) { atomicAdd(&bar[XB_TMO], 1u); break; } }
    }
    nloc = mine > 0u ? mine : 1u; nx = cnt > 0u ? cnt : 1u;
}

__device__ __forceinline__ void xcd_barrier(const XcdBarrier& b) {
    asm volatile("s_waitcnt vmcnt(0)" ::: "memory");
    __syncthreads();
    if (threadIdx.x == 0) {
        unsigned* bar = b.bar;
        __builtin_amdgcn_s_waitcnt(0);
        unsigned nloc = b.st[0], nx = b.st[1];
        if (nloc == 0u) { xcd_barrier_complete(bar, b.x, nloc, nx); b.st[0] = nloc; b.st[1] = nx; }
        const unsigned old = xb_add(&bar[XB_XSUB(b.x)], 1u);
        const unsigned gen = old / nloc;
        if (old + 1u == (gen + 1u) * nloc) {
            __builtin_amdgcn_fence(__ATOMIC_RELEASE, "agent");
            asm volatile("s_waitcnt vmcnt(0)" ::: "memory");
            const unsigned og = xb_add(&bar[XB_TOP], 1u);
            const unsigned tg = og / nx;
            if (og + 1u == (tg + 1u) * nx) xb_add(&bar[XB_TOPGEN], 1u);
            else XB_SPIN(xb_ld(&bar[XB_TOPGEN]) == tg, bar);
            __builtin_amdgcn_fence(__ATOMIC_ACQUIRE, "agent");
            xb_add(&bar[XB_XGEN(b.x)], 1u);
            asm volatile("s_waitcnt vmcnt(0)" ::: "memory");
        } else {
            XB_SPIN(xb_ld(&bar[XB_XGEN(b.x)]) == gen, bar);
            __builtin_amdgcn_fence(__ATOMIC_ACQUIRE, "agent");
            asm volatile("s_waitcnt vmcnt(0)" ::: "memory");
        }
    }
    __syncthreads();
}

namespace att {
using bf16x8 = __attribute__((ext_vector_type(8))) short;
using s16x4 = __attribute__((ext_vector_type(4))) short;
using f32x16 = __attribute__((ext_vector_type(16))) float;
using u32x4 = __attribute__((ext_vector_type(4))) unsigned;
typedef unsigned short bf16;
constexpr int PITCH = D_IN, OPITCH = D;
constexpr int NSLOT = 4, SLOTB = 8192;
constexpr int TAB_PAD = 96;
constexpr int LDS_K = 0, LDS_V = NSLOT * SLOTB, LDS_WS = 2 * NSLOT * SLOTB, LDS_OST = LDS_WS + 8 * 64 * 4, LDS_TAB = LDS_OST + 8 * 4096, LDS_KMS = LDS_TAB + (TAB_PAD + SEQ) * 4, LDS_NINF = LDS_KMS + 8 * 64 * 4, LDS_END = LDS_NINF + 64 * 4;
static_assert(LDS_END <= 131072, "attention LDS");
__device__ __forceinline__ int crow(int r, int hi) { return (r & 3) + 8 * (r >> 2) + 4 * hi; }
__device__ __forceinline__ void glds16(const void* gsrc, unsigned lds_dst) { unsigned keep;
  asm volatile("s_mov_b32 %0, m0\n\ts_mov_b32 m0, %2\n\ts_nop 0\n\tglobal_load_lds_dwordx4 %1, off\n\ts_mov_b32 m0, %0" : "=&s"(keep) : "v"(gsrc), "s"(lds_dst) : "memory"); }
typedef float f32x2_t __attribute__((ext_vector_type(2))); typedef __bf16 bf16x2_t __attribute__((ext_vector_type(2)));
__device__ __forceinline__ unsigned cvtpk_s(float lo, float hi) { f32x2_t v = {lo, hi}; bf16x2_t b = __builtin_convertvector(v, bf16x2_t); return __builtin_bit_cast(unsigned, b); }
#define ATT_WAIT_BAR(N) asm volatile("s_waitcnt vmcnt(" #N ") lgkmcnt(0)\n\ts_barrier" ::: "memory")
#define ATT_LBAR() asm volatile("s_waitcnt lgkmcnt(0)\n\ts_barrier" ::: "memory")
typedef float f32x2v __attribute__((ext_vector_type(2)));
__device__ __forceinline__ void bias_loads(f32x2v (&bb)[16], unsigned tba) {
#pragma unroll
  for (int i = 0; i < 16; ++i) { asm volatile("ds_read2_b32 %0, %1 offset0:%c2 offset1:%c3" : "=v"(bb[i]) : "v"(tba), "i"((i >> 3) * 32 + ((2 * i) & 3) + 8 * (((2 * i) & 15) >> 2)), "i"((i >> 3) * 32 + ((2 * i) & 3) + 8 * (((2 * i) & 15) >> 2) + 1) : "memory"); }
}
__device__ __forceinline__ void k_loads(bf16x8 (&kf)[8], unsigned ka) {
#pragma unroll
  for (int i = 0; i < 8; ++i) asm volatile("ds_read_b128 %0, %1 offset:%c2" : "=v"(kf[i]) : "v"(ka), "i"((i >> 1) * 2048 + (i & 1) * 512) : "memory");
}
#define ATT_C16(bb, o) (f32x16){bb[o][0], bb[o][1], bb[o + 1][0], bb[o + 1][1], bb[o + 2][0], bb[o + 2][1], bb[o + 3][0], bb[o + 3][1], bb[o + 4][0], bb[o + 4][1], bb[o + 5][0], bb[o + 5][1], bb[o + 6][0], bb[o + 6][1], bb[o + 7][0], bb[o + 7][1]}
__device__ __forceinline__ void qk_mma(f32x16& p0, f32x16& p1, const bf16x8 (&kf)[8], const bf16x8* qr, const f32x2v (&bb)[16]) {
  p0 = __builtin_amdgcn_mfma_f32_32x32x16_bf16(kf[0], qr[0], ATT_C16(bb, 0), 0, 0, 0); p1 = __builtin_amdgcn_mfma_f32_32x32x16_bf16(kf[1], qr[0], ATT_C16(bb, 8), 0, 0, 0);
#pragma unroll
  for (int d0 = 1; d0 < 4; ++d0) { p0 = __builtin_amdgcn_mfma_f32_32x32x16_bf16(kf[2 * d0], qr[d0], p0, 0, 0, 0); p1 = __builtin_amdgcn_mfma_f32_32x32x16_bf16(kf[2 * d0 + 1], qr[d0], p1, 0, 0, 0); }
}
__device__ __forceinline__ void v_loads(s16x4 (&lo)[2][4], s16x4 (&hi)[2][4], int vb) {
#pragma unroll
  for (int d0 = 0; d0 < 2; ++d0)
#pragma unroll
    for (int ks = 0; ks < 4; ++ks) {
      asm volatile("ds_read_b64_tr_b16 %0,%1 offset:%c2" : "=&v"(lo[d0][ks]) : "v"(vb), "i"(d0 * 4096 + ks * 1024) : "memory");
      asm volatile("ds_read_b64_tr_b16 %0,%1 offset:%c2" : "=&v"(hi[d0][ks]) : "v"(vb), "i"(d0 * 4096 + ks * 1024 + 512) : "memory"); }
}
__device__ __forceinline__ void pv_mma(f32x16* o, const s16x4 (&lo)[2][4], const s16x4 (&hi)[2][4], bf16x8 pa0, bf16x8 pa1, bf16x8 pa2, bf16x8 pa3) {
#define ATT_PK(d, k) (bf16x8){lo[d][k][0], lo[d][k][1], lo[d][k][2], lo[d][k][3], hi[d][k][0], hi[d][k][1], hi[d][k][2], hi[d][k][3]}
#pragma unroll
  for (int d0 = 0; d0 < 2; ++d0) {
    o[d0] = __builtin_amdgcn_mfma_f32_32x32x16_bf16(pa0, ATT_PK(d0, 0), o[d0], 0, 0, 0);
    o[d0] = __builtin_amdgcn_mfma_f32_32x32x16_bf16(pa1, ATT_PK(d0, 1), o[d0], 0, 0, 0);
    o[d0] = __builtin_amdgcn_mfma_f32_32x32x16_bf16(pa2, ATT_PK(d0, 2), o[d0], 0, 0, 0);
    o[d0] = __builtin_amdgcn_mfma_f32_32x32x16_bf16(pa3, ATT_PK(d0, 3), o[d0], 0, 0, 0);
  }
#undef ATT_PK
}
#define ATT_LWAIT(N) do { asm volatile("s_waitcnt lgkmcnt(" #N ")" ::: "memory"); __builtin_amdgcn_sched_barrier(0); } while (0)
struct UnitDesc { int b, qb, moba, qcol, kcol, vcol, ocol, head, fill, fillk, gqa, q0; float sink2; };

__device__ __forceinline__ void attn_unit(const UnitDesc& u, const bf16* P, bf16* O, const float* biasT, const float* ksum, const float* sinks, char* shm) {
  int tid_ = threadIdx.x; asm volatile("" : "+v"(tid_));
  const int tid = tid_, lane = tid & 63, r32 = lane & 31, hi = lane >> 5; const int wid = __builtin_amdgcn_readfirstlane(tid >> 6);
  const long rowbase = (long)u.b * SEQ; const int q0 = u.q0;
  const int wg = u.gqa ? (wid & 3) : 0, wrow = u.gqa ? (wid >> 2) * 32 : wid * 32;
  constexpr int TSW = TAB_PAD + 192;
  const unsigned lds0 = (unsigned)(uintptr_t)shm;
  float* wsf = (float*)(shm + LDS_WS) + wid * 64;
  float* tab = (float*)(shm + LDS_TAB); float* kms = (float*)(shm + LDS_KMS);
  const int tlo = u.moba ? 0 : (q0 < 128 ? 0 : (q0 >> 6) - 2), thi = u.gqa ? (q0 >> 6) : u.qb * 4 + 3;
  const bf16* ksrc = P + (rowbase + lane) * PITCH + u.kcol + wid * 8;
  const bf16* vsrc = P + (rowbase + 16 * (wid & 3) + (lane >> 2)) * PITCH + u.vcol + (wid >> 2) * 32 + (lane & 3) * 8;
  const unsigned kdst = lds0 + LDS_K + wid * 1024, vdst = lds0 + LDS_V + wid * 1024;
#define ATT_DMA(t, slot) do { glds16(ksrc + (long)(t) * 64 * PITCH, (unsigned)__builtin_amdgcn_readfirstlane(kdst + (slot))); glds16(vsrc + (long)(t) * 64 * PITCH, (unsigned)__builtin_amdgcn_readfirstlane(vdst + (slot))); } while (0)
  const unsigned ka0 = lds0 + LDS_K + hi * 1024 + r32 * 16;
  const int vb0 = (int)(lds0 + LDS_V) + ((lane >> 4) & 1) * 32 + (lane & 3) * 8 + (4 * hi + ((lane & 15) >> 2)) * 64;
  ATT_DMA(tlo, 0); ATT_DMA(tlo + 1, SLOTB);
  if (u.fill) {
    if (u.gqa) { for (int i = tid; i < 4 * TSW; i += 512) { const int hh = i / TSW, j = i - hh * TSW; tab[i] = (j >= 192) ? 0.f : biasT[(u.head + hh) * SEQ + 191 - j]; } }
    else for (int i = tid; i < TAB_PAD + SEQ; i += 512) tab[i] = (i >= SEQ) ? 0.f : biasT[u.head * SEQ + SEQ - 1 - i];
    if (tid < 64) ((float*)(shm + LDS_NINF))[tid] = -INFINITY;
  }
  if (u.fillk) kms[tid] = ksum[(size_t)(u.b * 8 + (tid >> 6)) * D_MOBA + u.head * HD + (tid & 63)];
  const bf16* Qw = P + (rowbase + q0 + wrow) * PITCH + u.qcol + wg * HD;
  bf16x8 qr[4];
#pragma unroll
  for (int d0 = 0; d0 < 4; ++d0) qr[d0] = *reinterpret_cast<const bf16x8*>(&Qw[(long)r32 * PITCH + d0 * 16 + hi * 8]);
  if (u.fill || u.fillk) ATT_LBAR();
  unsigned selmask = 0u;
  if (u.moba) {
    if (u.qb <= MB_TOPK) selmask = (1u << u.qb) - 1u;
    else {
      float gate[MB_NB - 1];
#pragma unroll
      for (int n = 0; n < MB_NB - 1; ++n) { float s = 0.f;
        if (n < u.qb) {
#pragma unroll
          for (int d0 = 0; d0 < 4; ++d0)
#pragma unroll
            for (int j = 0; j < 8; ++j) s += __uint_as_float((unsigned)(unsigned short)qr[d0][j] << 16) * kms[n * 64 + d0 * 16 + hi * 8 + j];
          s += __shfl_xor(s, 32); }
        gate[n] = s; }
#pragma unroll
      for (int r = 0; r < MB_TOPK; ++r) { int best = -1; float bv = 0.f;
#pragma unroll
        for (int n = 0; n < MB_NB - 1; ++n) if (n < u.qb && !((selmask >> n) & 1u) && (best < 0 || gate[n] > bv)) { best = n; bv = gate[n]; }
        selmask |= 1u << best; }
    }
  }
  const int qrel = wrow + r32, qpos = q0 + qrel;
  const unsigned tabqa = lds0 + LDS_TAB + (unsigned)((wg * TSW + (u.gqa ? 191 : SEQ - 1) - qpos + 4 * hi) * 4), ninfa = lds0 + LDS_NINF;
  float m = -1e30f, l = 0.f; f32x16 o[2]; o[0] = f32x16{}; o[1] = f32x16{};
  const int wq0 = q0 + wrow;
#define ATT_FLAGS(tt, need_, emask_, lsel_) do { lsel_ = true; \
    if (u.moba) { const int n_ = (tt) >> 2; \
      if (n_ < u.qb) { lsel_ = ((selmask >> n_) & 1u) != 0u; need_ = __any(lsel_); emask_ = false; } \
      else { need_ = (64 * (tt) <= wq0 + 31); emask_ = (64 * (tt) + 63 > wq0); } } \
    else { need_ = (64 * (tt) <= wq0 + 31) && (64 * (tt) + 63 >= wq0 - (SWA_W - 1)); emask_ = (64 * (tt) + 63 > wq0) || (wq0 + 31 - 64 * (tt) >= SWA_W); } } while (0)
#define ATT_QK_LOADS(tt, kslot, lsel_) do { bias_loads(bb, (lsel_) ? tabqa + 256u * (unsigned)(tt) : ninfa); k_loads(kf, ka0 + (kslot)); } while (0)
  const int lim = u.moba ? 0x7fffffff : SWA_W;
  int slotp = 3 * SLOTB, slot = 0, slotn = SLOTB, slotf = 2 * SLOTB;
  f32x16 pc0 = {}, pc1 = {}, pn0 = {}, pn1 = {};
  u32x4 pw0 = {}, pw1 = {}, pw2 = {}, pw3 = {};
  bool needC, emaskC, lselC, needN = false, emaskN = false, lselN = true, needP = false;
  asm volatile("" :: "v"(qr[0]), "v"(qr[1]), "v"(qr[2]), "v"(qr[3]));
  ATT_WAIT_BAR(2);
  ATT_FLAGS(tlo, needC, emaskC, lselC);
  if (needC) { f32x2v bb[16]; bf16x8 kf[8]; ATT_QK_LOADS(tlo, slot, lselC); ATT_LWAIT(0); qk_mma(pc0, pc1, kf, qr, bb); }
  for (int t = tlo; t <= thi; ++t) {
    ATT_WAIT_BAR(0);
    if (t + 2 <= thi) ATT_DMA(t + 2, slotf);
    if (t + 1 <= thi) { ATT_FLAGS(t + 1, needN, emaskN, lselN); } else needN = false;
    if (needN) { f32x2v bb[16]; bf16x8 kf[8]; ATT_QK_LOADS(t + 1, slotn, lselN); ATT_LWAIT(0); qk_mma(pn0, pn1, kf, qr, bb); }
    if (needP) { s16x4 vlo[2][4], vhi[2][4]; v_loads(vlo, vhi, vb0 + slotp); ATT_LWAIT(0); pv_mma(o, vlo, vhi, __builtin_bit_cast(bf16x8, pw0), __builtin_bit_cast(bf16x8, pw1), __builtin_bit_cast(bf16x8, pw2), __builtin_bit_cast(bf16x8, pw3)); }
    __builtin_amdgcn_sched_barrier(0);
    if (needC) {
      f32x16 p0 = pc0, p1 = pc1;
      if (emaskC) { const int dq = qpos - 64 * t - 4 * hi;
#pragma unroll
        for (int r = 0; r < 16; ++r) { const int c = (r & 3) + 8 * (r >> 2);
          p0[r] = ((unsigned)(dq - c) < (unsigned)lim) ? p0[r] : -INFINITY; p1[r] = ((unsigned)(dq - c - 32) < (unsigned)lim) ? p1[r] : -INFINITY; } }
      float rm = fmaxf(p0[0], p1[0]);
#pragma unroll
      for (int r = 1; r < 16; ++r) rm = fmaxf(fmaxf(rm, p0[r]), p1[r]);
      rm = fmaxf(rm, __shfl_xor(rm, 32));
      if (__any(rm > m + 8.0f)) {
        const float mnew = fmaxf(m, rm), alpha = __builtin_amdgcn_exp2f(m - mnew);
        l *= alpha; m = mnew;
        if (hi == 0) wsf[r32] = alpha;
        asm volatile("s_waitcnt lgkmcnt(0)" ::: "memory");
#pragma unroll
        for (int r = 0; r < 16; ++r) { const float f = wsf[crow(r, hi)]; o[0][r] *= f; o[1][r] *= f; }
      }
      float ls = 0.f;
#pragma unroll
      for (int r = 0; r < 16; ++r) { p0[r] = __builtin_amdgcn_exp2f(p0[r] - m); p1[r] = __builtin_amdgcn_exp2f(p1[r] - m); ls += p0[r] + p1[r]; }
      l += ls;
#define ATT_PKW(Pv, B) cvtpk_s(Pv[B], Pv[B + 1])
      pw0 = (u32x4){ATT_PKW(p0, 0), ATT_PKW(p0, 2), ATT_PKW(p0, 4), ATT_PKW(p0, 6)}; pw1 = (u32x4){ATT_PKW(p0, 8), ATT_PKW(p0, 10), ATT_PKW(p0, 12), ATT_PKW(p0, 14)};
      pw2 = (u32x4){ATT_PKW(p1, 0), ATT_PKW(p1, 2), ATT_PKW(p1, 4), ATT_PKW(p1, 6)}; pw3 = (u32x4){ATT_PKW(p1, 8), ATT_PKW(p1, 10), ATT_PKW(p1, 12), ATT_PKW(p1, 14)};
#undef ATT_PKW
    }
    needP = needC; pc0 = pn0; pc1 = pn1; needC = needN; emaskC = emaskN; lselC = lselN;
    { const int s_ = slotp; slotp = slot; slot = slotn; slotn = slotf; slotf = s_; }
  }
  if (needP) { s16x4 vlo[2][4], vhi[2][4]; v_loads(vlo, vhi, vb0 + slotp); ATT_LWAIT(0); pv_mma(o, vlo, vhi, __builtin_bit_cast(bf16x8, pw0), __builtin_bit_cast(bf16x8, pw1), __builtin_bit_cast(bf16x8, pw2), __builtin_bit_cast(bf16x8, pw3)); }
#undef ATT_FLAGS
#undef ATT_QK_LOADS
  l += __shfl_xor(l, 32);
  if (!u.moba) l += __builtin_amdgcn_exp2f((u.gqa ? sinks[u.head - NH_M + wg] * LOG2E : u.sink2) - m);
  if (hi == 0) wsf[32 + r32] = l;
  asm volatile("s_waitcnt lgkmcnt(0)" ::: "memory");
  float rli[16];
#pragma unroll
  for (int r = 0; r < 16; ++r) rli[r] = __builtin_amdgcn_rcpf(wsf[32 + crow(r, hi)]);
  bf16* Ow = O + (rowbase + q0 + wrow) * OPITCH + u.ocol + wg * HD;
  { bf16* stg = (bf16*)(shm + LDS_OST) + wid * 2048;
#pragma unroll
    for (int r = 0; r < 16; ++r) { const int orow = crow(r, hi);
#pragma unroll
      for (int d0 = 0; d0 < 2; ++d0) stg[orow * 64 + d0 * 32 + r32] = (bf16)(cvtpk_s(o[d0][r] * rli[r], 0.f) & 0xffffu); }
    asm volatile("s_waitcnt lgkmcnt(0)" ::: "memory");
#pragma unroll
    for (int i = 0; i < 4; ++i) { const int row = i * 8 + (lane >> 3), ch = lane & 7; const u32x4 v = *(const u32x4*)(stg + row * 64 + ch * 8); *(u32x4*)(Ow + (long)row * OPITCH + ch * 8) = v; } }
  ATT_LBAR();
#undef ATT_DMA
}
}

struct Frame {
    LAS unsigned char* lds;
    volatile LAS unsigned* MISC;
    gu32* ctl;
    int tid, lane, wave, vcu, G;
};
__device__ __forceinline__ float wave_sum(float v) {
#pragma unroll
    for (int o = 1; o < 64; o <<= 1) v += __shfl_xor(v, o);
    return v;
}
__device__ __forceinline__ int rel_bucket(int dist) {
    const int n = dist > 0 ? dist : 0;
    if (n < 16) return n;
    const int th[15] = {21, 27, 35, 46, 59, 77, 99, 128, 166, 216, 280, 363, 470, 609, 790};
    int bk = 16;
#pragma unroll
    for (int i = 0; i < 15; ++i) bk += (n >= th[i]) ? 1 : 0;
    return bk;
}
__device__ __forceinline__ void p0_transpose_item(const float* W, int K, int N, bf16* WT, int k0, int n0, int dst_row0, LAS float* scr, int lane) {
    { float v[32]; const float* wp = W + (size_t)(k0 + (lane >> 5)) * N + n0 + (lane & 31);
#pragma unroll
        for (int i = 0; i < 32; ++i) v[i] = __builtin_nontemporal_load(wp + (size_t)(2 * i) * N);
#pragma unroll
        for (int i = 0; i < 32; ++i) scr[(2 * i + (lane >> 5)) * 33 + (lane & 31)] = v[i]; }
    LDS_WAIT(); asm volatile("" ::: "memory");
    const int c = lane & 7;
#pragma unroll
    for (int j = 0; j < 4; ++j) { const int n = (lane >> 3) + 8 * j; const LAS float* s = scr + (8 * c) * 33 + n;
        v4u o; o.x = pk2(s[0 * 33], s[1 * 33]); o.y = pk2(s[2 * 33], s[3 * 33]); o.z = pk2(s[4 * 33], s[5 * 33]); o.w = pk2(s[6 * 33], s[7 * 33]);
        *(GAS v4u*)(WT + (size_t)(dst_row0 + n) * K + k0 + 8 * c) = o; }
    LDS_WAIT(); asm volatile("" ::: "memory");
}
__device__ __forceinline__ void p0_transpose_item_f8(const float* W, int K, int N, unsigned char* WT, int k0, int n0, int dst_row0, LAS float* scr, int lane) {
    v4u o[2][2];
    const int c = lane & 3;
#pragma unroll
    for (int hf = 0; hf < 2; ++hf) {
        { float v[32]; const float* wp = W + (size_t)(k0 + 64 * hf + (lane >> 5)) * N + n0 + (lane & 31);
#pragma unroll
            for (int i = 0; i < 32; ++i) v[i] = __builtin_nontemporal_load(wp + (size_t)(2 * i) * N);
#pragma unroll
            for (int i = 0; i < 32; ++i) scr[(2 * i + (lane >> 5)) * 33 + (lane & 31)] = v[i]; }
        LDS_WAIT(); asm volatile("" ::: "memory");
#pragma unroll
        for (int j = 0; j < 2; ++j) { const int n = (lane >> 2) + 16 * j; const LAS float* s = scr + (16 * c) * 33 + n;
            o[hf][j].x = pg8::pk4_f8(s[0 * 33] * WSCALE, s[1 * 33] * WSCALE, s[2 * 33] * WSCALE, s[3 * 33] * WSCALE); o[hf][j].y = pg8::pk4_f8(s[4 * 33] * WSCALE, s[5 * 33] * WSCALE, s[6 * 33] * WSCALE, s[7 * 33] * WSCALE);
            o[hf][j].z = pg8::pk4_f8(s[8 * 33] * WSCALE, s[9 * 33] * WSCALE, s[10 * 33] * WSCALE, s[11 * 33] * WSCALE); o[hf][j].w = pg8::pk4_f8(s[12 * 33] * WSCALE, s[13 * 33] * WSCALE, s[14 * 33] * WSCALE, s[15 * 33] * WSCALE); }
        LDS_WAIT(); asm volatile("" ::: "memory");
    }
#pragma unroll
    for (int j = 0; j < 2; ++j) { const int n = (lane >> 2) + 16 * j; unsigned char* rp = WT + (size_t)(dst_row0 + n) * K + k0 + 16 * c;
        *(GAS v4u*)(rp) = o[0][j]; *(GAS v4u*)(rp + 64) = o[1][j]; }
}
__device__ __forceinline__ void conv_load_half(f32x4 (&x)[16], const float* src, int N, int hf, int lane) {
    const int q = lane >> 4, m = lane & 15; const float* sp = src + (size_t)(hf * 64 + 4 * q) * N + 4 * m;
#pragma unroll
    for (int g = 0; g < 4; ++g)
#pragma unroll
        for (int i = 0; i < 4; ++i) x[g * 4 + i] = __builtin_nontemporal_load((const f32x4*)(sp + (size_t)(16 * g + i) * N));
}
__device__ __forceinline__ void conv_cvt_half(const f32x4 (&x)[16], LAS unsigned* t8, int hf, int lane) {
    const int q = lane >> 4, m = lane & 15;
#pragma unroll
    for (int g = 0; g < 4; ++g)
#pragma unroll
        for (int j = 0; j < 4; ++j) t8[(4 * m + j) * 33 + hf * 16 + 4 * g + q] = pg8::pk4_f8(x[g * 4 + 0][j] * WSCALE, x[g * 4 + 1][j] * WSCALE, x[g * 4 + 2][j] * WSCALE, x[g * 4 + 3][j] * WSCALE);
}
__device__ __forceinline__ void conv_store(unsigned char* dst, const LAS unsigned* t8, int lane) {
#pragma unroll
    for (int jj = 0; jj < 8; ++jj) { const int n = (lane >> 3) + 8 * jj, c = lane & 7; const LAS unsigned* rp = t8 + n * 33 + 4 * c;
        *(GAS v4u*)(dst + (size_t)n * 1024 + 16 * c) = (v4u){rp[0], rp[1], rp[2], rp[3]}; }
}
struct Args { const float* in[19]; float* out; unsigned char* ws; int ph_lo, ph_hi; };

__device__ __forceinline__ void p0_prologue(Frame& F, const Args& a) {
    LAS float* scr = (LAS float*)(F.lds + RING_OFF + F.wave * 16384);
    const int gw = F.vcu * NWAVES + F.wave, NGW = F.G * NWAVES;
    const float* w_in = a.in[5]; const float* w_out = a.in[7];
    bf16* Win_t = (bf16*)(a.ws + WS_WIN); bf16* Wout_t = (bf16*)(a.ws + WS_WOUT);
    constexpr int I_IN = 16 * (D_IN / 32), I_OUT = 16 * (D / 32), I_MOD = 96 * 8, I_BIAS = 16 * SEQ / 64;
    constexpr int NITEMS = I_IN + I_OUT + I_MOD + I_BIAS;
    for (int it = gw; it < NITEMS; it += NGW) {
        int r = it;
        if (r < I_MOD) {
            const int cc = r % 96, ks = r / 96, j = cc * 64 + F.lane;
            const float* c = a.in[1]; const float* w_ada = a.in[3];
            { const int b = F.lane >> 3, kq = (F.lane & 7) * 16;
#pragma unroll
                for (int i = 0; i < 16; ++i) { const float cv = c[b * D + ks * 128 + kq + i]; scr[b * 128 + kq + i] = cv / (1.f + expf(-cv)); } }
            LDS_WAIT(); asm volatile("" ::: "memory");
            float acc[BATCH];
#pragma unroll
            for (int b = 0; b < BATCH; ++b) acc[b] = 0.f;
            const float* wp = w_ada + (size_t)(ks * 128) * (6 * D) + j;
#pragma unroll 1
            for (int k0 = 0; k0 < 128; k0 += 16) { float w[16];
#pragma unroll
                for (int i = 0; i < 16; ++i) w[i] = wp[(size_t)(k0 + i) * (6 * D)];
#pragma unroll
                for (int i = 0; i < 16; ++i)
#pragma unroll
                    for (int b = 0; b < BATCH; ++b) acc[b] += scr[b * 128 + k0 + i] * w[i]; }
            LDS_WAIT(); asm volatile("" ::: "memory");
            float* mp = (float*)(a.ws + WS_MODP) + (size_t)ks * BATCH * 6 * D;
#pragma unroll
            for (int b = 0; b < BATCH; ++b) mp[(size_t)b * 6 * D + j] = acc[b];
            continue;
        }
        r -= I_MOD;
        if (r < I_BIAS) { const int i = r * 64 + F.lane, h = i / SEQ, d = i % SEQ; ((float*)(a.ws + WS_BIAS))[i] = a.in[9][rel_bucket(d) * 16 + h] * LOG2E; continue; }
        r -= I_BIAS;
        if (r < I_IN) { const int nb = r % (D_IN / 32), kb = r / (D_IN / 32); p0_transpose_item(w_in, D, D_IN, Win_t, kb * 64, nb * 32, nb * 32, scr, F.lane); continue; }
        r -= I_IN;
        { const int nb = r % (D / 32), kb = r / (D / 32); p0_transpose_item(w_out, D, D, Wout_t, kb * 64, nb * 32, nb * 32, scr, F.lane); }
    }
}
constexpr int CV_GU = NE * 8 * (2 * DFF / 64), CV_DN = NE * 8 * (D / 64), CV_ITEMS = CV_GU + CV_DN;
struct ConvItem { const float* src; unsigned char* dst; int N; };
__device__ __forceinline__ ConvItem conv_addr(const Args& a, int r) {
    const float* w_gu = a.in[14]; const float* w_down = a.in[16]; unsigned char* Wgu_t = a.ws + WS_WGU; unsigned char* Wd_t = a.ws + WS_WD; ConvItem c;
    if (r < CV_GU) { const int per = 8 * (2 * DFF / 64), e = r / per, q = r % per, nb = q % (2 * DFF / 64), kb = q / (2 * DFF / 64), n0 = nb * 64;
        const int drow = (n0 < DFF) ? ((n0 >> 7) * 256 + (n0 & 127)) : (((n0 - DFF) >> 7) * 256 + 128 + ((n0 - DFF) & 127));
        c.src = w_gu + (size_t)e * D * 2 * DFF + (size_t)(kb * 128) * (2 * DFF) + n0; c.N = 2 * DFF; c.dst = Wgu_t + (size_t)e * 2 * DFF * D + (size_t)drow * D + kb * 128; }
    else { const int rr = r - CV_GU, per = 8 * (D / 64), e = rr / per, q = rr % per, nb = q % (D / 64), kb = q / (D / 64), n0 = nb * 64;
        c.src = w_down + (size_t)e * DFF * D + (size_t)(kb * 128) * D + n0; c.N = D; c.dst = Wd_t + (size_t)e * D * DFF + (size_t)n0 * DFF + kb * 128; }
    return c;
}
__device__ __forceinline__ void conv_range(Frame& F, const Args& a, int lo, int hi, int first, int stride) {
    LAS unsigned* scr = (LAS unsigned*)(F.lds + RING_OFF + F.wave * 16384);
    int r = lo + first; if (r >= hi) return;
    ConvItem cur = conv_addr(a, r);
    f32x4 xa[16], xb[16];
    conv_load_half(xa, cur.src, cur.N, 0, F.lane); conv_load_half(xb, cur.src, cur.N, 1, F.lane);
#pragma unroll 1
    for (;;) {
        const int rn = r + stride; const bool more = rn < hi;
        const ConvItem nxt = conv_addr(a, more ? rn : r);
        conv_cvt_half(xa, scr, 0, F.lane); conv_load_half(xa, nxt.src, nxt.N, 0, F.lane);
        conv_cvt_half(xb, scr, 1, F.lane); conv_load_half(xb, nxt.src, nxt.N, 1, F.lane);
        LDS_WAIT(); asm volatile("" ::: "memory");
        conv_store(cur.dst, scr, F.lane);
        LDS_WAIT(); asm volatile("" ::: "memory");
        if (!more) break;
        cur = nxt; r = rn;
    }
}
__device__ __forceinline__ void p1_xn(Frame& F, const Args& a) {
    const float* modp = (const float*)(a.ws + WS_MODP); const float* b_ada = a.in[4]; float* modf = (float*)(a.ws + WS_MODF);
    for (int i = blockIdx.x * 512 + F.tid; i < BATCH * 6 * D; i += F.G * 512) { float s = b_ada[i % (6 * D)];
#pragma unroll
        for (int ks = 0; ks < 8; ++ks) s += modp[(size_t)ks * BATCH * 6 * D + i];
        modf[i] = s; }
    LAS float* tab = (LAS float*)(F.lds + RING_OFF);
    const float* x = a.in[0]; const float* g = a.in[2]; bf16* XN = (bf16*)(a.ws + WS_XN);
    for (int chunk = blockIdx.x; chunk < NTOK / 64; chunk += F.G) {
        const int b = chunk / (SEQ / 64);
        __syncthreads();
        for (int i = F.tid; i < 2 * D; i += 512) { const int col = i & (D - 1), chunkid = (i < D) ? 1 : 0; float s = b_ada[chunkid * D + col];
#pragma unroll
            for (int ks = 0; ks < 8; ++ks) s += modp[(size_t)ks * BATCH * 6 * D + (size_t)b * 6 * D + chunkid * D + col];
            tab[i] = (i < D) ? g[col] * (1.f + s) : s; }
        __syncthreads();
        for (int rr = F.wave; rr < 64; rr += 4 * NWAVES) {
            f32x4 v[4][4]; float s[4];
#pragma unroll
            for (int q = 0; q < 4; ++q) { const GAS f32x4* xr = (const GAS f32x4*)(x + (size_t)(chunk * 64 + rr + q * NWAVES) * D) + F.lane;
#pragma unroll
                for (int j = 0; j < 4; ++j) v[q][j] = xr[64 * j]; }
#pragma unroll
            for (int q = 0; q < 4; ++q) { s[q] = 0.f;
#pragma unroll
                for (int j = 0; j < 4; ++j) s[q] += (v[q][j].x * v[q][j].x + v[q][j].y * v[q][j].y) + (v[q][j].z * v[q][j].z + v[q][j].w * v[q][j].w); }
#pragma unroll
            for (int q = 0; q < 4; ++q) { const float rstd = 1.f / sqrtf(wave_sum(s[q]) * (1.f / D) + EPS);
                GAS unsigned long long* o8 = (GAS unsigned long long*)(XN + (size_t)(chunk * 64 + rr + q * NWAVES) * D) + F.lane;
#pragma unroll
                for (int j = 0; j < 4; ++j) { const int col = 4 * F.lane + 256 * j; const f32x4 gs = *(const LAS f32x4*)(tab + col), sh = *(const LAS f32x4*)(tab + D + col);
                    const f32x4 h = v[q][j] * rstd * gs + sh;
                    o8[64 * j] = (unsigned long long)pk2(h.x, h.y) | ((unsigned long long)pk2(h.z, h.w) << 32); } }
        }
    }
}

__device__ __forceinline__ void p5_router(Frame& F, const Args& a) {
    typedef __attribute__((ext_vector_type(8))) short bx8; typedef __attribute__((ext_vector_type(16))) float fx16;
    const unsigned short* x1 = (const unsigned short*)(a.ws + WS_X1); const float* modf = (const float*)(a.ws + WS_MODF); const float* g_ffn = a.in[11]; const float* w_router = a.in[12]; const float* b_router = a.in[13];
    unsigned char* H2 = a.ws + WS_H2; int* inv = (int*)(a.ws + WS_INV); float* tok_w = (float*)(a.ws + WS_TOKW);
    LAS float* part = (LAS float*)(F.lds + RING_OFF);
    LAS float* ssq = (LAS float*)(F.lds + RING_OFF + 32768);
    LAS float* cpart = (LAS float*)(F.lds + RING_OFF + 32768 + 1024);
    LAS float* lg = (LAS float*)(F.lds + RING_OFF + 32768 + 3072);
    LAS float* rs = (LAS float*)(F.lds + RING_OFF + 32768 + 3072 + 4352);
    LAS int* cb = (LAS int*)(F.lds + RING_OFF + 32768 + 3072 + 4352 + 128);
    LAS float* gsl = (LAS float*)(F.lds + RING_OFF + 49152);
    LAS float* shl = (LAS float*)(F.lds + RING_OFF + 49152 + 4096);
    const int lane = F.lane, w = F.wave, r32 = lane & 31, hi = lane >> 5;
#pragma unroll 1
    for (int chunk = blockIdx.x; chunk < NTOK / 64; chunk += F.G) {
        const int b = chunk / (SEQ / 64);
        __syncthreads();
        for (int i = F.tid; i < D; i += NWAVES * 64) { gsl[i] = g_ffn[i] * (1.f + modf[(size_t)b * 6 * D + 4 * D + i]); shl[i] = modf[(size_t)b * 6 * D + 3 * D + i]; }
        if (F.tid < NE) cb[F.tid] = 0;
        __syncthreads();
        bx8 ahi[8], alo[8]; float cp = 0.f;
        const float* wrp = w_router + (size_t)(128 * w + 8 * hi) * NE + r32; const LAS float* gsp = gsl + 128 * w + 8 * hi; const LAS float* shp = shl + 128 * w + 8 * hi;
#pragma unroll
        for (int s = 0; s < 8; ++s) {
            unsigned ph[4], pl[4];
#pragma unroll
            for (int j2 = 0; j2 < 4; ++j2) { float v[2];
#pragma unroll
                for (int q = 0; q < 2; ++q) { const int kk = 16 * s + 2 * j2 + q; const float wr_ = wrp[kk * NE]; cp += shp[kk] * wr_; v[q] = gsp[kk] * wr_; }
                const unsigned h0 = f2bf(v[0]), h1 = f2bf(v[1]); ph[j2] = h0 | (h1 << 16);
                pl[j2] = f2bf(v[0] - __uint_as_float(h0 << 16)) | (f2bf(v[1] - __uint_as_float(h1 << 16)) << 16); }
            ahi[s] = __builtin_bit_cast(bx8, (v4u){ph[0], ph[1], ph[2], ph[3]}); alo[s] = __builtin_bit_cast(bx8, (v4u){pl[0], pl[1], pl[2], pl[3]});
        }
        cpart[(w * 2 + hi) * 32 + r32] = cp;
#pragma unroll 1
        for (int pass = 0; pass < 2; ++pass) {
            const int tok = chunk * 64 + pass * 32 + r32;
            const unsigned short* xr = x1 + (size_t)tok * D + 128 * w + 8 * hi;
            float ss = 0.f; fx16 acc = {};
#pragma unroll
            for (int s = 0; s < 8; ++s) {
                const v4u xw = *(const GAS v4u*)(xr + 16 * s);
#pragma unroll
                for (int q = 0; q < 4; ++q) { const float v0 = __uint_as_float(xw[q] << 16), v1 = __uint_as_float(xw[q] & 0xffff0000u); ss += v0 * v0 + v1 * v1; }
                const bx8 bhi = __builtin_bit_cast(bx8, xw);
                acc = __builtin_amdgcn_mfma_f32_32x32x16_bf16(ahi[s], bhi, acc, 0, 0, 0);
                acc = __builtin_amdgcn_mfma_f32_32x32x16_bf16(alo[s], bhi, acc, 0, 0, 0);
            }
            ss += __shfl_xor(ss, 32);
            __syncthreads();
#pragma unroll
            for (int r = 0; r < 16; ++r) part[(w * 32 + ((r & 3) + 8 * (r >> 2) + 4 * hi)) * 32 + r32] = acc[r];
            if (hi == 0) ssq[w * 32 + r32] = ss;
            __syncthreads();
            { const int tk = F.tid & 31, eg = F.tid >> 5;
                float sq = 0.f;
#pragma unroll
                for (int ww = 0; ww < 8; ++ww) sq += ssq[ww * 32 + tk];
                const float rstd = 1.f / sqrtf(sq * (1.f / D) + EPS);
                if (eg == 0) rs[tk] = rstd;
#pragma unroll
                for (int q = 0; q < 2; ++q) { const int e = 2 * eg + q; float sum = 0.f, c = b_router[e];
#pragma unroll
                    for (int ww = 0; ww < 8; ++ww) sum += part[(ww * 32 + e) * 32 + tk];
#pragma unroll
                    for (int ww = 0; ww < 16; ++ww) c += cpart[ww * 32 + e];
                    lg[tk * 33 + e] = rstd * sum + c; } }
            __syncthreads();
            { const float rstd = rs[r32]; unsigned char* hr = H2 + (size_t)tok * D + 128 * w + 8 * hi;
#pragma unroll
                for (int s = 0; s < 8; ++s) { unsigned pk[2]; const v4u xw = *(const GAS v4u*)(xr + 16 * s);
#pragma unroll
                    for (int q = 0; q < 2; ++q) { const f32x4 xv = {__uint_as_float(xw[2 * q] << 16), __uint_as_float(xw[2 * q] & 0xffff0000u), __uint_as_float(xw[2 * q + 1] << 16), __uint_as_float(xw[2 * q + 1] & 0xffff0000u)};
                        const f32x4 g4 = *(const LAS f32x4*)(gsp + 16 * s + 4 * q), h4 = *(const LAS f32x4*)(shp + 16 * s + 4 * q);
                        const f32x4 hv = xv * rstd * g4 + h4; pk[q] = pg8::pk4_f8(hv.x, hv.y, hv.z, hv.w); }
                    *(GAS unsigned long long*)(hr + 16 * s) = (unsigned long long)pk[0] | ((unsigned long long)pk[1] << 32); } }
            if (w == 0 && lane < 32) {
                float lgv[NE];
#pragma unroll
                for (int i = 0; i < NE; ++i) lgv[i] = lg[lane * 33 + i];
                int idx[TOPK]; float val[TOPK]; unsigned used = 0;
#pragma unroll
                for (int r = 0; r < TOPK; ++r) { int best = -1; float bv = 0.f;
#pragma unroll
                    for (int i = 0; i < NE; ++i) if (!((used >> i) & 1u) && (best < 0 || lgv[i] > bv)) { best = i; bv = lgv[i]; }
                    used |= 1u << best; idx[r] = best; val[r] = bv; }
                float wsum = 0.f, wv[TOPK];
#pragma unroll
                for (int r = 0; r < TOPK; ++r) { wv[r] = __expf(val[r] - val[0]); wsum += wv[r]; }
                const int tk = chunk * 64 + pass * 32 + lane; const float inv_ws = 1.f / wsum;
                const unsigned selbits = (1u << idx[0]) | (1u << idx[1]) | (1u << idx[2]) | (1u << idx[3]);
                int rk[TOPK] = {0, 0, 0, 0};
#pragma unroll 1
                for (int e = 0; e < NE; ++e) {
                    const unsigned long long mm = __ballot((selbits >> e) & 1u);
                    const int base = cb[e], rnk = base + __popcll(mm & ((1ull << lane) - 1ull));
#pragma unroll
                    for (int r = 0; r < TOPK; ++r) if (idx[r] == e) rk[r] = rnk;
                    if (lane == 0) cb[e] = base + __popcll(mm);
                }
#pragma unroll
                for (int r = 0; r < TOPK; ++r) { inv[((size_t)chunk * NE + idx[r]) * 64 + rk[r]] = tk * 4 + r; tok_w[tk * 4 + r] = wv[r] * inv_ws; }
            }
        }
        if (w == 0 && lane < NE) ((int*)(a.ws + WS_CNTC))[lane * 256 + chunk] = cb[lane];
    }
}
__device__ __forceinline__ void build_tiles(Frame& F, const Args& a) {
    LAS int* tile_e = (LAS int*)(F.lds + LDS_TILE_E); LAS int* ntl = (LAS int*)(F.lds + LDS_NT); LAS int* tbase = (LAS int*)(F.lds + LDS_TBASE); LAS int* cnte = (LAS int*)(F.lds + LDS_CNTE);
    LAS int* pre = (LAS int*)(F.lds + RING_OFF);
    __syncthreads();
    { const int e = F.tid >> 4, part = F.tid & 15; const int* cp = (const int*)(a.ws + WS_CNTC) + e * 256 + part * 16;
        int v[16]; int sum = 0;
#pragma unroll
        for (int q = 0; q < 4; ++q) { const int4 t4 = *(const int4*)(cp + 4 * q); v[4 * q] = t4.x; v[4 * q + 1] = t4.y; v[4 * q + 2] = t4.z; v[4 * q + 3] = t4.w; }
#pragma unroll
        for (int q = 0; q < 16; ++q) { const int t = v[q]; v[q] = sum; sum += t; }
        int inc = sum;
#pragma unroll
        for (int d = 1; d < 16; d <<= 1) { const int n = __shfl_up(inc, d, 16); if (part >= d) inc += n; }
        const int excl = inc - sum;
#pragma unroll
        for (int q = 0; q < 16; ++q) pre[e * 256 + part * 16 + q] = excl + v[q];
        if (part == 15) cnte[e] = inc; }
    __syncthreads();
    if (F.tid == 0) { int base = 0;
        for (int e = 0; e < NE; ++e) { const int nt = (cnte[e] + 255) >> 8; tbase[e] = base; for (int j = 0; j < nt; ++j) tile_e[base + j] = e; base += nt; }
        ntl[0] = base; }
    __syncthreads();
}
__device__ __forceinline__ void p8_final(Frame& F, const Args& a) {
    const unsigned short* x1 = (const unsigned short*)(a.ws + WS_X1); const unsigned char* Y = a.ws + WS_Y; const float* modf = (const float*)(a.ws + WS_MODF);
    const int* tok_slot = (const int*)(a.ws + WS_TOKP); const float* tok_w = (const float*)(a.ws + WS_TOKW);
    const float* gfin = a.in[18];
    const int gw = F.vcu * NWAVES + F.wave, NGW = F.G * NWAVES;
    typedef int i32x4 __attribute__((ext_vector_type(4)));
    i32x4 np[2]; f32x4 nw[2];
#define P8_ROUTE(r0) do { _Pragma("unroll") for (int _q = 0; _q < 2; ++_q) { const int _r = (r0) + _q * NGW; if (_r < NTOK) { np[_q] = *(const GAS i32x4*)(tok_slot + _r * 4); nw[_q] = *(const GAS f32x4*)(tok_w + _r * 4); } } } while (0)
    P8_ROUTE(gw);
    for (int row0 = gw; row0 < NTOK; row0 += 2 * NGW) {
        i32x4 cp[2]; f32x4 cw[2];
#pragma unroll
        for (int q = 0; q < 2; ++q) { cp[q] = np[q]; cw[q] = nw[q]; }
        unsigned yv[2][TOPK][4]; pg8::u32x2 xv[2][4];
#pragma unroll
        for (int q = 0; q < 2; ++q) { const int row = row0 + q * NGW; if (row < NTOK) {
#pragma unroll
            for (int k = 0; k < TOPK; ++k) { const int slot = __builtin_amdgcn_readfirstlane(cp[q][k]);
                const GAS unsigned* yr = (const GAS unsigned*)(Y + (size_t)slot * D) + F.lane;
#pragma unroll
                for (int j = 0; j < 4; ++j) yv[q][k][j] = yr[64 * j]; }
            const GAS pg8::u32x2* xr = (const GAS pg8::u32x2*)(x1 + (size_t)row * D) + F.lane;
#pragma unroll
            for (int j = 0; j < 4; ++j) xv[q][j] = xr[64 * j]; } }
        P8_ROUTE(row0 + 2 * NGW);
#pragma unroll
        for (int q = 0; q < 2; ++q) { const int row = row0 + q * NGW; if (row < NTOK) {
            const int b = row / SEQ; const float* gf = modf + (size_t)b * 6 * D + 5 * D;
            f32x4 acc[4];
#pragma unroll
            for (int j = 0; j < 4; ++j) acc[j] = (f32x4){0.f, 0.f, 0.f, 0.f};
#pragma unroll
            for (int k = 0; k < TOPK; ++k) { const float wk = cw[q][k] * (1.0f / YSCALE);
#pragma unroll
                for (int j = 0; j < 4; ++j) { const int qq = (int)yv[q][k][j]; const auto lo = __builtin_amdgcn_cvt_pk_f32_fp8(qq, false), hi = __builtin_amdgcn_cvt_pk_f32_fp8(qq, true);
                    acc[j].x += wk * lo[0]; acc[j].y += wk * lo[1]; acc[j].z += wk * hi[0]; acc[j].w += wk * hi[1]; } }
            float s = 0.f; f32x4 v[4];
#pragma unroll
            for (int j = 0; j < 4; ++j) { const f32x4 g4 = *(const GAS f32x4*)(gf + 4 * F.lane + 256 * j); const f32x4 x4 = {__uint_as_float(xv[q][j].x << 16), __uint_as_float(xv[q][j].x & 0xffff0000u), __uint_as_float(xv[q][j].y << 16), __uint_as_float(xv[q][j].y & 0xffff0000u)}; v[j] = x4 + g4 * acc[j]; s += (v[j].x * v[j].x + v[j].y * v[j].y) + (v[j].z * v[j].z + v[j].w * v[j].w); }
            const float rstd = 1.f / sqrtf(wave_sum(s) * (1.f / D) + EPS);
            GAS f32x4* orow = (GAS f32x4*)(a.out + (size_t)row * D) + F.lane;
#pragma unroll
            for (int j = 0; j < 4; ++j) { const f32x4 g4 = *(const GAS f32x4*)(gfin + 4 * F.lane + 256 * j); orow[64 * j] = v[j] * rstd * g4; } } }
    }
#undef P8_ROUTE
}
__device__ __forceinline__ void build_ridx(Frame& F, const Args& a, int nN) {
    const LAS int* tile_e = (const LAS int*)(F.lds + LDS_TILE_E); const LAS int* tbase = (const LAS int*)(F.lds + LDS_TBASE); const LAS int* cnte = (const LAS int*)(F.lds + LDS_CNTE);
    const LAS int* pre = (const LAS int*)(F.lds + RING_OFF); const int ntiles = *(const LAS int*)(F.lds + LDS_NT);
    LAS int* ridx = (LAS int*)(F.lds + LDS_RIDX); const int* lists = (const int*)(a.ws + WS_INV); int* tok_slot = (int*)(a.ws + WS_TOKP);
    int adr[5], slot[5], flag[5];
#pragma unroll
    for (int k = 0; k < 5; ++k) { const int it = F.tid + k * (NWAVES * 64), i = it >> 8, r = it & 255; int t, pn_; flag[k] = 0; adr[k] = 0; slot[k] = 0;
        if (pg8::moe_unit(i, (int)blockIdx.x, F.G, nN, cnte, tbase, ntiles, t, pn_)) {
            const int e = tile_e[t], j = t - tbase[e], c = cnte[e]; int pos = j * 256 + r; const bool real = pos < c; if (!real) pos = 0;
            int lo = 0;
#pragma unroll
            for (int st = 128; st >= 1; st >>= 1) if (pre[e * 256 + lo + st] <= pos) lo += st;
            adr[k] = (lo * NE + e) * 64 + (pos - pre[e * 256 + lo]); slot[k] = t * 256 + r; flag[k] = (pn_ == 0 && real) ? 2 : 1; } }
    int ent[5];
#pragma unroll
    for (int k = 0; k < 5; ++k) ent[k] = flag[k] ? lists[adr[k]] : 0;
#pragma unroll
    for (int k = 0; k < 5; ++k) if (flag[k]) { ridx[F.tid + k * (NWAVES * 64)] = ent[k] >> 2; if (flag[k] == 2) tok_slot[ent[k]] = slot[k]; }
    __syncthreads();
}

__global__ void __launch_bounds__(NWAVES * 64, 2) mega_fwd(Args args) {
    extern __shared__ __attribute__((aligned(16))) unsigned char lds[];
    Frame F;
    F.lds = (LAS unsigned char*)lds;
    F.MISC = (volatile LAS unsigned*)(F.lds + MISC_OFF);
    F.tid = threadIdx.x; F.lane = F.tid & 63; F.wave = __builtin_amdgcn_readfirstlane(F.tid >> 6);
    F.G = gridDim.x; { const int bx = blockIdx.x; F.vcu = (F.G % 8 == 0) ? (bx % 8) * (F.G / 8) + bx / 8 : bx; }
    unsigned char* ws = args.ws;
    F.ctl = (gu32*)(ws + WS_CTL);
    for (int u = F.tid; u < 512 / 4; u += NWAVES * 64) ((LAS unsigned*)(F.lds + LDSCTL_OFF))[u] = 0u;
    __syncthreads();
    XcdBarrier bar = xcd_barrier_post((unsigned*)(F.ctl + CW_BAR), F.MISC + 8);
    const int lo = args.ph_lo, hi = args.ph_hi;
#ifndef PHASE_MASK
#define PHASE_MASK 0x1ff
#endif
#define IN(k) (((PHASE_MASK >> (k)) & 1) && lo <= (k) && (k) < hi)
#define BOTH(k) (IN(k) && IN((k) + 1))
#define GRID_BAR() xcd_barrier(bar)
#define REFRESH() do { int t_ = threadIdx.x; asm volatile("" : "+v"(t_)); F.tid = t_; F.lane = t_ & 63; F.wave = __builtin_amdgcn_readfirstlane(t_ >> 6); } while (0)
    const bool split = (F.G == 256); constexpr int NCONV = 64, NCONV3 = 64;
    const bool is_conv = split && (int)blockIdx.x >= F.G - NCONV, is_conv3 = split && (int)blockIdx.x >= F.G - NCONV3;
    const int NC = split ? F.G - NCONV : F.G, NC3 = split ? F.G - NCONV3 : F.G, cidx = (int)blockIdx.x;
    const int nconvw = (split ? NCONV : F.G) * NWAVES, convw = (split ? (int)blockIdx.x - (F.G - NCONV) : (int)blockIdx.x) * NWAVES;
    const int nconvw3 = (split ? NCONV3 : F.G) * NWAVES, convw3 = (split ? (int)blockIdx.x - (F.G - NCONV3) : (int)blockIdx.x) * NWAVES;
    constexpr int CV_SPLIT = 4096;
    if (IN(0)) { p0_prologue(F, args); if (!split) conv_range(F, args, 0, CV_ITEMS, F.vcu * NWAVES + F.wave, F.G * NWAVES); if (BOTH(0)) GRID_BAR(); }
    if (IN(1)) { REFRESH(); p1_xn(F, args); if (BOTH(1)) GRID_BAR(); }
    if (IN(2)) {
        if (is_conv) { REFRESH(); conv_range(F, args, 0, CV_SPLIT, convw + F.wave, nconvw); }
        else {
            pg8::Gemm g{(const bf16*)(ws + WS_XN), (const bf16*)(ws + WS_WIN), NTOK, D_IN, D}; pg8::StaticOrder S; S.init(NTOK, D_IN, NC, cidx);
            pg8::EpiProj E{(bf16*)(ws + WS_PROJ), args.in[6], (float*)(F.ctl + CW_KSUM)};
            pg8::gemm_phase<pg8::EpiProj, pg8::StaticOrder, false, true>(F.lds + RING_OFF, g, S, E);
        }
        if (BOTH(2)) GRID_BAR();
    }
    if (IN(3)) {
        if (is_conv3) { REFRESH(); conv_range(F, args, CV_SPLIT, CV_ITEMS, convw3 + F.wave, nconvw3); }
        else {
            const float* sinks = args.in[10]; int prev_key = -1;
            for (int round = 0; ; ++round) {
                const int rank = round * NC3 + ((round & 1) ? (((NC3 & 7) == 0) ? ((NC3 - 1 - cidx) ^ 7) : NC3 - 1 - cidx) : cidx); if (rank >= 1024) break;
                att::UnitDesc u;
                if (rank < 512) { const int bh = rank & 63, h = bh & 7; u.b = bh >> 3; u.qb = 7 - (rank >> 6); u.q0 = u.qb * 256; u.gqa = 0; u.moba = 1;
                    u.qcol = h * 64; u.kcol = 512 + h * 64; u.vcol = 1024 + h * 64; u.ocol = h * 64; u.head = h; u.sink2 = 0.f; u.fill = (h != prev_key); prev_key = h; u.fillk = 1; }
                else { const int idx = rank - 512, bk = idx & 15, kvh = bk & 1; u.b = bk >> 1; u.q0 = (31 - (idx >> 4)) * 64; u.qb = u.q0 >> 8; u.gqa = 1; u.moba = 0;
                    u.qcol = 1536 + kvh * 256; u.kcol = 2048 + kvh * 64; u.vcol = 2176 + kvh * 64; u.ocol = 512 + kvh * 256; u.head = 8 + kvh * 4; u.sink2 = 0.f; u.fill = (64 + kvh != prev_key); prev_key = 64 + kvh; u.fillk = 0; }
                att::attn_unit(u, (const bf16*)(ws + WS_PROJ), (bf16*)(ws + WS_O), (const float*)(ws + WS_BIAS), (const float*)(F.ctl + CW_KSUM), sinks, (char*)lds + RING_OFF);
            }
        }
        if (BOTH(3)) GRID_BAR();
    }
    if (IN(4)) {
        pg8::Gemm g{(const bf16*)(ws + WS_O), (const bf16*)(ws + WS_WOUT), NTOK, D, D}; pg8::StaticOrder S; S.init(NTOK, D, F.G, (int)blockIdx.x);
        pg8::EpiX1 E{args.in[0], (pg8::bf16_t*)(ws + WS_X1), args.in[8], (const float*)(ws + WS_MODF)};
        pg8::gemm_phase<pg8::EpiX1, pg8::StaticOrder, false, true>(F.lds + RING_OFF, g, S, E);
        if (BOTH(4)) GRID_BAR();
    }
    if (IN(5)) { REFRESH(); p5_router(F, args); if (BOTH(5)) GRID_BAR(); }
    if (IN(6)) {
        REFRESH(); build_tiles(F, args); build_ridx(F, args, 2 * DFF / 256);
        pg8::Gemm g{(const bf16*)(ws + WS_H2), (const bf16*)(ws + WS_WGU), MAXSLOTS, 2 * DFF, D / 2};
        pg8::GroupedOrder S{2 * DFF / 256, F.G, (int)blockIdx.x, *(const LAS int*)(F.lds + LDS_NT), (const LAS int*)(F.lds + LDS_TILE_E), (const LAS int*)(F.lds + LDS_RIDX), (size_t)2 * DFF * D, (const LAS int*)(F.lds + LDS_CNTE), (const LAS int*)(F.lds + LDS_TBASE)};
        pg8::EpiSwiglu8 E{ws + WS_ACT, args.in[15]};
        pg8::gemm_phase<pg8::EpiSwiglu8, pg8::GroupedOrder, false, true, true>(F.lds + RING_OFF, g, S, E);
        if (BOTH(6)) GRID_BAR();
    }
    if (IN(7)) {
        REFRESH(); if (!IN(6)) build_tiles(F, args);
        pg8::Gemm g{(const bf16*)(ws + WS_ACT), (const bf16*)(ws + WS_WD), MAXSLOTS, D, DFF / 2};
        pg8::GroupedOrder S{D / 256, F.G, (int)blockIdx.x, *(const LAS int*)(F.lds + LDS_NT), (const LAS int*)(F.lds + LDS_TILE_E), (const LAS int*)nullptr, (size_t)D * DFF, (const LAS int*)(F.lds + LDS_CNTE), (const LAS int*)(F.lds + LDS_TBASE)};
        pg8::EpiDown8 E{ws + WS_Y, args.in[17]};
        pg8::gemm_phase<pg8::EpiDown8, pg8::GroupedOrder, false, true, true>(F.lds + RING_OFF, g, S, E);
        if (BOTH(7)) GRID_BAR();
    }
    if (IN(8)) { REFRESH(); p8_final(F, args); }
#undef IN
#undef BOTH
}

#ifndef MK_PER_PHASE
#define MK_PER_PHASE 0
#endif
extern "C" void kernel_launch(void* const* d_in, const int* in_sizes, int n_in, void* d_out, int out_size, void* d_ws, size_t ws_size, hipStream_t stream) {
    static int grid = 0;
    if (grid == 0) {
        if (n_in != 19 || ws_size < WS_END) { fprintf(stderr, "kernel_launch: unexpected n_in %d / ws %zu\n", n_in, ws_size); grid = -1; return; }
        int dev = 0, cus = 0, per_cu = 0;
        if (hipGetDevice(&dev) != hipSuccess || hipDeviceGetAttribute(&cus, hipDeviceAttributeMultiprocessorCount, dev) != hipSuccess) { grid = -1; return; }
        if (hipFuncSetAttribute((const void*)mega_fwd, hipFuncAttributeMaxDynamicSharedMemorySize, LDS_BYTES) != hipSuccess) { fprintf(stderr, "kernel_launch: hipFuncSetAttribute failed\n"); grid = -1; return; }
        if (hipOccupancyMaxActiveBlocksPerMultiprocessor(&per_cu, (const void*)mega_fwd, NWAVES * 64, LDS_BYTES) != hipSuccess || per_cu < 1) fprintf(stderr, "kernel_launch: occupancy query reports %d\n", per_cu);
        (void)hipGetLastError();
        grid = cus;
    }
    if (grid < 0) return;
    unsigned char* ws = (unsigned char*)d_ws;
    (void)hipMemsetAsync(ws + WS_CTL, 0, CTL_ZERO_BYTES, stream);
    Args a{};
    for (int i = 0; i < 19; ++i) a.in[i] = (const float*)d_in[i];
    a.out = (float*)d_out; a.ws = ws;
#if MK_PER_PHASE
    for (int ph = 0; ph < 9; ++ph) { a.ph_lo = ph; a.ph_hi = ph + 1; hipLaunchKernelGGL(mega_fwd, dim3(grid), dim3(NWAVES * 64), LDS_BYTES, stream, a); }
#else
    a.ph_lo = 0; a.ph_hi = 9; hipLaunchKernelGGL(mega_fwd, dim3(grid), dim3(NWAVES * 64), LDS_BYTES, stream, a);
#endif
}
```

```cpp
#include <hip/hip_runtime.h>
#include <hip/hip_bf16.h>
#include <cstdio>
#include <cstdint>
#include <cmath>

constexpr int D = 1024, BATCH = 8, SEQ = 2048, NTOK = BATCH * SEQ;
constexpr int HD = 64, NH_M = 8, NH_S = 8, NKV_S = 2;
constexpr int D_MOBA = 512, D_SWA_Q = 512, D_SWA_KV = 128, D_IN = 2304;
constexpr int MB_L = 256, MB_NB = SEQ / MB_L, MB_TOPK = 3;
constexpr int SWA_W = 128;
constexpr int NE = 32, TOPK = 4, DFF = 1024;
constexpr float EPS = 1e-5f, NEGF = -1e30f;
constexpr int MAXTILES = 288;
constexpr int MAXSLOTS = MAXTILES * 256;
constexpr float LOG2E = 1.4426950408889634f;
constexpr float YSCALE = 16.0f;
constexpr float WSCALE = 32.0f;
constexpr float QSCALE = 0.125f * LOG2E;

namespace pg8 {
#define PG8_LAS __attribute__((address_space(3)))
typedef unsigned short bf16_t;
typedef short bf16x8 __attribute__((ext_vector_type(8)));
typedef float f32x4 __attribute__((ext_vector_type(4)));
typedef unsigned u32x4 __attribute__((ext_vector_type(4)));
typedef int v4i_t __attribute__((ext_vector_type(4)));
constexpr int BM = 256, BK = 64, HALF = 128, HTB = HALF * BK * 2  , STAGE_BYTES = 8 * HTB, NXCD = 8, WGM = 8;

__host__ __device__ __forceinline__ int lds_byte(int r, int c) { const int st = (r >> 4) * 2 + (c >> 5), rr = r & 15, cc = c & 31, ob = rr * 64 + cc * 2; return st * 1024 + (ob ^ (((ob >> 9) & 1) << 5)); }
__host__ __device__ __forceinline__ void stage_rc(int b, int& R, int& C) { const int st = b / 1024, sb = b % 1024, swz = sb ^ (((sb >> 9) & 1) << 5); R = (st >> 1) * 16 + swz / 64; C = (st & 1) * 32 + (swz % 64) / 2; }
__host__ __device__ __forceinline__ int perm32(int rho) { const int n = rho >> 4, i = rho & 15; return 8 * (i >> 2) + 4 * n + (i & 3); }

struct Unit { int pm, pn, e; };
struct Gemm { const bf16_t* A; const bf16_t* Bt; int M, N, K; };

struct StaticOrder {
    int nM, nN, nwg, G, c;
    __host__ __device__ void init(int M, int N, int G_, int c_) { nM = M / BM; nN = N / BM; nwg = nM * nN; G = G_; c = c_; }
    __host__ __device__ bool next(int i, Unit& u) const {
        const long L = (long)i * G + c; if (L >= nwg) return false;
        int wgid = (int)L; { const int q = nwg / NXCD, r = nwg % NXCD, xcd = wgid % NXCD, off = wgid / NXCD; wgid = (xcd < r ? xcd * (q + 1) : r * (q + 1) + (xcd - r) * q) + off; }
        const int nig = WGM * nN, gid = wgid / nig, fm = gid * WGM, gsz = (nM - fm) < WGM ? (nM - fm) : WGM;
        u.pm = fm + ((wgid % nig) % gsz); u.pn = (wgid % nig) / gsz; u.e = 0; return true;
    }
    __device__ __forceinline__ size_t abase(const Unit& u, int h, int K) const { return (size_t)(u.pm * BM + h * HALF) * K * 2; }
    __device__ __forceinline__ unsigned alane(int, const Unit&, int, int, unsigned voff, int) const { return voff; }
    __device__ __forceinline__ size_t bbase(const Unit& u, size_t tstep) const { return (size_t)u.pn * tstep; }
    __device__ __forceinline__ void a_ready(const Unit&) const {}
    __device__ __forceinline__ void done(const Unit&) const {}
};
__device__ __forceinline__ bool moe_unit(int i, int c, int G, int nN, const PG8_LAS int* cnte, const PG8_LAS int* tbase, int ntiles, int& t, int& pn) {
    if ((G & 7) == 0) {
        const int x = c & 7, rank = c >> 3, W = G >> 3, lo = (x * ntiles) >> 3, hi = ((x + 1) * ntiles) >> 3, v = i * W + rank;
        if (v >= (hi - lo) * nN) return false;
        const int j = v / nN; t = lo + j; pn = v - j * nN; return true;
    }
    const int L = i * G + c; t = L / nN; if (t >= ntiles) return false; pn = L - t * nN; return true;
}
struct GroupedOrder {
    int nN, G, c, ntiles; const PG8_LAS int* tile_e; const PG8_LAS int* ridx; size_t bstride; const PG8_LAS int* cnte; const PG8_LAS int* tbase;
    __device__ __forceinline__ bool next(int i, Unit& u) const {
        int t, pn; if (!moe_unit(i, c, G, nN, cnte, tbase, ntiles, t, pn)) return false;
        u.pm = __builtin_amdgcn_readfirstlane(t); u.pn = __builtin_amdgcn_readfirstlane(pn); u.e = __builtin_amdgcn_readfirstlane(tile_e[t]); return true;
    }
    __device__ __forceinline__ size_t abase(const Unit& u, int h, int K) const { return ridx ? (size_t)0 : (size_t)(u.pm * BM + h * HALF) * K * 2; }
    __device__ __forceinline__ unsigned alane(int ui, const Unit&, int h, int piece, unsigned voff, int K) const {
        if (!ridx) return voff;
        int t_ = (int)threadIdx.x; asm volatile("" : "+v"(t_));
        int R, C; stage_rc(t_ * 16 + piece * 8192, R, C);
        return (unsigned)ridx[ui * BM + h * HALF + R] * (unsigned)K * 2u + (unsigned)C * 2u; }
    __device__ __forceinline__ size_t bbase(const Unit& u, size_t tstep) const { return (size_t)u.e * bstride + (size_t)u.pn * tstep; }
    __device__ __forceinline__ void a_ready(const Unit&) const {}
    __device__ __forceinline__ void done(const Unit&) const {}
};

__device__ __forceinline__ unsigned cvt_pk_bf16(float lo, float hi) { unsigned r; asm volatile("v_cvt_pk_bf16_f32 %0, %1, %2" : "=v"(r) : "v"(lo), "v"(hi)); return r; }

struct EpiProj {
    static constexpr bool PERM = true, AFTER_DRAIN = false;
    bf16_t* O; const float* bias; float* ksum;
    __device__ __forceinline__ void operator()(const f32x4 (&acc)[2][2][4][2], const Unit& u, int wr, int wc, int fr, int fq) const {
        const int row0 = u.pm * BM + wr * 64 + fr, col0 = u.pn * BM + wc * 32 + 8 * fq;
        const float sc = (u.pn < 2 || u.pn == 6 || u.pn == 7) ? QSCALE : 1.0f;
        f32x4 bv[2][2];
#pragma unroll
        for (int bj = 0; bj < 2; ++bj)
#pragma unroll
            for (int n = 0; n < 2; ++n) bv[bj][n] = *(const f32x4*)(bias + col0 + bj * HALF + 4 * n);
#pragma unroll
        for (int ai = 0; ai < 2; ++ai)
#pragma unroll
            for (int m = 0; m < 4; ++m) { bf16_t* rowp = O + (size_t)(row0 + ai * HALF + m * 16) * D_IN + col0;
#pragma unroll
                for (int bj = 0; bj < 2; ++bj) { f32x4 v0 = (acc[ai][bj][m][0] + bv[bj][0]) * sc, v1 = (acc[ai][bj][m][1] + bv[bj][1]) * sc;
                    u32x4 w; w.x = cvt_pk_bf16(v0[0], v0[1]); w.y = cvt_pk_bf16(v0[2], v0[3]); w.z = cvt_pk_bf16(v1[0], v1[1]); w.w = cvt_pk_bf16(v1[2], v1[3]);
                    *(u32x4*)(rowp + bj * HALF) = w; } }
        if (u.pn == 2 || u.pn == 3) {
#pragma unroll
            for (int bj = 0; bj < 2; ++bj)
#pragma unroll
                for (int n = 0; n < 2; ++n) {
                    f32x4 s = bv[bj][n] * 8.0f;
#pragma unroll
                    for (int ai = 0; ai < 2; ++ai)
#pragma unroll
                        for (int m = 0; m < 4; ++m) s += acc[ai][bj][m][n];
#pragma unroll
                    for (int j = 0; j < 4; ++j) { float t = s[j]; t += __shfl_xor(t, 1); t += __shfl_xor(t, 2); t += __shfl_xor(t, 4); t += __shfl_xor(t, 8);
                        if (fr == 0) atomicAdd(ksum + (size_t)u.pm * D_MOBA + (u.pn - 2) * BM + bj * HALF + wc * 32 + 8 * fq + 4 * n + j, t); }
                }
        }
    }
};
struct EpiX1 {
    static constexpr bool PERM = true, AFTER_DRAIN = false;
    const float* x; bf16_t* x1; const float* bias; const float* modf;
    __device__ __forceinline__ void operator()(const f32x4 (&acc)[2][2][4][2], const Unit& u, int wr, int wc, int fr, int fq) const {
        const int row0 = u.pm * BM + wr * 64 + fr, col0 = u.pn * BM + wc * 32 + 8 * fq;
        const float* ga = modf + (size_t)(u.pm >> 3) * 6 * D + 2 * D;
        f32x4 bv[2][2], gv[2][2];
#pragma unroll
        for (int bj = 0; bj < 2; ++bj)
#pragma unroll
            for (int n = 0; n < 2; ++n) { bv[bj][n] = *(const f32x4*)(bias + col0 + bj * HALF + 4 * n); gv[bj][n] = *(const f32x4*)(ga + col0 + bj * HALF + 4 * n); }
#pragma unroll
        for (int ai = 0; ai < 2; ++ai)
#pragma unroll
            for (int m = 0; m < 4; ++m) { const size_t off = (size_t)(row0 + ai * HALF + m * 16) * D + col0;
#pragma unroll
                for (int bj = 0; bj < 2; ++bj) { const f32x4 xr0 = *(const f32x4*)(x + off + bj * HALF), xr1 = *(const f32x4*)(x + off + bj * HALF + 4);
                    const f32x4 v0 = xr0 + gv[bj][0] * (acc[ai][bj][m][0] + bv[bj][0]), v1 = xr1 + gv[bj][1] * (acc[ai][bj][m][1] + bv[bj][1]);
                    u32x4 w; w.x = cvt_pk_bf16(v0[0], v0[1]); w.y = cvt_pk_bf16(v0[2], v0[3]); w.z = cvt_pk_bf16(v1[0], v1[1]); w.w = cvt_pk_bf16(v1[2], v1[3]);
                    *(u32x4*)(x1 + off + bj * HALF) = w; }
                if (m == 3) asm volatile("" ::: "memory"); }
    }
};
struct EpiSwiglu {
    static constexpr bool PERM = true, AFTER_DRAIN = false;
    bf16_t* act; const float* bias;
    __device__ __forceinline__ void operator()(const f32x4 (&acc)[2][2][4][2], const Unit& u, int wr, int wc, int fr, int fq) const {
        const int row0 = u.pm * BM + wr * 64 + fr, ff0 = u.pn * HALF + wc * 32 + 8 * fq;
        const float* bg = bias + (size_t)u.e * 2 * DFF + ff0;
        f32x4 bgv[2], buv[2];
#pragma unroll
        for (int n = 0; n < 2; ++n) { bgv[n] = *(const f32x4*)(bg + 4 * n); buv[n] = *(const f32x4*)(bg + DFF + 4 * n); }
#pragma unroll
        for (int ai = 0; ai < 2; ++ai)
#pragma unroll
            for (int m = 0; m < 4; ++m) {
                f32x4 o[2];
#pragma unroll
                for (int n = 0; n < 2; ++n) { const f32x4 gq = acc[ai][0][m][n] + bgv[n], uq = acc[ai][1][m][n] + buv[n];
#pragma unroll
                    for (int j = 0; j < 4; ++j) { const float g = fminf(gq[j], 7.0f), uu = fminf(fmaxf(uq[j], -7.0f), 7.0f);
                        const float sg = __builtin_amdgcn_rcpf(1.0f + __builtin_amdgcn_exp2f(-1.702f * LOG2E * g)); o[n][j] = (uu + 1.0f) * (g * sg); } }
                u32x4 w; w.x = cvt_pk_bf16(o[0][0], o[0][1]); w.y = cvt_pk_bf16(o[0][2], o[0][3]); w.z = cvt_pk_bf16(o[1][0], o[1][1]); w.w = cvt_pk_bf16(o[1][2], o[1][3]);
                *(u32x4*)(act + (size_t)(row0 + ai * HALF + m * 16) * DFF + ff0) = w; }
    }
};
struct EpiDown {
    static constexpr bool PERM = true, AFTER_DRAIN = false;
    bf16_t* y; const float* bias;
    __device__ __forceinline__ void operator()(const f32x4 (&acc)[2][2][4][2], const Unit& u, int wr, int wc, int fr, int fq) const {
        const int row0 = u.pm * BM + wr * 64 + fr, col0 = u.pn * BM + wc * 32 + 8 * fq;
        const float* bb = bias + (size_t)u.e * D + col0;
        f32x4 bv[2][2];
#pragma unroll
        for (int bj = 0; bj < 2; ++bj)
#pragma unroll
            for (int n = 0; n < 2; ++n) bv[bj][n] = *(const f32x4*)(bb + bj * HALF + 4 * n);
#pragma unroll
        for (int ai = 0; ai < 2; ++ai)
#pragma unroll
            for (int m = 0; m < 4; ++m) { bf16_t* rowp = y + (size_t)(row0 + ai * HALF + m * 16) * D + col0;
#pragma unroll
                for (int bj = 0; bj < 2; ++bj) { const f32x4 v0 = acc[ai][bj][m][0] + bv[bj][0], v1 = acc[ai][bj][m][1] + bv[bj][1];
                    u32x4 w; w.x = cvt_pk_bf16(v0[0], v0[1]); w.y = cvt_pk_bf16(v0[2], v0[3]); w.z = cvt_pk_bf16(v1[0], v1[1]); w.w = cvt_pk_bf16(v1[2], v1[3]);
                    *(u32x4*)(rowp + bj * HALF) = w; } }
    }
};

__device__ __forceinline__ unsigned pk4_f8(float a, float b, float c, float d) { int r = __builtin_amdgcn_cvt_pk_fp8_f32(a, b, 0, false); r = __builtin_amdgcn_cvt_pk_fp8_f32(c, d, r, true); return (unsigned)r; }
typedef unsigned u32x2 __attribute__((ext_vector_type(2)));
struct EpiSwiglu8 {
    static constexpr bool PERM = true, AFTER_DRAIN = false;
    unsigned char* act; const float* bias;
    __device__ __forceinline__ void operator()(const f32x4 (&acc)[2][2][4][2], const Unit& u, int wr, int wc, int fr, int fq) const {
        const int row0 = u.pm * BM + wr * 64 + fr, ff0 = u.pn * HALF + wc * 32 + 8 * fq;
        const float* bg = bias + (size_t)u.e * 2 * DFF + ff0;
        f32x4 bgv[2], buv[2];
#pragma unroll
        for (int n = 0; n < 2; ++n) { bgv[n] = *(const f32x4*)(bg + 4 * n); buv[n] = *(const f32x4*)(bg + DFF + 4 * n); }
#pragma unroll
        for (int ai = 0; ai < 2; ++ai)
#pragma unroll
            for (int m = 0; m < 4; ++m) {
                f32x4 o[2];
#pragma unroll
                for (int n = 0; n < 2; ++n) { const f32x4 gq = acc[ai][0][m][n] * (1.0f / WSCALE) + bgv[n], uq = acc[ai][1][m][n] * (1.0f / WSCALE) + buv[n];
#pragma unroll
                    for (int j = 0; j < 4; ++j) { const float g = fminf(gq[j], 7.0f), uu = fminf(fmaxf(uq[j], -7.0f), 7.0f);
                        const float sg = __builtin_amdgcn_rcpf(1.0f + __builtin_amdgcn_exp2f(-1.702f * LOG2E * g)); o[n][j] = (uu + 1.0f) * (g * sg); } }
                u32x2 w; w.x = pk4_f8(o[0][0], o[0][1], o[0][2], o[0][3]); w.y = pk4_f8(o[1][0], o[1][1], o[1][2], o[1][3]);
                *(u32x2*)(act + (size_t)(row0 + ai * HALF + m * 16) * DFF + ff0) = w;
                asm volatile("" ::: "memory"); }
    }
};
struct EpiDown8 {
    static constexpr bool PERM = true, AFTER_DRAIN = false;
    unsigned char* y; const float* bias;
    __device__ __forceinline__ void operator()(const f32x4 (&acc)[2][2][4][2], const Unit& u, int wr, int wc, int fr, int fq) const {
        const int row0 = u.pm * BM + wr * 64 + fr, col0 = u.pn * BM + wc * 32 + 8 * fq;
        const float* bb = bias + (size_t)u.e * D + col0;
        f32x4 bv[2][2];
#pragma unroll
        for (int bj = 0; bj < 2; ++bj)
#pragma unroll
            for (int n = 0; n < 2; ++n) bv[bj][n] = *(const f32x4*)(bb + bj * HALF + 4 * n) * YSCALE;
#pragma unroll
        for (int ai = 0; ai < 2; ++ai)
#pragma unroll
            for (int m = 0; m < 4; ++m) { unsigned char* rowp = y + (size_t)(row0 + ai * HALF + m * 16) * D + col0;
#pragma unroll
                for (int bj = 0; bj < 2; ++bj) { const f32x4 v0 = acc[ai][bj][m][0] * (YSCALE / WSCALE) + bv[bj][0], v1 = acc[ai][bj][m][1] * (YSCALE / WSCALE) + bv[bj][1];
                    u32x2 w; w.x = pk4_f8(v0[0], v0[1], v0[2], v0[3]); w.y = pk4_f8(v1[0], v1[1], v1[2], v1[3]);
                    *(u32x2*)(rowp + bj * HALF) = w; }
                asm volatile("" ::: "memory"); }
    }
};

__device__ __forceinline__ void glds16_s(const char* sbase, unsigned voff, unsigned lds_dst) { unsigned keep;
    asm volatile("s_mov_b32 %0, m0\n\ts_mov_b32 m0, %3\n\ts_nop 0\n\tglobal_load_lds_dwordx4 %1, %2\n\ts_mov_b32 m0, %0" : "=&s"(keep) : "v"(voff), "s"(sbase), "s"(lds_dst) : "memory"); }
template <class Epi, class Sched, bool ALIGN_EPI = false, bool SP2 = false, bool F8 = false>
__device__ __forceinline__ void gemm_phase(PG8_LAS unsigned char* lds, const Gemm g, const Sched& S, const Epi& E) {
    int tid_ = threadIdx.x; asm volatile("" : "+v"(tid_));
    const int tid = tid_, wid = __builtin_amdgcn_readfirstlane(tid >> 6), lane = tid & 63, wr = wid >> 2, wc = wid & 3, fr = lane & 15, fq = lane >> 4;
    const int K = g.K, nt = K / BK;
    unsigned voffA[2], voffB[2];
#pragma unroll
    for (int i = 0; i < 2; ++i) { int R, C; stage_rc(tid * 16 + i * 8192, R, C); const int Rb = Epi::PERM ? ((R & ~31) + perm32(R & 31)) : R;
        voffA[i] = (unsigned)(R * K + C) * 2u; voffB[i] = (unsigned)(Rb * K + C) * 2u; }
#define PG8_STAGE_A(bufoff, kptr, UI, U, H) do { const char* _gb = (kptr) + S.abase(U, H, K); _Pragma("unroll") for (int _i = 0; _i < 2; ++_i) \
        glds16_s(_gb, S.alane(UI, U, H, _i, voffA[_i], K), ldsbase + (unsigned)((bufoff) + _i * 8192)); } while (0)
    const size_t kstep = (size_t)(BK * 2);
    const size_t hstep = (size_t)HALF * K * 2;
    const size_t tstep = 2 * hstep;
    const unsigned ldsw = (unsigned)wid * 1024u;
    const unsigned ldsbase = (unsigned)__builtin_amdgcn_readfirstlane((int)((unsigned)(size_t)lds + ldsw));
    const int aoff = lds_byte(wr * 64 + fr, fq * 8), boff = lds_byte(wc * 32 + fr, fq * 8);
#define PG8_SA(b, h) (((b) * 2 + (h)) * HTB)
#define PG8_SB(b, h) ((4 + (b) * 2 + (h)) * HTB)
#define PG8_STAGE(bufoff, gbase, voff) do { _Pragma("unroll") for (int _i = 0; _i < 2; ++_i) \
        glds16_s((const char*)(gbase), (voff)[_i], ldsbase + (unsigned)((bufoff) + _i * 8192)); } while (0)
#define PG8_LDA(dst, b, h) do { _Pragma("unroll") for (int m = 0; m < 4; ++m) _Pragma("unroll") for (int k = 0; k < 2; ++k) dst[m][k] = *(const PG8_LAS bf16x8*)(lds + PG8_SA(b, h) + aoff + m * 2048 + k * 1024); } while (0)
#define PG8_LDB(dst, b, h) do { _Pragma("unroll") for (int n = 0; n < 2; ++n) _Pragma("unroll") for (int k = 0; k < 2; ++k) dst[n][k] = *(const PG8_LAS bf16x8*)(lds + PG8_SB(b, h) + boff + n * 2048 + k * 1024); } while (0)
#define PG8_CAT(x) __builtin_shufflevector(__builtin_bit_cast(v4i_t, x[0]), __builtin_bit_cast(v4i_t, x[1]), 0, 1, 2, 3, 4, 5, 6, 7)
#define PG8_MMA(ai, bj, At, Bt) do { __builtin_amdgcn_s_setprio(1); _Pragma("unroll") for (int m = 0; m < 4; ++m) _Pragma("unroll") for (int n = 0; n < 2; ++n) { \
        if constexpr (F8) { acc[ai][bj][m][n] = __builtin_amdgcn_mfma_scale_f32_16x16x128_f8f6f4(PG8_CAT(Bt[n]), PG8_CAT(At[m]), acc[ai][bj][m][n], 0, 0, 0, 0, 0, 0); } \
        else { _Pragma("unroll") for (int k = 0; k < 2; ++k) acc[ai][bj][m][n] = __builtin_amdgcn_mfma_f32_16x16x32_bf16(Bt[n][k], At[m][k], acc[ai][bj][m][n], 0, 0, 0); } } \
        __builtin_amdgcn_s_setprio(0); } while (0)
#define PG8_WAIT_V(n) asm volatile("s_waitcnt vmcnt(" #n ")" ::: "memory")
#define PG8_WAIT_L(n) asm volatile("s_waitcnt lgkmcnt(" #n ")" ::: "memory")
#define PG8_BAR __builtin_amdgcn_s_barrier()
#define PG8_SCHED __builtin_amdgcn_sched_barrier(0)
    Unit cur, nxt; int ui = 0;
    if (!S.next(0, cur)) return;
    f32x4 acc[2][2][4][2];
#pragma unroll
    for (int a = 0; a < 2; ++a)
#pragma unroll
        for (int b = 0; b < 2; ++b)
#pragma unroll
            for (int m = 0; m < 4; ++m)
#pragma unroll
                for (int n = 0; n < 2; ++n) acc[a][b][m][n] = (f32x4){0.f, 0.f, 0.f, 0.f};
    bf16x8 At[4][2], B0[2][2], B1[2][2];
    const char* const A0 = (const char*)g.A; const char* cB = (const char*)g.Bt + S.bbase(cur, tstep);

    S.a_ready(cur);
    if constexpr (SP2) {
        PG8_STAGE(PG8_SB(0, 0), cB, voffB); PG8_STAGE(PG8_SB(0, 1), cB + hstep, voffB); PG8_STAGE_A(PG8_SA(0, 0), A0, 0, cur, 0); PG8_STAGE_A(PG8_SA(0, 1), A0, 0, cur, 1);
        if (wr == 1) PG8_BAR;
        PG8_WAIT_V(2); PG8_BAR;
        PG8_STAGE(PG8_SB(1, 0), cB + kstep, voffB); PG8_STAGE_A(PG8_SA(1, 0), A0 + kstep, 0, cur, 0); PG8_STAGE(PG8_SB(1, 1), cB + hstep + kstep, voffB);
        PG8_WAIT_V(6); PG8_BAR;
    } else {
        PG8_STAGE(PG8_SB(0, 0), cB, voffB); PG8_STAGE_A(PG8_SA(0, 0), A0, 0, cur, 0); PG8_STAGE(PG8_SB(0, 1), cB + hstep, voffB); PG8_STAGE_A(PG8_SA(0, 1), A0, 0, cur, 1);
        if (wr == 1) PG8_BAR;
        PG8_WAIT_V(4); PG8_BAR;
        PG8_STAGE(PG8_SB(1, 0), cB + kstep, voffB); PG8_STAGE_A(PG8_SA(1, 0), A0 + kstep, 0, cur, 0); PG8_STAGE(PG8_SB(1, 1), cB + hstep + kstep, voffB);
        PG8_WAIT_V(6); PG8_BAR;
    }
    for (;;) {
        const bool has_next = S.next(ui + 1, nxt);
        const char* nB = has_next ? (const char*)g.Bt + S.bbase(nxt, tstep) : cB;
        if (!has_next) nxt = cur;
        const int nui = has_next ? ui + 1 : ui;
#pragma unroll 1
        for (int t = 0; t < nt; t += 2) {
            const bool last = (t == nt - 2);
            const char* a1 = A0 + (size_t)(t + 1) * kstep;
            const char* a2 = last ? A0 : A0 + (size_t)(t + 2) * kstep; const char* b2 = last ? nB : cB + (size_t)(t + 2) * kstep;
            const int lui = last ? nui : ui; Unit lu; lu.pm = last ? nxt.pm : cur.pm; lu.pn = last ? nxt.pn : cur.pn; lu.e = last ? nxt.e : cur.e;
            const char* a3 = a2 + kstep; const char* b3 = b2 + kstep;
            if (last && has_next) S.a_ready(nxt);
            if constexpr (SP2) {
            PG8_LDB(B0, 0, 0); PG8_LDB(B1, 0, 1); PG8_SCHED; PG8_LDA(At, 0, 0); PG8_STAGE_A(PG8_SA(1, 1), a1, ui, cur, 1);
            PG8_WAIT_V(8); PG8_WAIT_L(0); PG8_BAR; PG8_MMA(0, 0, At, B0); PG8_MMA(0, 1, At, B1); PG8_BAR; PG8_SCHED;
            PG8_LDA(At, 0, 1); PG8_STAGE(PG8_SB(0, 0), b2, voffB); PG8_STAGE(PG8_SB(0, 1), b2 + hstep, voffB); PG8_STAGE_A(PG8_SA(0, 0), a2, lui, lu, 0);
            PG8_WAIT_V(8); PG8_WAIT_L(0); PG8_BAR; PG8_MMA(1, 0, At, B0); PG8_MMA(1, 1, At, B1); PG8_BAR; PG8_SCHED;
            PG8_LDB(B0, 1, 0); PG8_LDB(B1, 1, 1); PG8_SCHED; PG8_LDA(At, 1, 0); PG8_STAGE_A(PG8_SA(0, 1), a2, lui, lu, 1);
            PG8_WAIT_V(8); PG8_WAIT_L(0); PG8_BAR; PG8_MMA(0, 0, At, B0); PG8_MMA(0, 1, At, B1); PG8_BAR; PG8_SCHED;
            PG8_LDA(At, 1, 1); PG8_STAGE(PG8_SB(1, 0), b3, voffB); PG8_STAGE(PG8_SB(1, 1), b3 + hstep, voffB); PG8_STAGE_A(PG8_SA(1, 0), a3, lui, lu, 0);
            PG8_WAIT_V(8); PG8_WAIT_L(0); PG8_BAR; PG8_MMA(1, 0, At, B0); PG8_MMA(1, 1, At, B1); PG8_BAR; PG8_SCHED;
            } else {
            PG8_LDB(B0, 0, 0); PG8_SCHED; PG8_LDA(At, 0, 0); PG8_STAGE_A(PG8_SA(1, 1), a1, ui, cur, 1);
            PG8_WAIT_L(8); PG8_BAR; PG8_WAIT_L(0); PG8_MMA(0, 0, At, B0); PG8_BAR; PG8_SCHED;
            PG8_LDB(B1, 0, 1); PG8_STAGE(PG8_SB(0, 0), b2, voffB);
            PG8_BAR; PG8_WAIT_L(0); PG8_MMA(0, 1, At, B1); PG8_BAR;
            PG8_LDA(At, 0, 1); PG8_STAGE_A(PG8_SA(0, 0), a2, lui, lu, 0);
            PG8_BAR; PG8_WAIT_L(0); PG8_MMA(1, 0, At, B0); PG8_BAR; PG8_SCHED;
            PG8_STAGE(PG8_SB(0, 1), b2 + hstep, voffB);
            PG8_WAIT_V(6); PG8_BAR; PG8_MMA(1, 1, At, B1); PG8_BAR;
            PG8_LDB(B0, 1, 0); PG8_SCHED; PG8_LDA(At, 1, 0); PG8_STAGE_A(PG8_SA(0, 1), a2, lui, lu, 1);
            PG8_WAIT_L(8); PG8_BAR; PG8_WAIT_L(0); PG8_MMA(0, 0, At, B0); PG8_BAR; PG8_SCHED;
            PG8_LDB(B1, 1, 1); PG8_STAGE(PG8_SB(1, 0), b3, voffB);
            PG8_BAR; PG8_WAIT_L(0); PG8_MMA(0, 1, At, B1); PG8_BAR;
            PG8_LDA(At, 1, 1); PG8_STAGE_A(PG8_SA(1, 0), a3, lui, lu, 0);
            PG8_BAR; PG8_WAIT_L(0); PG8_MMA(1, 0, At, B0); PG8_BAR; PG8_SCHED;
            PG8_STAGE(PG8_SB(1, 1), b3 + hstep, voffB);
            PG8_WAIT_V(6); PG8_BAR; PG8_MMA(1, 1, At, B1); PG8_BAR;
            }
        }
        if constexpr (ALIGN_EPI) { if (wr == 0) PG8_BAR; }
        if constexpr (!Epi::AFTER_DRAIN) { E(acc, cur, wr, wc, fr, fq); S.done(cur); }
        if (!has_next) break;
#pragma unroll
        for (int a = 0; a < 2; ++a)
#pragma unroll
            for (int b = 0; b < 2; ++b)
#pragma unroll
                for (int m = 0; m < 4; ++m)
#pragma unroll
                    for (int n = 0; n < 2; ++n) acc[a][b][m][n] = (f32x4){0.f, 0.f, 0.f, 0.f};
        cur = nxt; cB = nB; ++ui;
        if constexpr (ALIGN_EPI) { if (wr == 1) PG8_BAR; }
    }
    PG8_WAIT_V(0);
    if constexpr (!ALIGN_EPI) { if (wr == 0) PG8_BAR; }
    PG8_BAR;
    if constexpr (Epi::AFTER_DRAIN) { E.fused(acc, cur, wr, wc, fr, fq, lds, wid, lane); S.done(cur); }
#undef PG8_STAGE_A
#undef PG8_SA
#undef PG8_SB
#undef PG8_STAGE
#undef PG8_LDA
#undef PG8_LDB
#undef PG8_MMA
#undef PG8_CAT
#undef PG8_WAIT_V
#undef PG8_WAIT_L
#undef PG8_BAR
#undef PG8_SCHED
}
}

constexpr size_t MiB = 1u << 20;
constexpr size_t WS_CTL = 0, CTL_ZERO_BYTES = 1 * MiB;
constexpr size_t WS_MODP = 1 * MiB;
constexpr size_t WS_MODF = 3 * MiB;
constexpr size_t WS_BIAS = 4 * MiB;
constexpr size_t WS_TOKE = 5 * MiB;
constexpr size_t WS_TOKP = 6 * MiB;
constexpr size_t WS_CNTC = 5 * MiB + 512 * 1024;
constexpr size_t WS_TOKW = 7 * MiB;
constexpr size_t WS_INV = 8 * MiB;
constexpr size_t WS_WIN = 10 * MiB;
constexpr size_t WS_WOUT = 15 * MiB;
constexpr size_t WS_X1 = 32 * MiB;
constexpr size_t WS_XN = 96 * MiB;
constexpr size_t WS_H2 = 128 * MiB;
constexpr size_t WS_PROJ = 160 * MiB;
constexpr size_t WS_O = 232 * MiB;
constexpr size_t WS_WGU = 264 * MiB;
constexpr size_t WS_WD = 392 * MiB;
constexpr size_t WS_ACT = 456 * MiB;
constexpr size_t WS_Y = 600 * MiB;
constexpr size_t WS_END = 744 * MiB;
constexpr int CW_TMO = 0, CW_CODE = 1;
constexpr int CW_CNT = 64;
constexpr int CW_BAR = 4096;
constexpr int CW_KSUM = 16384;
static_assert((CW_KSUM + 64 * 512) * 4 <= (int)CTL_ZERO_BYTES, "CTL region");
constexpr int RING_OFF = 0, RING_BYTES = 131072;
constexpr int LDSCTL_OFF = RING_BYTES, MISC_OFF = LDSCTL_OFF + 320;
constexpr int LDS_TILE_E = LDSCTL_OFF + 512;
constexpr int LDS_NT = LDS_TILE_E + MAXTILES * 4;
constexpr int LDS_TBASE = LDS_NT + 16;
constexpr int LDS_CNTE = LDS_TBASE + 128;
constexpr int LDS_RIDX = LDS_CNTE + 128;
constexpr int LDS_BYTES = 147456;
static_assert(LDS_RIDX % 16 == 0 && LDS_RIDX + 10 * 1024 <= LDS_BYTES, "LDS map");
constexpr int NWAVES = 8;

#define GAS __attribute__((address_space(1)))
#define LAS __attribute__((address_space(3)))
typedef unsigned short bf16;
typedef unsigned v4u __attribute__((ext_vector_type(4)));
typedef float f32x4 __attribute__((ext_vector_type(4)));
typedef short bf16x8 __attribute__((ext_vector_type(8)));
typedef GAS unsigned gu32;
typedef GAS unsigned long long gu64;
#define RLX_AGENT __ATOMIC_RELAXED, __HIP_MEMORY_SCOPE_AGENT
#define LDS_WAIT() asm volatile("s_waitcnt lgkmcnt(0)" ::: "memory")
#define VM_WAIT() asm volatile("s_waitcnt vmcnt(0)" ::: "memory")
__device__ __forceinline__ unsigned long long rt() { return __builtin_amdgcn_s_memrealtime(); }
__device__ __forceinline__ unsigned f2bf(float f) { unsigned u = __builtin_bit_cast(unsigned, f); return (u + 0x7fffu + ((u >> 16) & 1u)) >> 16; }
__device__ __forceinline__ unsigned pk2(float lo, float hi) { return f2bf(lo) | (f2bf(hi) << 16); }

#define XB_TMO      128
#define XB_XCNT(j)  (256  + 64 * (j))
#define XB_XSUB(j)  (1280 + 64 * (j))
#define XB_XGEN(j)  (2304 + 64 * (j))
#define XB_TOP      3328
#define XB_TOPGEN   3392
#define XCD_BAR_WORDS 3456
#define XB_SPIN_CAP (1u << 18)

__device__ __forceinline__ unsigned xb_ld(unsigned* p)              { return __hip_atomic_load(p, __ATOMIC_RELAXED, __HIP_MEMORY_SCOPE_AGENT); }
__device__ __forceinline__ unsigned xb_add(unsigned* p, unsigned v) { return __hip_atomic_fetch_add(p, v, __ATOMIC_RELAXED, __HIP_MEMORY_SCOPE_AGENT); }
__device__ __forceinline__ unsigned xb_xcc_id() { return (unsigned)__builtin_amdgcn_s_getreg((3 << 11) | 20) & 0xFu; }
#define XB_SPIN(cond, bar) do { unsigned _sp = 0; while (cond) { __builtin_amdgcn_s_sleep(1); \
    if ((++_sp & 255u) == 0u) { if (xb_ld(&(bar)[XB_TMO])) break; if (_sp > XB_SPIN_CAP) { atomicAdd(&(bar)[XB_TMO], 1u); break; } } } } while (0)

struct XcdBarrier {
    unsigned* bar; unsigned x;
    volatile LAS unsigned* st;
};

__device__ __forceinline__ XcdBarrier xcd_barrier_post(unsigned* bar, volatile LAS unsigned* st) {
    XcdBarrier b; b.bar = bar; b.x = xb_xcc_id(); b.st = st;
    if (threadIdx.x == 0) (void)xb_add(&bar[XB_XCNT(b.x)], 1u);
    return b;
}
__device__ __forceinline__ void xcd_barrier_complete(unsigned* bar, unsigned x, unsigned& nloc, unsigned& nx) {
    const unsigned G = gridDim.x * gridDim.y * gridDim.z;
    unsigned sum, cnt, mine, sp = 0u;
    for (;;) {
        sum = 0u; cnt = 0u; mine = 0u;
#pragma unroll
        for (unsigned j = 0; j < 16; ++j) { const unsigned c = xb_ld(&bar[XB_XCNT(j)]); sum += c; cnt += (c > 0u) ? 1u : 0u; mine = (j == x) ? c : mine; }
        if (sum == G) break;
        __builtin_amdgcn_s_sleep(1);
        if ((++sp & 255u) == 0u) { if (xb_ld(&bar[XB_TMO])) break; if (sp > XB_SPIN_CAP) { atomicAdd(&bar[XB_TMO], 1u); break; } }
    }
    nloc = mine > 0u ? mine : 1u; nx = cnt > 0u ? cnt : 1u;
}

__device__ __forceinline__ void xcd_barrier(const XcdBarrier& b) {
    asm volatile("s_waitcnt vmcnt(0)" ::: "memory");
    __syncthreads();
    if (threadIdx.x == 0) {
        unsigned* bar = b.bar;
        __builtin_amdgcn_s_waitcnt(0);
        unsigned nloc = b.st[0], nx = b.st[1];
        if (nloc == 0u) { xcd_barrier_complete(bar, b.x, nloc, nx); b.st[0] = nloc; b.st[1] = nx; }
        const unsigned old = xb_add(&bar[XB_XSUB(b.x)], 1u);
        const unsigned gen = old / nloc;
        if (old + 1u == (gen + 1u) * nloc) {
            __builtin_amdgcn_fence(__ATOMIC_RELEASE, "agent");
            asm volatile("s_waitcnt vmcnt(0)" ::: "memory");
            const unsigned og = xb_add(&bar[XB_TOP], 1u);
            const unsigned tg = og / nx;
            if (og + 1u == (tg + 1u) * nx) xb_add(&bar[XB_TOPGEN], 1u);
            else XB_SPIN(xb_ld(&bar[XB_TOPGEN]) == tg, bar);
            __builtin_amdgcn_fence(__ATOMIC_ACQUIRE, "agent");
            xb_add(&bar[XB_XGEN(b.x)], 1u);
            asm volatile("s_waitcnt vmcnt(0)" ::: "memory");
        } else {
            XB_SPIN(xb_ld(&bar[XB_XGEN(b.x)]) == gen, bar);
            __builtin_amdgcn_fence(__ATOMIC_ACQUIRE, "agent");
            asm volatile("s_waitcnt vmcnt(0)" ::: "memory");
        }
    }
    __syncthreads();
}

namespace att {
using bf16x8 = __attribute__((ext_vector_type(8))) short;
using s16x4 = __attribute__((ext_vector_type(4))) short;
using f32x16 = __attribute__((ext_vector_type(16))) float;
using u32x4 = __attribute__((ext_vector_type(4))) unsigned;
typedef unsigned short bf16;
constexpr int PITCH = D_IN, OPITCH = D;
constexpr int NSLOT = 4, SLOTB = 8192;
constexpr int TAB_PAD = 96;
constexpr int LDS_K = 0, LDS_V = NSLOT * SLOTB, LDS_WS = 2 * NSLOT * SLOTB, LDS_OST = LDS_WS + 8 * 64 * 4, LDS_TAB = LDS_OST + 8 * 4096, LDS_KMS = LDS_TAB + (TAB_PAD + SEQ) * 4, LDS_NINF = LDS_KMS + 8 * 64 * 4, LDS_END = LDS_NINF + 64 * 4;
static_assert(LDS_END <= 131072, "attention LDS");
__device__ __forceinline__ int crow(int r, int hi) { return (r & 3) + 8 * (r >> 2) + 4 * hi; }
__device__ __forceinline__ void glds16(const void* gsrc, unsigned lds_dst) { unsigned keep;
  asm volatile("s_mov_b32 %0, m0\n\ts_mov_b32 m0, %2\n\ts_nop 0\n\tglobal_load_lds_dwordx4 %1, off\n\ts_mov_b32 m0, %0" : "=&s"(keep) : "v"(gsrc), "s"(lds_dst) : "memory"); }
typedef float f32x2_t __attribute__((ext_vector_type(2))); typedef __bf16 bf16x2_t __attribute__((ext_vector_type(2)));
__device__ __forceinline__ unsigned cvtpk_s(float lo, float hi) { f32x2_t v = {lo, hi}; bf16x2_t b = __builtin_convertvector(v, bf16x2_t); return __builtin_bit_cast(unsigned, b); }
#define ATT_WAIT_BAR(N) asm volatile("s_waitcnt vmcnt(" #N ") lgkmcnt(0)\n\ts_barrier" ::: "memory")
#define ATT_LBAR() asm volatile("s_waitcnt lgkmcnt(0)\n\ts_barrier" ::: "memory")
typedef float f32x2v __attribute__((ext_vector_type(2)));
__device__ __forceinline__ void bias_loads(f32x2v (&bb)[16], unsigned tba) {
#pragma unroll
  for (int i = 0; i < 16; ++i) { asm volatile("ds_read2_b32 %0, %1 offset0:%c2 offset1:%c3" : "=v"(bb[i]) : "v"(tba), "i"((i >> 3) * 32 + ((2 * i) & 3) + 8 * (((2 * i) & 15) >> 2)), "i"((i >> 3) * 32 + ((2 * i) & 3) + 8 * (((2 * i) & 15) >> 2) + 1) : "memory"); }
}
__device__ __forceinline__ void k_loads(bf16x8 (&kf)[8], unsigned ka) {
#pragma unroll
  for (int i = 0; i < 8; ++i) asm volatile("ds_read_b128 %0, %1 offset:%c2" : "=v"(kf[i]) : "v"(ka), "i"((i >> 1) * 2048 + (i & 1) * 512) : "memory");
}
#define ATT_C16(bb, o) (f32x16){bb[o][0], bb[o][1], bb[o + 1][0], bb[o + 1][1], bb[o + 2][0], bb[o + 2][1], bb[o + 3][0], bb[o + 3][1], bb[o + 4][0], bb[o + 4][1], bb[o + 5][0], bb[o + 5][1], bb[o + 6][0], bb[o + 6][1], bb[o + 7][0], bb[o + 7][1]}
__device__ __forceinline__ void qk_mma(f32x16& p0, f32x16& p1, const bf16x8 (&kf)[8], const bf16x8* qr, const f32x2v (&bb)[16]) {
  p0 = __builtin_amdgcn_mfma_f32_32x32x16_bf16(kf[0], qr[0], ATT_C16(bb, 0), 0, 0, 0); p1 = __builtin_amdgcn_mfma_f32_32x32x16_bf16(kf[1], qr[0], ATT_C16(bb, 8), 0, 0, 0);
#pragma unroll
  for (int d0 = 1; d0 < 4; ++d0) { p0 = __builtin_amdgcn_mfma_f32_32x32x16_bf16(kf[2 * d0], qr[d0], p0, 0, 0, 0); p1 = __builtin_amdgcn_mfma_f32_32x32x16_bf16(kf[2 * d0 + 1], qr[d0], p1, 0, 0, 0); }
}
__device__ __forceinline__ void v_loads(s16x4 (&lo)[2][4], s16x4 (&hi)[2][4], int vb) {
#pragma unroll
  for (int d0 = 0; d0 < 2; ++d0)
#pragma unroll
    for (int ks = 0; ks < 4; ++ks) {
      asm volatile("ds_read_b64_tr_b16 %0,%1 offset:%c2" : "=&v"(lo[d0][ks]) : "v"(vb), "i"(d0 * 4096 + ks * 1024) : "memory");
      asm volatile("ds_read_b64_tr_b16 %0,%1 offset:%c2" : "=&v"(hi[d0][ks]) : "v"(vb), "i"(d0 * 4096 + ks * 1024 + 512) : "memory"); }
}
__device__ __forceinline__ void pv_mma(f32x16* o, const s16x4 (&lo)[2][4], const s16x4 (&hi)[2][4], bf16x8 pa0, bf16x8 pa1, bf16x8 pa2, bf16x8 pa3) {
#define ATT_PK(d, k) (bf16x8){lo[d][k][0], lo[d][k][1], lo[d][k][2], lo[d][k][3], hi[d][k][0], hi[d][k][1], hi[d][k][2], hi[d][k][3]}
#pragma unroll
  for (int d0 = 0; d0 < 2; ++d0) {
    o[d0] = __builtin_amdgcn_mfma_f32_32x32x16_bf16(pa0, ATT_PK(d0, 0), o[d0], 0, 0, 0);
    o[d0] = __builtin_amdgcn_mfma_f32_32x32x16_bf16(pa1, ATT_PK(d0, 1), o[d0], 0, 0, 0);
    o[d0] = __builtin_amdgcn_mfma_f32_32x32x16_bf16(pa2, ATT_PK(d0, 2), o[d0], 0, 0, 0);
    o[d0] = __builtin_amdgcn_mfma_f32_32x32x16_bf16(pa3, ATT_PK(d0, 3), o[d0], 0, 0, 0);
  }
#undef ATT_PK
}
#define ATT_LWAIT(N) do { asm volatile("s_waitcnt lgkmcnt(" #N ")" ::: "memory"); __builtin_amdgcn_sched_barrier(0); } while (0)
struct UnitDesc { int b, qb, moba, qcol, kcol, vcol, ocol, head, fill, fillk, gqa, q0; float sink2; };

__device__ __forceinline__ void attn_unit(const UnitDesc& u, const bf16* P, bf16* O, const float* biasT, const float* ksum, const float* sinks, char* shm) {
  int tid_ = threadIdx.x; asm volatile("" : "+v"(tid_));
  const int tid = tid_, lane = tid & 63, r32 = lane & 31, hi = lane >> 5; const int wid = __builtin_amdgcn_readfirstlane(tid >> 6);
  const long rowbase = (long)u.b * SEQ; const int q0 = u.q0;
  const int wg = u.gqa ? (wid & 3) : 0, wrow = u.gqa ? (wid >> 2) * 32 : wid * 32;
  constexpr int TSW = TAB_PAD + 192;
  const unsigned lds0 = (unsigned)(uintptr_t)shm;
  float* wsf = (float*)(shm + LDS_WS) + wid * 64;
  float* tab = (float*)(shm + LDS_TAB); float* kms = (float*)(shm + LDS_KMS);
  const int tlo = u.moba ? 0 : (q0 < 128 ? 0 : (q0 >> 6) - 2), thi = u.gqa ? (q0 >> 6) : u.qb * 4 + 3;
  const bf16* ksrc = P + (rowbase + lane) * PITCH + u.kcol + wid * 8;
  const bf16* vsrc = P + (rowbase + 16 * (wid & 3) + (lane >> 2)) * PITCH + u.vcol + (wid >> 2) * 32 + (lane & 3) * 8;
  const unsigned kdst = lds0 + LDS_K + wid * 1024, vdst = lds0 + LDS_V + wid * 1024;
#define ATT_DMA(t, slot) do { glds16(ksrc + (long)(t) * 64 * PITCH, (unsigned)__builtin_amdgcn_readfirstlane(kdst + (slot))); glds16(vsrc + (long)(t) * 64 * PITCH, (unsigned)__builtin_amdgcn_readfirstlane(vdst + (slot))); } while (0)
  const unsigned ka0 = lds0 + LDS_K + hi * 1024 + r32 * 16;
  const int vb0 = (int)(lds0 + LDS_V) + ((lane >> 4) & 1) * 32 + (lane & 3) * 8 + (4 * hi + ((lane & 15) >> 2)) * 64;
  ATT_DMA(tlo, 0); ATT_DMA(tlo + 1, SLOTB);
  if (u.fill) {
    if (u.gqa) { for (int i = tid; i < 4 * TSW; i += 512) { const int hh = i / TSW, j = i - hh * TSW; tab[i] = (j >= 192) ? 0.f : biasT[(u.head + hh) * SEQ + 191 - j]; } }
    else for (int i = tid; i < TAB_PAD + SEQ; i += 512) tab[i] = (i >= SEQ) ? 0.f : biasT[u.head * SEQ + SEQ - 1 - i];
    if (tid < 64) ((float*)(shm + LDS_NINF))[tid] = -INFINITY;
  }
  if (u.fillk) kms[tid] = ksum[(size_t)(u.b * 8 + (tid >> 6)) * D_MOBA + u.head * HD + (tid & 63)];
  const bf16* Qw = P + (rowbase + q0 + wrow) * PITCH + u.qcol + wg * HD;
  bf16x8 qr[4];
#pragma unroll
  for (int d0 = 0; d0 < 4; ++d0) qr[d0] = *reinterpret_cast<const bf16x8*>(&Qw[(long)r32 * PITCH + d0 * 16 + hi * 8]);
  if (u.fill || u.fillk) ATT_LBAR();
  unsigned selmask = 0u;
  if (u.moba) {
    if (u.qb <= MB_TOPK) selmask = (1u << u.qb) - 1u;
    else {
      float gate[MB_NB - 1];
#pragma unroll
      for (int n = 0; n < MB_NB - 1; ++n) { float s = 0.f;
        if (n < u.qb) {
#pragma unroll
          for (int d0 = 0; d0 < 4; ++d0)
#pragma unroll
            for (int j = 0; j < 8; ++j) s += __uint_as_float((unsigned)(unsigned short)qr[d0][j] << 16) * kms[n * 64 + d0 * 16 + hi * 8 + j];
          s += __shfl_xor(s, 32); }
        gate[n] = s; }
#pragma unroll
      for (int r = 0; r < MB_TOPK; ++r) { int best = -1; float bv = 0.f;
#pragma unroll
        for (int n = 0; n < MB_NB - 1; ++n) if (n < u.qb && !((selmask >> n) & 1u) && (best < 0 || gate[n] > bv)) { best = n; bv = gate[n]; }
        selmask |= 1u << best; }
    }
  }
  const int qrel = wrow + r32, qpos = q0 + qrel;
  const unsigned tabqa = lds0 + LDS_TAB + (unsigned)((wg * TSW + (u.gqa ? 191 : SEQ - 1) - qpos + 4 * hi) * 4), ninfa = lds0 + LDS_NINF;
  float m = -1e30f, l = 0.f; f32x16 o[2]; o[0] = f32x16{}; o[1] = f32x16{};
  const int wq0 = q0 + wrow;
#define ATT_FLAGS(tt, need_, emask_, lsel_) do { lsel_ = true; \
    if (u.moba) { const int n_ = (tt) >> 2; \
      if (n_ < u.qb) { lsel_ = ((selmask >> n_) & 1u) != 0u; need_ = __any(lsel_); emask_ = false; } \
      else { need_ = (64 * (tt) <= wq0 + 31); emask_ = (64 * (tt) + 63 > wq0); } } \
    else { need_ = (64 * (tt) <= wq0 + 31) && (64 * (tt) + 63 >= wq0 - (SWA_W - 1)); emask_ = (64 * (tt) + 63 > wq0) || (wq0 + 31 - 64 * (tt) >= SWA_W); } } while (0)
#define ATT_QK_LOADS(tt, kslot, lsel_) do { bias_loads(bb, (lsel_) ? tabqa + 256u * (unsigned)(tt) : ninfa); k_loads(kf, ka0 + (kslot)); } while (0)
  const int lim = u.moba ? 0x7fffffff : SWA_W;
  int slotp = 3 * SLOTB, slot = 0, slotn = SLOTB, slotf = 2 * SLOTB;
  f32x16 pc0 = {}, pc1 = {}, pn0 = {}, pn1 = {};
  u32x4 pw0 = {}, pw1 = {}, pw2 = {}, pw3 = {};
  bool needC, emaskC, lselC, needN = false, emaskN = false, lselN = true, needP = false;
  asm volatile("" :: "v"(qr[0]), "v"(qr[1]), "v"(qr[2]), "v"(qr[3]));
  ATT_WAIT_BAR(2);
  ATT_FLAGS(tlo, needC, emaskC, lselC);
  if (needC) { f32x2v bb[16]; bf16x8 kf[8]; ATT_QK_LOADS(tlo, slot, lselC); ATT_LWAIT(0); qk_mma(pc0, pc1, kf, qr, bb); }
  for (int t = tlo; t <= thi; ++t) {
    ATT_WAIT_BAR(0);
    if (t + 2 <= thi) ATT_DMA(t + 2, slotf);
    if (t + 1 <= thi) { ATT_FLAGS(t + 1, needN, emaskN, lselN); } else needN = false;
    if (needN) { f32x2v bb[16]; bf16x8 kf[8]; ATT_QK_LOADS(t + 1, slotn, lselN); ATT_LWAIT(0); qk_mma(pn0, pn1, kf, qr, bb); }
    if (needP) { s16x4 vlo[2][4], vhi[2][4]; v_loads(vlo, vhi, vb0 + slotp); ATT_LWAIT(0); pv_mma(o, vlo, vhi, __builtin_bit_cast(bf16x8, pw0), __builtin_bit_cast(bf16x8, pw1), __builtin_bit_cast(bf16x8, pw2), __builtin_bit_cast(bf16x8, pw3)); }
    __builtin_amdgcn_sched_barrier(0);
    if (needC) {
      f32x16 p0 = pc0, p1 = pc1;
      if (emaskC) { const int dq = qpos - 64 * t - 4 * hi;
#pragma unroll
        for (int r = 0; r < 16; ++r) { const int c = (r & 3) + 8 * (r >> 2);
          p0[r] = ((unsigned)(dq - c) < (unsigned)lim) ? p0[r] : -INFINITY; p1[r] = ((unsigned)(dq - c - 32) < (unsigned)lim) ? p1[r] : -INFINITY; } }
      float rm = fmaxf(p0[0], p1[0]);
#pragma unroll
      for (int r = 1; r < 16; ++r) rm = fmaxf(fmaxf(rm, p0[r]), p1[r]);
      rm = fmaxf(rm, __shfl_xor(rm, 32));
      if (__any(rm > m + 8.0f)) {
        const float mnew = fmaxf(m, rm), alpha = __builtin_amdgcn_exp2f(m - mnew);
        l *= alpha; m = mnew;
        if (hi == 0) wsf[r32] = alpha;
        asm volatile("s_waitcnt lgkmcnt(0)" ::: "memory");
#pragma unroll
        for (int r = 0; r < 16; ++r) { const float f = wsf[crow(r, hi)]; o[0][r] *= f; o[1][r] *= f; }
      }
      float ls = 0.f;
#pragma unroll
      for (int r = 0; r < 16; ++r) { p0[r] = __builtin_amdgcn_exp2f(p0[r] - m); p1[r] = __builtin_amdgcn_exp2f(p1[r] - m); ls += p0[r] + p1[r]; }
      l += ls;
#define ATT_PKW(Pv, B) cvtpk_s(Pv[B], Pv[B + 1])
      pw0 = (u32x4){ATT_PKW(p0, 0), ATT_PKW(p0, 2), ATT_PKW(p0, 4), ATT_PKW(p0, 6)}; pw1 = (u32x4){ATT_PKW(p0, 8), ATT_PKW(p0, 10), ATT_PKW(p0, 12), ATT_PKW(p0, 14)};
      pw2 = (u32x4){ATT_PKW(p1, 0), ATT_PKW(p1, 2), ATT_PKW(p1, 4), ATT_PKW(p1, 6)}; pw3 = (u32x4){ATT_PKW(p1, 8), ATT_PKW(p1, 10), ATT_PKW(p1, 12), ATT_PKW(p1, 14)};
#undef ATT_PKW
    }
    needP = needC; pc0 = pn0; pc1 = pn1; needC = needN; emaskC = emaskN; lselC = lselN;
    { const int s_ = slotp; slotp = slot; slot = slotn; slotn = slotf; slotf = s_; }
  }
  if (needP) { s16x4 vlo[2][4], vhi[2][4]; v_loads(vlo, vhi, vb0 + slotp); ATT_LWAIT(0); pv_mma(o, vlo, vhi, __builtin_bit_cast(bf16x8, pw0), __builtin_bit_cast(bf16x8, pw1), __builtin_bit_cast(bf16x8, pw2), __builtin_bit_cast(bf16x8, pw3)); }
#undef ATT_FLAGS
#undef ATT_QK_LOADS
  l += __shfl_xor(l, 32);
  if (!u.moba) l += __builtin_amdgcn_exp2f((u.gqa ? sinks[u.head - NH_M + wg] * LOG2E : u.sink2) - m);
  if (hi == 0) wsf[32 + r32] = l;
  asm volatile("s_waitcnt lgkmcnt(0)" ::: "memory");
  float rli[16];
#pragma unroll
  for (int r = 0; r < 16; ++r) rli[r] = __builtin_amdgcn_rcpf(wsf[32 + crow(r, hi)]);
  bf16* Ow = O + (rowbase + q0 + wrow) * OPITCH + u.ocol + wg * HD;
  { bf16* stg = (bf16*)(shm + LDS_OST) + wid * 2048;
#pragma unroll
    for (int r = 0; r < 16; ++r) { const int orow = crow(r, hi);
#pragma unroll
      for (int d0 = 0; d0 < 2; ++d0) stg[orow * 64 + d0 * 32 + r32] = (bf16)(cvtpk_s(o[d0][r] * rli[r], 0.f) & 0xffffu); }
    asm volatile("s_waitcnt lgkmcnt(0)" ::: "memory");
#pragma unroll
    for (int i = 0; i < 4; ++i) { const int row = i * 8 + (lane >> 3), ch = lane & 7; const u32x4 v = *(const u32x4*)(stg + row * 64 + ch * 8); *(u32x4*)(Ow + (long)row * OPITCH + ch * 8) = v; } }
  ATT_LBAR();
#undef ATT_DMA
}
}

struct Frame {
    LAS unsigned char* lds;
    volatile LAS unsigned* MISC;
    gu32* ctl;
    int tid, lane, wave, vcu, G;
};
__device__ __forceinline__ float wave_sum(float v) {
#pragma unroll
    for (int o = 1; o < 64; o <<= 1) v += __shfl_xor(v, o);
    return v;
}
__device__ __forceinline__ int rel_bucket(int dist) {
    const int n = dist > 0 ? dist : 0;
    if (n < 16) return n;
    const int th[15] = {21, 27, 35, 46, 59, 77, 99, 128, 166, 216, 280, 363, 470, 609, 790};
    int bk = 16;
#pragma unroll
    for (int i = 0; i < 15; ++i) bk += (n >= th[i]) ? 1 : 0;
    return bk;
}
__device__ __forceinline__ void p0_transpose_item(const float* W, int K, int N, bf16* WT, int k0, int n0, int dst_row0, LAS float* scr, int lane) {
    { float v[32]; const float* wp = W + (size_t)(k0 + (lane >> 5)) * N + n0 + (lane & 31);
#pragma unroll
        for (int i = 0; i < 32; ++i) v[i] = __builtin_nontemporal_load(wp + (size_t)(2 * i) * N);
#pragma unroll
        for (int i = 0; i < 32; ++i) scr[(2 * i + (lane >> 5)) * 33 + (lane & 31)] = v[i]; }
    LDS_WAIT(); asm volatile("" ::: "memory");
    const int c = lane & 7;
#pragma unroll
    for (int j = 0; j < 4; ++j) { const int n = (lane >> 3) + 8 * j; const LAS float* s = scr + (8 * c) * 33 + n;
        v4u o; o.x = pk2(s[0 * 33], s[1 * 33]); o.y = pk2(s[2 * 33], s[3 * 33]); o.z = pk2(s[4 * 33], s[5 * 33]); o.w = pk2(s[6 * 33], s[7 * 33]);
        *(GAS v4u*)(WT + (size_t)(dst_row0 + n) * K + k0 + 8 * c) = o; }
    LDS_WAIT(); asm volatile("" ::: "memory");
}
__device__ __forceinline__ void p0_transpose_item_f8(const float* W, int K, int N, unsigned char* WT, int k0, int n0, int dst_row0, LAS float* scr, int lane) {
    v4u o[2][2];
    const int c = lane & 3;
#pragma unroll
    for (int hf = 0; hf < 2; ++hf) {
        { float v[32]; const float* wp = W + (size_t)(k0 + 64 * hf + (lane >> 5)) * N + n0 + (lane & 31);
#pragma unroll
            for (int i = 0; i < 32; ++i) v[i] = __builtin_nontemporal_load(wp + (size_t)(2 * i) * N);
#pragma unroll
            for (int i = 0; i < 32; ++i) scr[(2 * i + (lane >> 5)) * 33 + (lane & 31)] = v[i]; }
        LDS_WAIT(); asm volatile("" ::: "memory");
#pragma unroll
        for (int j = 0; j < 2; ++j) { const int n = (lane >> 2) + 16 * j; const LAS float* s = scr + (16 * c) * 33 + n;
            o[hf][j].x = pg8::pk4_f8(s[0 * 33] * WSCALE, s[1 * 33] * WSCALE, s[2 * 33] * WSCALE, s[3 * 33] * WSCALE); o[hf][j].y = pg8::pk4_f8(s[4 * 33] * WSCALE, s[5 * 33] * WSCALE, s[6 * 33] * WSCALE, s[7 * 33] * WSCALE);
            o[hf][j].z = pg8::pk4_f8(s[8 * 33] * WSCALE, s[9 * 33] * WSCALE, s[10 * 33] * WSCALE, s[11 * 33] * WSCALE); o[hf][j].w = pg8::pk4_f8(s[12 * 33] * WSCALE, s[13 * 33] * WSCALE, s[14 * 33] * WSCALE, s[15 * 33] * WSCALE); }
        LDS_WAIT(); asm volatile("" ::: "memory");
    }
#pragma unroll
    for (int j = 0; j < 2; ++j) { const int n = (lane >> 2) + 16 * j; unsigned char* rp = WT + (size_t)(dst_row0 + n) * K + k0 + 16 * c;
        *(GAS v4u*)(rp) = o[0][j]; *(GAS v4u*)(rp + 64) = o[1][j]; }
}
__device__ __forceinline__ void conv_load_half(f32x4 (&x)[16], const float* src, int N, int hf, int lane) {
    const int q = lane >> 4, m = lane & 15; const float* sp = src + (size_t)(hf * 64 + 4 * q) * N + 4 * m;
#pragma unroll
    for (int g = 0; g < 4; ++g)
#pragma unroll
        for (int i = 0; i < 4; ++i) x[g * 4 + i] = __builtin_nontemporal_load((const f32x4*)(sp + (size_t)(16 * g + i) * N));
}
__device__ __forceinline__ void conv_cvt_half(const f32x4 (&x)[16], LAS unsigned* t8, int hf, int lane) {
    const int q = lane >> 4, m = lane & 15;
#pragma unroll
    for (int g = 0; g < 4; ++g)
#pragma unroll
        for (int j = 0; j < 4; ++j) t8[(4 * m + j) * 33 + hf * 16 + 4 * g + q] = pg8::pk4_f8(x[g * 4 + 0][j] * WSCALE, x[g * 4 + 1][j] * WSCALE, x[g * 4 + 2][j] * WSCALE, x[g * 4 + 3][j] * WSCALE);
}
__device__ __forceinline__ void conv_store(unsigned char* dst, const LAS unsigned* t8, int lane) {
#pragma unroll
    for (int jj = 0; jj < 8; ++jj) { const int n = (lane >> 3) + 8 * jj, c = lane & 7; const LAS unsigned* rp = t8 + n * 33 + 4 * c;
        *(GAS v4u*)(dst + (size_t)n * 1024 + 16 * c) = (v4u){rp[0], rp[1], rp[2], rp[3]}; }
}
struct Args { const float* in[19]; float* out; unsigned char* ws; int ph_lo, ph_hi; };

__device__ __forceinline__ void p0_prologue(Frame& F, const Args& a) {
    LAS float* scr = (LAS float*)(F.lds + RING_OFF + F.wave * 16384);
    const int gw = F.vcu * NWAVES + F.wave, NGW = F.G * NWAVES;
    const float* w_in = a.in[5]; const float* w_out = a.in[7];
    bf16* Win_t = (bf16*)(a.ws + WS_WIN); bf16* Wout_t = (bf16*)(a.ws + WS_WOUT);
    constexpr int I_IN = 16 * (D_IN / 32), I_OUT = 16 * (D / 32), I_MOD = 96 * 8, I_BIAS = 16 * SEQ / 64;
    constexpr int NITEMS = I_IN + I_OUT + I_MOD + I_BIAS;
    for (int it = gw; it < NITEMS; it += NGW) {
        int r = it;
        if (r < I_MOD) {
            const int cc = r % 96, ks = r / 96, j = cc * 64 + F.lane;
            const float* c = a.in[1]; const float* w_ada = a.in[3];
            { const int b = F.lane >> 3, kq = (F.lane & 7) * 16;
#pragma unroll
                for (int i = 0; i < 16; ++i) { const float cv = c[b * D + ks * 128 + kq + i]; scr[b * 128 + kq + i] = cv / (1.f + expf(-cv)); } }
            LDS_WAIT(); asm volatile("" ::: "memory");
            float acc[BATCH];
#pragma unroll
            for (int b = 0; b < BATCH; ++b) acc[b] = 0.f;
            const float* wp = w_ada + (size_t)(ks * 128) * (6 * D) + j;
#pragma unroll 1
            for (int k0 = 0; k0 < 128; k0 += 16) { float w[16];
#pragma unroll
                for (int i = 0; i < 16; ++i) w[i] = wp[(size_t)(k0 + i) * (6 * D)];
#pragma unroll
                for (int i = 0; i < 16; ++i)
#pragma unroll
                    for (int b = 0; b < BATCH; ++b) acc[b] += scr[b * 128 + k0 + i] * w[i]; }
            LDS_WAIT(); asm volatile("" ::: "memory");
            float* mp = (float*)(a.ws + WS_MODP) + (size_t)ks * BATCH * 6 * D;
#pragma unroll
            for (int b = 0; b < BATCH; ++b) mp[(size_t)b * 6 * D + j] = acc[b];
            continue;
        }
        r -= I_MOD;
        if (r < I_BIAS) { const int i = r * 64 + F.lane, h = i / SEQ, d = i % SEQ; ((float*)(a.ws + WS_BIAS))[i] = a.in[9][rel_bucket(d) * 16 + h] * LOG2E; continue; }
        r -= I_BIAS;
        if (r < I_IN) { const int nb = r % (D_IN / 32), kb = r / (D_IN / 32); p0_transpose_item(w_in, D, D_IN, Win_t, kb * 64, nb * 32, nb * 32, scr, F.lane); continue; }
        r -= I_IN;
        { const int nb = r % (D / 32), kb = r / (D / 32); p0_transpose_item(w_out, D, D, Wout_t, kb * 64, nb * 32, nb * 32, scr, F.lane); }
    }
}
constexpr int CV_GU = NE * 8 * (2 * DFF / 64), CV_DN = NE * 8 * (D / 64), CV_ITEMS = CV_GU + CV_DN;
struct ConvItem { const float* src; unsigned char* dst; int N; };
__device__ __forceinline__ ConvItem conv_addr(const Args& a, int r) {
    const float* w_gu = a.in[14]; const float* w_down = a.in[16]; unsigned char* Wgu_t = a.ws + WS_WGU; unsigned char* Wd_t = a.ws + WS_WD; ConvItem c;
    if (r < CV_GU) { const int per = 8 * (2 * DFF / 64), e = r / per, q = r % per, nb = q % (2 * DFF / 64), kb = q / (2 * DFF / 64), n0 = nb * 64;
        const int drow = (n0 < DFF) ? ((n0 >> 7) * 256 + (n0 & 127)) : (((n0 - DFF) >> 7) * 256 + 128 + ((n0 - DFF) & 127));
        c.src = w_gu + (size_t)e * D * 2 * DFF + (size_t)(kb * 128) * (2 * DFF) + n0; c.N = 2 * DFF; c.dst = Wgu_t + (size_t)e * 2 * DFF * D + (size_t)drow * D + kb * 128; }
    else { const int rr = r - CV_GU, per = 8 * (D / 64), e = rr / per, q = rr % per, nb = q % (D / 64), kb = q / (D / 64), n0 = nb * 64;
        c.src = w_down + (size_t)e * DFF * D + (size_t)(kb * 128) * D + n0; c.N = D; c.dst = Wd_t + (size_t)e * D * DFF + (size_t)n0 * DFF + kb * 128; }
    return c;
}
__device__ __forceinline__ void conv_range(Frame& F, const Args& a, int lo, int hi, int first, int stride) {
    LAS unsigned* scr = (LAS unsigned*)(F.lds + RING_OFF + F.wave * 16384);
    int r = lo + first; if (r >= hi) return;
    ConvItem cur = conv_addr(a, r);
    f32x4 xa[16], xb[16];
    conv_load_half(xa, cur.src, cur.N, 0, F.lane); conv_load_half(xb, cur.src, cur.N, 1, F.lane);
#pragma unroll 1
    for (;;) {
        const int rn = r + stride; const bool more = rn < hi;
        const ConvItem nxt = conv_addr(a, more ? rn : r);
        conv_cvt_half(xa, scr, 0, F.lane); conv_load_half(xa, nxt.src, nxt.N, 0, F.lane);
        conv_cvt_half(xb, scr, 1, F.lane); conv_load_half(xb, nxt.src, nxt.N, 1, F.lane);
        LDS_WAIT(); asm volatile("" ::: "memory");
        conv_store(cur.dst, scr, F.lane);
        LDS_WAIT(); asm volatile("" ::: "memory");
        if (!more) break;
        cur = nxt; r = rn;
    }
}
__device__ __forceinline__ void p1_xn(Frame& F, const Args& a) {
    const float* modp = (const float*)(a.ws + WS_MODP); const float* b_ada = a.in[4]; float* modf = (float*)(a.ws + WS_MODF);
    for (int i = blockIdx.x * 512 + F.tid; i < BATCH * 6 * D; i += F.G * 512) { float s = b_ada[i % (6 * D)];
#pragma unroll
        for (int ks = 0; ks < 8; ++ks) s += modp[(size_t)ks * BATCH * 6 * D + i];
        modf[i] = s; }
    LAS float* tab = (LAS float*)(F.lds + RING_OFF);
    const float* x = a.in[0]; const float* g = a.in[2]; bf16* XN = (bf16*)(a.ws + WS_XN);
    for (int chunk = blockIdx.x; chunk < NTOK / 64; chunk += F.G) {
        const int b = chunk / (SEQ / 64);
        __syncthreads();
        for (int i = F.tid; i < 2 * D; i += 512) { const int col = i & (D - 1), chunkid = (i < D) ? 1 : 0; float s = b_ada[chunkid * D + col];
#pragma unroll
            for (int ks = 0; ks < 8; ++ks) s += modp[(size_t)ks * BATCH * 6 * D + (size_t)b * 6 * D + chunkid * D + col];
            tab[i] = (i < D) ? g[col] * (1.f + s) : s; }
        __syncthreads();
        for (int rr = F.wave; rr < 64; rr += 4 * NWAVES) {
            f32x4 v[4][4]; float s[4];
#pragma unroll
            for (int q = 0; q < 4; ++q) { const GAS f32x4* xr = (const GAS f32x4*)(x + (size_t)(chunk * 64 + rr + q * NWAVES) * D) + F.lane;
#pragma unroll
                for (int j = 0; j < 4; ++j) v[q][j] = xr[64 * j]; }
#pragma unroll
            for (int q = 0; q < 4; ++q) { s[q] = 0.f;
#pragma unroll
                for (int j = 0; j < 4; ++j) s[q] += (v[q][j].x * v[q][j].x + v[q][j].y * v[q][j].y) + (v[q][j].z * v[q][j].z + v[q][j].w * v[q][j].w); }
#pragma unroll
            for (int q = 0; q < 4; ++q) { const float rstd = 1.f / sqrtf(wave_sum(s[q]) * (1.f / D) + EPS);
                GAS unsigned long long* o8 = (GAS unsigned long long*)(XN + (size_t)(chunk * 64 + rr + q * NWAVES) * D) + F.lane;
#pragma unroll
                for (int j = 0; j < 4; ++j) { const int col = 4 * F.lane + 256 * j; const f32x4 gs = *(const LAS f32x4*)(tab + col), sh = *(const LAS f32x4*)(tab + D + col);
                    const f32x4 h = v[q][j] * rstd * gs + sh;
                    o8[64 * j] = (unsigned long long)pk2(h.x, h.y) | ((unsigned long long)pk2(h.z, h.w) << 32); } }
        }
    }
}

__device__ __forceinline__ void p5_router(Frame& F, const Args& a) {
    typedef __attribute__((ext_vector_type(8))) short bx8; typedef __attribute__((ext_vector_type(16))) float fx16;
    const unsigned short* x1 = (const unsigned short*)(a.ws + WS_X1); const float* modf = (const float*)(a.ws + WS_MODF); const float* g_ffn = a.in[11]; const float* w_router = a.in[12]; const float* b_router = a.in[13];
    unsigned char* H2 = a.ws + WS_H2; int* inv = (int*)(a.ws + WS_INV); float* tok_w = (float*)(a.ws + WS_TOKW);
    LAS float* part = (LAS float*)(F.lds + RING_OFF);
    LAS float* ssq = (LAS float*)(F.lds + RING_OFF + 32768);
    LAS float* cpart = (LAS float*)(F.lds + RING_OFF + 32768 + 1024);
    LAS float* lg = (LAS float*)(F.lds + RING_OFF + 32768 + 3072);
    LAS float* rs = (LAS float*)(F.lds + RING_OFF + 32768 + 3072 + 4352);
    LAS int* cb = (LAS int*)(F.lds + RING_OFF + 32768 + 3072 + 4352 + 128);
    LAS float* gsl = (LAS float*)(F.lds + RING_OFF + 49152);
    LAS float* shl = (LAS float*)(F.lds + RING_OFF + 49152 + 4096);
    const int lane = F.lane, w = F.wave, r32 = lane & 31, hi = lane >> 5;
#pragma unroll 1
    for (int chunk = blockIdx.x; chunk < NTOK / 64; chunk += F.G) {
        const int b = chunk / (SEQ / 64);
        __syncthreads();
        for (int i = F.tid; i < D; i += NWAVES * 64) { gsl[i] = g_ffn[i] * (1.f + modf[(size_t)b * 6 * D + 4 * D + i]); shl[i] = modf[(size_t)b * 6 * D + 3 * D + i]; }
        if (F.tid < NE) cb[F.tid] = 0;
        __syncthreads();
        bx8 ahi[8], alo[8]; float cp = 0.f;
        const float* wrp = w_router + (size_t)(128 * w + 8 * hi) * NE + r32; const LAS float* gsp = gsl + 128 * w + 8 * hi; const LAS float* shp = shl + 128 * w + 8 * hi;
#pragma unroll
        for (int s = 0; s < 8; ++s) {
            unsigned ph[4], pl[4];
#pragma unroll
            for (int j2 = 0; j2 < 4; ++j2) { float v[2];
#pragma unroll
                for (int q = 0; q < 2; ++q) { const int kk = 16 * s + 2 * j2 + q; const float wr_ = wrp[kk * NE]; cp += shp[kk] * wr_; v[q] = gsp[kk] * wr_; }
                const unsigned h0 = f2bf(v[0]), h1 = f2bf(v[1]); ph[j2] = h0 | (h1 << 16);
                pl[j2] = f2bf(v[0] - __uint_as_float(h0 << 16)) | (f2bf(v[1] - __uint_as_float(h1 << 16)) << 16); }
            ahi[s] = __builtin_bit_cast(bx8, (v4u){ph[0], ph[1], ph[2], ph[3]}); alo[s] = __builtin_bit_cast(bx8, (v4u){pl[0], pl[1], pl[2], pl[3]});
        }
        cpart[(w * 2 + hi) * 32 + r32] = cp;
#pragma unroll 1
        for (int pass = 0; pass < 2; ++pass) {
            const int tok = chunk * 64 + pass * 32 + r32;
            const unsigned short* xr = x1 + (size_t)tok * D + 128 * w + 8 * hi;
            float ss = 0.f; fx16 acc = {};
#pragma unroll
            for (int s = 0; s < 8; ++s) {
                const v4u xw = *(const GAS v4u*)(xr + 16 * s);
#pragma unroll
                for (int q = 0; q < 4; ++q) { const float v0 = __uint_as_float(xw[q] << 16), v1 = __uint_as_float(xw[q] & 0xffff0000u); ss += v0 * v0 + v1 * v1; }
                const bx8 bhi = __builtin_bit_cast(bx8, xw);
                acc = __builtin_amdgcn_mfma_f32_32x32x16_bf16(ahi[s], bhi, acc, 0, 0, 0);
                acc = __builtin_amdgcn_mfma_f32_32x32x16_bf16(alo[s], bhi, acc, 0, 0, 0);
            }
            ss += __shfl_xor(ss, 32);
            __syncthreads();
#pragma unroll
            for (int r = 0; r < 16; ++r) part[(w * 32 + ((r & 3) + 8 * (r >> 2) + 4 * hi)) * 32 + r32] = acc[r];
            if (hi == 0) ssq[w * 32 + r32] = ss;
            __syncthreads();
            { const int tk = F.tid & 31, eg = F.tid >> 5;
                float sq = 0.f;
#pragma unroll
                for (int ww = 0; ww < 8; ++ww) sq += ssq[ww * 32 + tk];
                const float rstd = 1.f / sqrtf(sq * (1.f / D) + EPS);
                if (eg == 0) rs[tk] = rstd;
#pragma unroll
                for (int q = 0; q < 2; ++q) { const int e = 2 * eg + q; float sum = 0.f, c = b_router[e];
#pragma unroll
                    for (int ww = 0; ww < 8; ++ww) sum += part[(ww * 32 + e) * 32 + tk];
#pragma unroll
                    for (int ww = 0; ww < 16; ++ww) c += cpart[ww * 32 + e];
                    lg[tk * 33 + e] = rstd * sum + c; } }
            __syncthreads();
            { const float rstd = rs[r32]; unsigned char* hr = H2 + (size_t)tok * D + 128 * w + 8 * hi;
#pragma unroll
                for (int s = 0; s < 8; ++s) { unsigned pk[2]; const v4u xw = *(const GAS v4u*)(xr + 16 * s);
#pragma unroll
                    for (int q = 0; q < 2; ++q) { const f32x4 xv = {__uint_as_float(xw[2 * q] << 16), __uint_as_float(xw[2 * q] & 0xffff0000u), __uint_as_float(xw[2 * q + 1] << 16), __uint_as_float(xw[2 * q + 1] & 0xffff0000u)};
                        const f32x4 g4 = *(const LAS f32x4*)(gsp + 16 * s + 4 * q), h4 = *(const LAS f32x4*)(shp + 16 * s + 4 * q);
                        const f32x4 hv = xv * rstd * g4 + h4; pk[q] = pg8::pk4_f8(hv.x, hv.y, hv.z, hv.w); }
                    *(GAS unsigned long long*)(hr + 16 * s) = (unsigned long long)pk[0] | ((unsigned long long)pk[1] << 32); } }
            if (w == 0 && lane < 32) {
                float lgv[NE];
#pragma unroll
                for (int i = 0; i < NE; ++i) lgv[i] = lg[lane * 33 + i];
                int idx[TOPK]; float val[TOPK]; unsigned used = 0;
#pragma unroll
                for (int r = 0; r < TOPK; ++r) { int best = -1; float bv = 0.f;
#pragma unroll
                    for (int i = 0; i < NE; ++i) if (!((used >> i) & 1u) && (best < 0 || lgv[i] > bv)) { best = i; bv = lgv[i]; }
                    used |= 1u << best; idx[r] = best; val[r] = bv; }
                float wsum = 0.f, wv[TOPK];
#pragma unroll
                for (int r = 0; r < TOPK; ++r) { wv[r] = __expf(val[r] - val[0]); wsum += wv[r]; }
                const int tk = chunk * 64 + pass * 32 + lane; const float inv_ws = 1.f / wsum;
                const unsigned selbits = (1u << idx[0]) | (1u << idx[1]) | (1u << idx[2]) | (1u << idx[3]);
                int rk[TOPK] = {0, 0, 0, 0};
#pragma unroll 1
                for (int e = 0; e < NE; ++e) {
                    const unsigned long long mm = __ballot((selbits >> e) & 1u);
                    const int base = cb[e], rnk = base + __popcll(mm & ((1ull << lane) - 1ull));
#pragma unroll
                    for (int r = 0; r < TOPK; ++r) if (idx[r] == e) rk[r] = rnk;
                    if (lane == 0) cb[e] = base + __popcll(mm);
                }
#pragma unroll
                for (int r = 0; r < TOPK; ++r) { inv[((size_t)chunk * NE + idx[r]) * 64 + rk[r]] = tk * 4 + r; tok_w[tk * 4 + r] = wv[r] * inv_ws; }
            }
        }
        if (w == 0 && lane < NE) ((int*)(a.ws + WS_CNTC))[lane * 256 + chunk] = cb[lane];
    }
}
__device__ __forceinline__ void build_tiles(Frame& F, const Args& a) {
    LAS int* tile_e = (LAS int*)(F.lds + LDS_TILE_E); LAS int* ntl = (LAS int*)(F.lds + LDS_NT); LAS int* tbase = (LAS int*)(F.lds + LDS_TBASE); LAS int* cnte = (LAS int*)(F.lds + LDS_CNTE);
    LAS int* pre = (LAS int*)(F.lds + RING_OFF);
    __syncthreads();
    { const int e = F.tid >> 4, part = F.tid & 15; const int* cp = (const int*)(a.ws + WS_CNTC) + e * 256 + part * 16;
        int v[16]; int sum = 0;
#pragma unroll
        for (int q = 0; q < 4; ++q) { const int4 t4 = *(const int4*)(cp + 4 * q); v[4 * q] = t4.x; v[4 * q + 1] = t4.y; v[4 * q + 2] = t4.z; v[4 * q + 3] = t4.w; }
#pragma unroll
        for (int q = 0; q < 16; ++q) { const int t = v[q]; v[q] = sum; sum += t; }
        int inc = sum;
#pragma unroll
        for (int d = 1; d < 16; d <<= 1) { const int n = __shfl_up(inc, d, 16); if (part >= d) inc += n; }
        const int excl = inc - sum;
#pragma unroll
        for (int q = 0; q < 16; ++q) pre[e * 256 + part * 16 + q] = excl + v[q];
        if (part == 15) cnte[e] = inc; }
    __syncthreads();
    if (F.tid == 0) { int base = 0;
        for (int e = 0; e < NE; ++e) { const int nt = (cnte[e] + 255) >> 8; tbase[e] = base; for (int j = 0; j < nt; ++j) tile_e[base + j] = e; base += nt; }
        ntl[0] = base; }
    __syncthreads();
}
__device__ __forceinline__ void p8_final(Frame& F, const Args& a) {
    const unsigned short* x1 = (const unsigned short*)(a.ws + WS_X1); const unsigned char* Y = a.ws + WS_Y; const float* modf = (const float*)(a.ws + WS_MODF);
    const int* tok_slot = (const int*)(a.ws + WS_TOKP); const float* tok_w = (const float*)(a.ws + WS_TOKW);
    const float* gfin = a.in[18];
    const int gw = F.vcu * NWAVES + F.wave, NGW = F.G * NWAVES;
    constexpr int P8R = 4;
    typedef int i32x4 __attribute__((ext_vector_type(4)));
    i32x4 np[P8R]; f32x4 nw[P8R];
#define P8_ROUTE(r0) do { _Pragma("unroll") for (int _q = 0; _q < P8R; ++_q) { const int _r = (r0) + _q * NGW; if (_r < NTOK) { np[_q] = *(const GAS i32x4*)(tok_slot + _r * 4); nw[_q] = *(const GAS f32x4*)(tok_w + _r * 4); } } } while (0)
    P8_ROUTE(gw);
    for (int row0 = gw; row0 < NTOK; row0 += P8R * NGW) {
        i32x4 cp[P8R]; f32x4 cw[P8R];
#pragma unroll
        for (int q = 0; q < P8R; ++q) { cp[q] = np[q]; cw[q] = nw[q]; }
        unsigned yv[P8R][TOPK][4]; pg8::u32x2 xv[P8R][4];
#pragma unroll
        for (int q = 0; q < P8R; ++q) { const int row = row0 + q * NGW; if (row < NTOK) {
#pragma unroll
            for (int k = 0; k < TOPK; ++k) { const int slot = __builtin_amdgcn_readfirstlane(cp[q][k]);
                const GAS unsigned* yr = (const GAS unsigned*)(Y + (size_t)slot * D) + F.lane;
#pragma unroll
                for (int j = 0; j < 4; ++j) yv[q][k][j] = yr[64 * j]; }
            const GAS pg8::u32x2* xr = (const GAS pg8::u32x2*)(x1 + (size_t)row * D) + F.lane;
#pragma unroll
            for (int j = 0; j < 4; ++j) xv[q][j] = xr[64 * j]; } }
        P8_ROUTE(row0 + P8R * NGW);
#pragma unroll
        for (int q = 0; q < P8R; ++q) { const int row = row0 + q * NGW; if (row < NTOK) {
            const int b = row / SEQ; const float* gf = modf + (size_t)b * 6 * D + 5 * D;
            f32x4 acc[4];
#pragma unroll
            for (int j = 0; j < 4; ++j) acc[j] = (f32x4){0.f, 0.f, 0.f, 0.f};
#pragma unroll
            for (int k = 0; k < TOPK; ++k) { const float wk = cw[q][k] * (1.0f / YSCALE);
#pragma unroll
                for (int j = 0; j < 4; ++j) { const int qq = (int)yv[q][k][j]; const auto lo = __builtin_amdgcn_cvt_pk_f32_fp8(qq, false), hi = __builtin_amdgcn_cvt_pk_f32_fp8(qq, true);
                    acc[j].x += wk * lo[0]; acc[j].y += wk * lo[1]; acc[j].z += wk * hi[0]; acc[j].w += wk * hi[1]; } }
            float s = 0.f; f32x4 v[4];
#pragma unroll
            for (int j = 0; j < 4; ++j) { const f32x4 g4 = *(const GAS f32x4*)(gf + 4 * F.lane + 256 * j); const f32x4 x4 = {__uint_as_float(xv[q][j].x << 16), __uint_as_float(xv[q][j].x & 0xffff0000u), __uint_as_float(xv[q][j].y << 16), __uint_as_float(xv[q][j].y & 0xffff0000u)}; v[j] = x4 + g4 * acc[j]; s += (v[j].x * v[j].x + v[j].y * v[j].y) + (v[j].z * v[j].z + v[j].w * v[j].w); }
            const float rstd = 1.f / sqrtf(wave_sum(s) * (1.f / D) + EPS);
            GAS f32x4* orow = (GAS f32x4*)(a.out + (size_t)row * D) + F.lane;
#pragma unroll
            for (int j = 0; j < 4; ++j) { const f32x4 g4 = *(const GAS f32x4*)(gfin + 4 * F.lane + 256 * j); orow[64 * j] = v[j] * rstd * g4; } } }
    }
#undef P8_ROUTE
}
__device__ __forceinline__ void build_ridx(Frame& F, const Args& a, int nN) {
    const LAS int* tile_e = (const LAS int*)(F.lds + LDS_TILE_E); const LAS int* tbase = (const LAS int*)(F.lds + LDS_TBASE); const LAS int* cnte = (const LAS int*)(F.lds + LDS_CNTE);
    const LAS int* pre = (const LAS int*)(F.lds + RING_OFF); const int ntiles = *(const LAS int*)(F.lds + LDS_NT);
    LAS int* ridx = (LAS int*)(F.lds + LDS_RIDX); const int* lists = (const int*)(a.ws + WS_INV); int* tok_slot = (int*)(a.ws + WS_TOKP);
    int adr[5], slot[5], flag[5];
#pragma unroll
    for (int k = 0; k < 5; ++k) { const int it = F.tid + k * (NWAVES * 64), i = it >> 8, r = it & 255; int t, pn_; flag[k] = 0; adr[k] = 0; slot[k] = 0;
        if (pg8::moe_unit(i, (int)blockIdx.x, F.G, nN, cnte, tbase, ntiles, t, pn_)) {
            const int e = tile_e[t], j = t - tbase[e], c = cnte[e]; int pos = j * 256 + r; const bool real = pos < c; if (!real) pos = 0;
            int lo = 0;
#pragma unroll
            for (int st = 128; st >= 1; st >>= 1) if (pre[e * 256 + lo + st] <= pos) lo += st;
            adr[k] = (lo * NE + e) * 64 + (pos - pre[e * 256 + lo]); slot[k] = t * 256 + r; flag[k] = (pn_ == 0 && real) ? 2 : 1; } }
    int ent[5];
#pragma unroll
    for (int k = 0; k < 5; ++k) ent[k] = flag[k] ? lists[adr[k]] : 0;
#pragma unroll
    for (int k = 0; k < 5; ++k) if (flag[k]) { ridx[F.tid + k * (NWAVES * 64)] = ent[k] >> 2; if (flag[k] == 2) tok_slot[ent[k]] = slot[k]; }
    __syncthreads();
}

__global__ void __launch_bounds__(NWAVES * 64, 2) mega_fwd(Args args) {
    extern __shared__ __attribute__((aligned(16))) unsigned char lds[];
    Frame F;
    F.lds = (LAS unsigned char*)lds;
    F.MISC = (volatile LAS unsigned*)(F.lds + MISC_OFF);
    F.tid = threadIdx.x; F.lane = F.tid & 63; F.wave = __builtin_amdgcn_readfirstlane(F.tid >> 6);
    F.G = gridDim.x; { const int bx = blockIdx.x; F.vcu = (F.G % 8 == 0) ? (bx % 8) * (F.G / 8) + bx / 8 : bx; }
    unsigned char* ws = args.ws;
    F.ctl = (gu32*)(ws + WS_CTL);
    for (int u = F.tid; u < 512 / 4; u += NWAVES * 64) ((LAS unsigned*)(F.lds + LDSCTL_OFF))[u] = 0u;
    __syncthreads();
    XcdBarrier bar = xcd_barrier_post((unsigned*)(F.ctl + CW_BAR), F.MISC + 8);
    const int lo = args.ph_lo, hi = args.ph_hi;
#ifndef PHASE_MASK
#define PHASE_MASK 0x1ff
#endif
#define IN(k) (((PHASE_MASK >> (k)) & 1) && lo <= (k) && (k) < hi)
#define BOTH(k) (IN(k) && IN((k) + 1))
#define GRID_BAR() xcd_barrier(bar)
#define REFRESH() do { int t_ = threadIdx.x; asm volatile("" : "+v"(t_)); F.tid = t_; F.lane = t_ & 63; F.wave = __builtin_amdgcn_readfirstlane(t_ >> 6); } while (0)
    const bool split = (F.G == 256); constexpr int NCONV = 64, NCONV3 = 64;
    const bool is_conv = split && (int)blockIdx.x >= F.G - NCONV, is_conv3 = split && (int)blockIdx.x >= F.G - NCONV3;
    const int NC = split ? F.G - NCONV : F.G, NC3 = split ? F.G - NCONV3 : F.G, cidx = (int)blockIdx.x;
    const int nconvw = (split ? NCONV : F.G) * NWAVES, convw = (split ? (int)blockIdx.x - (F.G - NCONV) : (int)blockIdx.x) * NWAVES;
    const int nconvw3 = (split ? NCONV3 : F.G) * NWAVES, convw3 = (split ? (int)blockIdx.x - (F.G - NCONV3) : (int)blockIdx.x) * NWAVES;
    constexpr int CV_SPLIT = 4096;
    if (IN(0)) { p0_prologue(F, args); if (!split) conv_range(F, args, 0, CV_ITEMS, F.vcu * NWAVES + F.wave, F.G * NWAVES); if (BOTH(0)) GRID_BAR(); }
    if (IN(1)) { REFRESH(); p1_xn(F, args); if (BOTH(1)) GRID_BAR(); }
    if (IN(2)) {
        if (is_conv) { REFRESH(); conv_range(F, args, 0, CV_SPLIT, convw + F.wave, nconvw); }
        else {
            pg8::Gemm g{(const bf16*)(ws + WS_XN), (const bf16*)(ws + WS_WIN), NTOK, D_IN, D}; pg8::StaticOrder S; S.init(NTOK, D_IN, NC, cidx);
            pg8::EpiProj E{(bf16*)(ws + WS_PROJ), args.in[6], (float*)(F.ctl + CW_KSUM)};
            pg8::gemm_phase<pg8::EpiProj, pg8::StaticOrder, false, true>(F.lds + RING_OFF, g, S, E);
        }
        if (BOTH(2)) GRID_BAR();
    }
    if (IN(3)) {
        if (is_conv3) { REFRESH(); conv_range(F, args, CV_SPLIT, CV_ITEMS, convw3 + F.wave, nconvw3); }
        else {
            const float* sinks = args.in[10]; int prev_key = -1;
            for (int round = 0; ; ++round) {
                const int rank = round * NC3 + ((round & 1) ? (((NC3 & 7) == 0) ? ((NC3 - 1 - cidx) ^ 7) : NC3 - 1 - cidx) : cidx); if (rank >= 1024) break;
                att::UnitDesc u;
                if (rank < 512) { const int bh = rank & 63, h = bh & 7; u.b = bh >> 3; u.qb = 7 - (rank >> 6); u.q0 = u.qb * 256; u.gqa = 0; u.moba = 1;
                    u.qcol = h * 64; u.kcol = 512 + h * 64; u.vcol = 1024 + h * 64; u.ocol = h * 64; u.head = h; u.sink2 = 0.f; u.fill = (h != prev_key); prev_key = h; u.fillk = 1; }
                else { const int idx = rank - 512, bk = idx & 15, kvh = bk & 1; u.b = bk >> 1; u.q0 = (31 - (idx >> 4)) * 64; u.qb = u.q0 >> 8; u.gqa = 1; u.moba = 0;
                    u.qcol = 1536 + kvh * 256; u.kcol = 2048 + kvh * 64; u.vcol = 2176 + kvh * 64; u.ocol = 512 + kvh * 256; u.head = 8 + kvh * 4; u.sink2 = 0.f; u.fill = (64 + kvh != prev_key); prev_key = 64 + kvh; u.fillk = 0; }
                att::attn_unit(u, (const bf16*)(ws + WS_PROJ), (bf16*)(ws + WS_O), (const float*)(ws + WS_BIAS), (const float*)(F.ctl + CW_KSUM), sinks, (char*)lds + RING_OFF);
            }
        }
        if (BOTH(3)) GRID_BAR();
    }
    if (IN(4)) {
        pg8::Gemm g{(const bf16*)(ws + WS_O), (const bf16*)(ws + WS_WOUT), NTOK, D, D}; pg8::StaticOrder S; S.init(NTOK, D, F.G, (int)blockIdx.x);
        pg8::EpiX1 E{args.in[0], (pg8::bf16_t*)(ws + WS_X1), args.in[8], (const float*)(ws + WS_MODF)};
        pg8::gemm_phase<pg8::EpiX1, pg8::StaticOrder, false, true>(F.lds + RING_OFF, g, S, E);
        if (BOTH(4)) GRID_BAR();
    }
    if (IN(5)) { REFRESH(); p5_router(F, args); if (BOTH(5)) GRID_BAR(); }
    if (IN(6)) {
        REFRESH(); build_tiles(F, args); build_ridx(F, args, 2 * DFF / 256);
        pg8::Gemm g{(const bf16*)(ws + WS_H2), (const bf16*)(ws + WS_WGU), MAXSLOTS, 2 * DFF, D / 2};
        pg8::GroupedOrder S{2 * DFF / 256, F.G, (int)blockIdx.x, *(const LAS int*)(F.lds + LDS_NT), (const LAS int*)(F.lds + LDS_TILE_E), (const LAS int*)(F.lds + LDS_RIDX), (size_t)2 * DFF * D, (const LAS int*)(F.lds + LDS_CNTE), (const LAS int*)(F.lds + LDS_TBASE)};
        pg8::EpiSwiglu8 E{ws + WS_ACT, args.in[15]};
        pg8::gemm_phase<pg8::EpiSwiglu8, pg8::GroupedOrder, false, true, true>(F.lds + RING_OFF, g, S, E);
        if (BOTH(6)) GRID_BAR();
    }
    if (IN(7)) {
        REFRESH(); if (!IN(6)) build_tiles(F, args);
        pg8::Gemm g{(const bf16*)(ws + WS_ACT), (const bf16*)(ws + WS_WD), MAXSLOTS, D, DFF / 2};
        pg8::GroupedOrder S{D / 256, F.G, (int)blockIdx.x, *(const LAS int*)(F.lds + LDS_NT), (const LAS int*)(F.lds + LDS_TILE_E), (const LAS int*)nullptr, (size_t)D * DFF, (const LAS int*)(F.lds + LDS_CNTE), (const LAS int*)(F.lds + LDS_TBASE)};
        pg8::EpiDown8 E{ws + WS_Y, args.in[17]};
        pg8::gemm_phase<pg8::EpiDown8, pg8::GroupedOrder, false, true, true>(F.lds + RING_OFF, g, S, E);
        if (BOTH(7)) GRID_BAR();
    }
    if (IN(8)) { REFRESH(); p8_final(F, args); }
#undef IN
#undef BOTH
}

#ifndef MK_PER_PHASE
#define MK_PER_PHASE 0
#endif
extern "C" void kernel_launch(void* const* d_in, const int* in_sizes, int n_in, void* d_out, int out_size, void* d_ws, size_t ws_size, hipStream_t stream) {
    static int grid = 0;
    if (grid == 0) {
        if (n_in != 19 || ws_size < WS_END) { fprintf(stderr, "kernel_launch: unexpected n_in %d / ws %zu\n", n_in, ws_size); grid = -1; return; }
        int dev = 0, cus = 0, per_cu = 0;
        if (hipGetDevice(&dev) != hipSuccess || hipDeviceGetAttribute(&cus, hipDeviceAttributeMultiprocessorCount, dev) != hipSuccess) { grid = -1; return; }
        if (hipFuncSetAttribute((const void*)mega_fwd, hipFuncAttributeMaxDynamicSharedMemorySize, LDS_BYTES) != hipSuccess) { fprintf(stderr, "kernel_launch: hipFuncSetAttribute failed\n"); grid = -1; return; }
        if (hipOccupancyMaxActiveBlocksPerMultiprocessor(&per_cu, (const void*)mega_fwd, NWAVES * 64, LDS_BYTES) != hipSuccess || per_cu < 1) fprintf(stderr, "kernel_launch: occupancy query reports %d\n", per_cu);
        (void)hipGetLastError();
        grid = cus;
    }
    if (grid < 0) return;
    unsigned char* ws = (unsigned char*)d_ws;
    (void)hipMemsetAsync(ws + WS_CTL, 0, CTL_ZERO_BYTES, stream);
    Args a{};
    for (int i = 0; i < 19; ++i) a.in[i] = (const float*)d_in[i];
    a.out = (float*)d_out; a.ws = ws;
#if MK_PER_PHASE
    for (int ph = 0; ph < 9; ++ph) { a.ph_lo = ph; a.ph_hi = ph + 1; hipLaunchKernelGGL(mega_fwd, dim3(grid), dim3(NWAVES * 64), LDS_BYTES, stream, a); }
#else
    a.ph_lo = 0; a.ph_hi = 9; hipLaunchKernelGGL(mega_fwd, dim3(grid), dim3(NWAVES * 64), LDS_BYTES, stream, a);
#endif
}
```

```cpp
#include <hip/hip_runtime.h>
#include <hip/hip_bf16.h>
#include <cstdio>
#include <cstdint>
#include <cmath>

constexpr int D = 1024, BATCH = 8, SEQ = 2048, NTOK = BATCH * SEQ;
constexpr int HD = 64, NH_M = 8, NH_S = 8, NKV_S = 2;
constexpr int D_MOBA = 512, D_SWA_Q = 512, D_SWA_KV = 128, D_IN = 2304;
constexpr int MB_L = 256, MB_NB = SEQ / MB_L, MB_TOPK = 3;
constexpr int SWA_W = 128;
constexpr int NE = 32, TOPK = 4, DFF = 1024;
constexpr float EPS = 1e-5f, NEGF = -1e30f;
constexpr int MAXTILES = 288;
constexpr int MAXSLOTS = MAXTILES * 256;
constexpr float LOG2E = 1.4426950408889634f;
constexpr float YSCALE = 16.0f;
constexpr float WSCALE = 32.0f;
constexpr float QSCALE = 0.125f * LOG2E;

namespace pg8 {
#define PG8_LAS __attribute__((address_space(3)))
typedef unsigned short bf16_t;
typedef short bf16x8 __attribute__((ext_vector_type(8)));
typedef float f32x4 __attribute__((ext_vector_type(4)));
typedef unsigned u32x4 __attribute__((ext_vector_type(4)));
typedef int v4i_t __attribute__((ext_vector_type(4)));
constexpr int BM = 256, BK = 64, HALF = 128, HTB = HALF * BK * 2  , STAGE_BYTES = 8 * HTB, NXCD = 8, WGM = 8;

__host__ __device__ __forceinline__ int lds_byte(int r, int c) { const int st = (r >> 4) * 2 + (c >> 5), rr = r & 15, cc = c & 31, ob = rr * 64 + cc * 2; return st * 1024 + (ob ^ (((ob >> 9) & 1) << 5)); }
__host__ __device__ __forceinline__ void stage_rc(int b, int& R, int& C) { const int st = b / 1024, sb = b % 1024, swz = sb ^ (((sb >> 9) & 1) << 5); R = (st >> 1) * 16 + swz / 64; C = (st & 1) * 32 + (swz % 64) / 2; }
__host__ __device__ __forceinline__ int perm32(int rho) { const int n = rho >> 4, i = rho & 15; return 8 * (i >> 2) + 4 * n + (i & 3); }

struct Unit { int pm, pn, e; };
struct Gemm { const bf16_t* A; const bf16_t* Bt; int M, N, K; };

struct StaticOrder {
    int nM, nN, nwg, G, c;
    __host__ __device__ void init(int M, int N, int G_, int c_) { nM = M / BM; nN = N / BM; nwg = nM * nN; G = G_; c = c_; }
    __host__ __device__ bool next(int i, Unit& u) const {
        const long L = (long)i * G + c; if (L >= nwg) return false;
        int wgid = (int)L; { const int q = nwg / NXCD, r = nwg % NXCD, xcd = wgid % NXCD, off = wgid / NXCD; wgid = (xcd < r ? xcd * (q + 1) : r * (q + 1) + (xcd - r) * q) + off; }
        const int nig = WGM * nN, gid = wgid / nig, fm = gid * WGM, gsz = (nM - fm) < WGM ? (nM - fm) : WGM;
        u.pm = fm + ((wgid % nig) % gsz); u.pn = (wgid % nig) / gsz; u.e = 0; return true;
    }
    __device__ __forceinline__ size_t abase(const Unit& u, int h, int K) const { return (size_t)(u.pm * BM + h * HALF) * K * 2; }
    __device__ __forceinline__ unsigned alane(int, const Unit&, int, int, unsigned voff, int) const { return voff; }
    __device__ __forceinline__ size_t bbase(const Unit& u, size_t tstep) const { return (size_t)u.pn * tstep; }
    __device__ __forceinline__ void a_ready(const Unit&) const {}
    __device__ __forceinline__ void done(const Unit&) const {}
};
__device__ __forceinline__ bool moe_unit(int i, int c, int G, int nN, const PG8_LAS int* cnte, const PG8_LAS int* tbase, int ntiles, int& t, int& pn) {
    if ((G & 7) == 0) {
        const int x = c & 7, rank = c >> 3, W = G >> 3, lo = (x * ntiles) >> 3, hi = ((x + 1) * ntiles) >> 3, v = i * W + rank;
        if (v >= (hi - lo) * nN) return false;
        const int j = v / nN; t = lo + j; pn = v - j * nN; return true;
    }
    const int L = i * G + c; t = L / nN; if (t >= ntiles) return false; pn = L - t * nN; return true;
}
struct GroupedOrder {
    int nN, G, c, ntiles; const PG8_LAS int* tile_e; const PG8_LAS int* ridx; size_t bstride; const PG8_LAS int* cnte; const PG8_LAS int* tbase;
    __device__ __forceinline__ bool next(int i, Unit& u) const {
        int t, pn; if (!moe_unit(i, c, G, nN, cnte, tbase, ntiles, t, pn)) return false;
        u.pm = __builtin_amdgcn_readfirstlane(t); u.pn = __builtin_amdgcn_readfirstlane(pn); u.e = __builtin_amdgcn_readfirstlane(tile_e[t]); return true;
    }
    __device__ __forceinline__ size_t abase(const Unit& u, int h, int K) const { return ridx ? (size_t)0 : (size_t)(u.pm * BM + h * HALF) * K * 2; }
    __device__ __forceinline__ unsigned alane(int ui, const Unit&, int h, int piece, unsigned voff, int K) const {
        if (!ridx) return voff;
        int t_ = (int)threadIdx.x; asm volatile("" : "+v"(t_));
        int R, C; stage_rc(t_ * 16 + piece * 8192, R, C);
        return (unsigned)ridx[ui * BM + h * HALF + R] * (unsigned)K * 2u + (unsigned)C * 2u; }
    __device__ __forceinline__ size_t bbase(const Unit& u, size_t tstep) const { return (size_t)u.e * bstride + (size_t)u.pn * tstep; }
    __device__ __forceinline__ void a_ready(const Unit&) const {}
    __device__ __forceinline__ void done(const Unit&) const {}
};

__device__ __forceinline__ unsigned cvt_pk_bf16(float lo, float hi) { unsigned r; asm volatile("v_cvt_pk_bf16_f32 %0, %1, %2" : "=v"(r) : "v"(lo), "v"(hi)); return r; }

struct EpiProj {
    static constexpr bool PERM = true, AFTER_DRAIN = false;
    bf16_t* O; const float* bias; float* ksum;
    __device__ __forceinline__ void operator()(const f32x4 (&acc)[2][2][4][2], const Unit& u, int wr, int wc, int fr, int fq) const {
        const int row0 = u.pm * BM + wr * 64 + fr, col0 = u.pn * BM + wc * 32 + 8 * fq;
        const float sc = (u.pn < 2 || u.pn == 6 || u.pn == 7) ? QSCALE : 1.0f;
        f32x4 bv[2][2];
#pragma unroll
        for (int bj = 0; bj < 2; ++bj)
#pragma unroll
            for (int n = 0; n < 2; ++n) bv[bj][n] = *(const f32x4*)(bias + col0 + bj * HALF + 4 * n);
#pragma unroll
        for (int ai = 0; ai < 2; ++ai)
#pragma unroll
            for (int m = 0; m < 4; ++m) { bf16_t* rowp = O + (size_t)(row0 + ai * HALF + m * 16) * D_IN + col0;
#pragma unroll
                for (int bj = 0; bj < 2; ++bj) { f32x4 v0 = (acc[ai][bj][m][0] + bv[bj][0]) * sc, v1 = (acc[ai][bj][m][1] + bv[bj][1]) * sc;
                    u32x4 w; w.x = cvt_pk_bf16(v0[0], v0[1]); w.y = cvt_pk_bf16(v0[2], v0[3]); w.z = cvt_pk_bf16(v1[0], v1[1]); w.w = cvt_pk_bf16(v1[2], v1[3]);
                    *(u32x4*)(rowp + bj * HALF) = w; } }
        if (u.pn == 2 || u.pn == 3) {
#pragma unroll
            for (int bj = 0; bj < 2; ++bj)
#pragma unroll
                for (int n = 0; n < 2; ++n) {
                    f32x4 s = bv[bj][n] * 8.0f;
#pragma unroll
                    for (int ai = 0; ai < 2; ++ai)
#pragma unroll
                        for (int m = 0; m < 4; ++m) s += acc[ai][bj][m][n];
#pragma unroll
                    for (int j = 0; j < 4; ++j) { float t = s[j]; t += __shfl_xor(t, 1); t += __shfl_xor(t, 2); t += __shfl_xor(t, 4); t += __shfl_xor(t, 8);
                        if (fr == 0) atomicAdd(ksum + (size_t)u.pm * D_MOBA + (u.pn - 2) * BM + bj * HALF + wc * 32 + 8 * fq + 4 * n + j, t); }
                }
        }
    }
};
struct EpiX1 {
    static constexpr bool PERM = true, AFTER_DRAIN = false;
    const float* x; bf16_t* x1; const float* bias; const float* modf;
    __device__ __forceinline__ void operator()(const f32x4 (&acc)[2][2][4][2], const Unit& u, int wr, int wc, int fr, int fq) const {
        const int row0 = u.pm * BM + wr * 64 + fr, col0 = u.pn * BM + wc * 32 + 8 * fq;
        const float* ga = modf + (size_t)(u.pm >> 3) * 6 * D + 2 * D;
        f32x4 bv[2][2], gv[2][2];
#pragma unroll
        for (int bj = 0; bj < 2; ++bj)
#pragma unroll
            for (int n = 0; n < 2; ++n) { bv[bj][n] = *(const f32x4*)(bias + col0 + bj * HALF + 4 * n); gv[bj][n] = *(const f32x4*)(ga + col0 + bj * HALF + 4 * n); }
#pragma unroll
        for (int ai = 0; ai < 2; ++ai)
#pragma unroll
            for (int m = 0; m < 4; ++m) { const size_t off = (size_t)(row0 + ai * HALF + m * 16) * D + col0;
#pragma unroll
                for (int bj = 0; bj < 2; ++bj) { const f32x4 xr0 = *(const f32x4*)(x + off + bj * HALF), xr1 = *(const f32x4*)(x + off + bj * HALF + 4);
                    const f32x4 v0 = xr0 + gv[bj][0] * (acc[ai][bj][m][0] + bv[bj][0]), v1 = xr1 + gv[bj][1] * (acc[ai][bj][m][1] + bv[bj][1]);
                    u32x4 w; w.x = cvt_pk_bf16(v0[0], v0[1]); w.y = cvt_pk_bf16(v0[2], v0[3]); w.z = cvt_pk_bf16(v1[0], v1[1]); w.w = cvt_pk_bf16(v1[2], v1[3]);
                    *(u32x4*)(x1 + off + bj * HALF) = w; }
                if (m == 3) asm volatile("" ::: "memory"); }
    }
};
struct EpiSwiglu {
    static constexpr bool PERM = true, AFTER_DRAIN = false;
    bf16_t* act; const float* bias;
    __device__ __forceinline__ void operator()(const f32x4 (&acc)[2][2][4][2], const Unit& u, int wr, int wc, int fr, int fq) const {
        const int row0 = u.pm * BM + wr * 64 + fr, ff0 = u.pn * HALF + wc * 32 + 8 * fq;
        const float* bg = bias + (size_t)u.e * 2 * DFF + ff0;
        f32x4 bgv[2], buv[2];
#pragma unroll
        for (int n = 0; n < 2; ++n) { bgv[n] = *(const f32x4*)(bg + 4 * n); buv[n] = *(const f32x4*)(bg + DFF + 4 * n); }
#pragma unroll
        for (int ai = 0; ai < 2; ++ai)
#pragma unroll
            for (int m = 0; m < 4; ++m) {
                f32x4 o[2];
#pragma unroll
                for (int n = 0; n < 2; ++n) { const f32x4 gq = acc[ai][0][m][n] + bgv[n], uq = acc[ai][1][m][n] + buv[n];
#pragma unroll
                    for (int j = 0; j < 4; ++j) { const float g = fminf(gq[j], 7.0f), uu = fminf(fmaxf(uq[j], -7.0f), 7.0f);
                        const float sg = __builtin_amdgcn_rcpf(1.0f + __builtin_amdgcn_exp2f(-1.702f * LOG2E * g)); o[n][j] = (uu + 1.0f) * (g * sg); } }
                u32x4 w; w.x = cvt_pk_bf16(o[0][0], o[0][1]); w.y = cvt_pk_bf16(o[0][2], o[0][3]); w.z = cvt_pk_bf16(o[1][0], o[1][1]); w.w = cvt_pk_bf16(o[1][2], o[1][3]);
                *(u32x4*)(act + (size_t)(row0 + ai * HALF + m * 16) * DFF + ff0) = w; }
    }
};
struct EpiDown {
    static constexpr bool PERM = true, AFTER_DRAIN = false;
    bf16_t* y; const float* bias;
    __device__ __forceinline__ void operator()(const f32x4 (&acc)[2][2][4][2], const Unit& u, int wr, int wc, int fr, int fq) const {
        const int row0 = u.pm * BM + wr * 64 + fr, col0 = u.pn * BM + wc * 32 + 8 * fq;
        const float* bb = bias + (size_t)u.e * D + col0;
        f32x4 bv[2][2];
#pragma unroll
        for (int bj = 0; bj < 2; ++bj)
#pragma unroll
            for (int n = 0; n < 2; ++n) bv[bj][n] = *(const f32x4*)(bb + bj * HALF + 4 * n);
#pragma unroll
        for (int ai = 0; ai < 2; ++ai)
#pragma unroll
            for (int m = 0; m < 4; ++m) { bf16_t* rowp = y + (size_t)(row0 + ai * HALF + m * 16) * D + col0;
#pragma unroll
                for (int bj = 0; bj < 2; ++bj) { const f32x4 v0 = acc[ai][bj][m][0] + bv[bj][0], v1 = acc[ai][bj][m][1] + bv[bj][1];
                    u32x4 w; w.x = cvt_pk_bf16(v0[0], v0[1]); w.y = cvt_pk_bf16(v0[2], v0[3]); w.z = cvt_pk_bf16(v1[0], v1[1]); w.w = cvt_pk_bf16(v1[2], v1[3]);
                    *(u32x4*)(rowp + bj * HALF) = w; } }
    }
};

__device__ __forceinline__ unsigned pk4_f8(float a, float b, float c, float d) { int r = __builtin_amdgcn_cvt_pk_fp8_f32(a, b, 0, false); r = __builtin_amdgcn_cvt_pk_fp8_f32(c, d, r, true); return (unsigned)r; }
typedef unsigned u32x2 __attribute__((ext_vector_type(2)));
struct EpiSwiglu8 {
    static constexpr bool PERM = true, AFTER_DRAIN = false;
    unsigned char* act; const float* bias;
    __device__ __forceinline__ void operator()(const f32x4 (&acc)[2][2][4][2], const Unit& u, int wr, int wc, int fr, int fq) const {
        const int row0 = u.pm * BM + wr * 64 + fr, ff0 = u.pn * HALF + wc * 32 + 8 * fq;
        const float* bg = bias + (size_t)u.e * 2 * DFF + ff0;
        f32x4 bgv[2], buv[2];
#pragma unroll
        for (int n = 0; n < 2; ++n) { bgv[n] = *(const f32x4*)(bg + 4 * n); buv[n] = *(const f32x4*)(bg + DFF + 4 * n); }
#pragma unroll
        for (int ai = 0; ai < 2; ++ai)
#pragma unroll
            for (int m = 0; m < 4; ++m) {
                f32x4 o[2];
#pragma unroll
                for (int n = 0; n < 2; ++n) { const f32x4 gq = acc[ai][0][m][n] * (1.0f / WSCALE) + bgv[n], uq = acc[ai][1][m][n] * (1.0f / WSCALE) + buv[n];
#pragma unroll
                    for (int j = 0; j < 4; ++j) { const float g = fminf(gq[j], 7.0f), uu = fminf(fmaxf(uq[j], -7.0f), 7.0f);
                        const float sg = __builtin_amdgcn_rcpf(1.0f + __builtin_amdgcn_exp2f(-1.702f * LOG2E * g)); o[n][j] = (uu + 1.0f) * (g * sg); } }
                u32x2 w; w.x = pk4_f8(o[0][0], o[0][1], o[0][2], o[0][3]); w.y = pk4_f8(o[1][0], o[1][1], o[1][2], o[1][3]);
                *(u32x2*)(act + (size_t)(row0 + ai * HALF + m * 16) * DFF + ff0) = w;
                asm volatile("" ::: "memory"); }
    }
};
struct EpiDown8 {
    static constexpr bool PERM = true, AFTER_DRAIN = false;
    unsigned char* y; const float* bias;
    __device__ __forceinline__ void operator()(const f32x4 (&acc)[2][2][4][2], const Unit& u, int wr, int wc, int fr, int fq) const {
        const int row0 = u.pm * BM + wr * 64 + fr, col0 = u.pn * BM + wc * 32 + 8 * fq;
        const float* bb = bias + (size_t)u.e * D + col0;
        f32x4 bv[2][2];
#pragma unroll
        for (int bj = 0; bj < 2; ++bj)
#pragma unroll
            for (int n = 0; n < 2; ++n) bv[bj][n] = *(const f32x4*)(bb + bj * HALF + 4 * n) * YSCALE;
#pragma unroll
        for (int ai = 0; ai < 2; ++ai)
#pragma unroll
            for (int m = 0; m < 4; ++m) { unsigned char* rowp = y + (size_t)(row0 + ai * HALF + m * 16) * D + col0;
#pragma unroll
                for (int bj = 0; bj < 2; ++bj) { const f32x4 v0 = acc[ai][bj][m][0] * (YSCALE / WSCALE) + bv[bj][0], v1 = acc[ai][bj][m][1] * (YSCALE / WSCALE) + bv[bj][1];
                    u32x2 w; w.x = pk4_f8(v0[0], v0[1], v0[2], v0[3]); w.y = pk4_f8(v1[0], v1[1], v1[2], v1[3]);
                    *(u32x2*)(rowp + bj * HALF) = w; }
                asm volatile("" ::: "memory"); }
    }
};

__device__ __forceinline__ void glds16_s(const char* sbase, unsigned voff, unsigned lds_dst) { unsigned keep;
    asm volatile("s_mov_b32 %0, m0\n\ts_mov_b32 m0, %3\n\ts_nop 0\n\tglobal_load_lds_dwordx4 %1, %2\n\ts_mov_b32 m0, %0" : "=&s"(keep) : "v"(voff), "s"(sbase), "s"(lds_dst) : "memory"); }
template <class Epi, class Sched, bool ALIGN_EPI = false, bool SP2 = false, bool F8 = false>
__device__ __forceinline__ void gemm_phase(PG8_LAS unsigned char* lds, const Gemm g, const Sched& S, const Epi& E) {
    int tid_ = threadIdx.x; asm volatile("" : "+v"(tid_));
    const int tid = tid_, wid = __builtin_amdgcn_readfirstlane(tid >> 6), lane = tid & 63, wr = wid >> 2, wc = wid & 3, fr = lane & 15, fq = lane >> 4;
    const int K = g.K, nt = K / BK;
    unsigned voffA[2], voffB[2];
#pragma unroll
    for (int i = 0; i < 2; ++i) { int R, C; stage_rc(tid * 16 + i * 8192, R, C); const int Rb = Epi::PERM ? ((R & ~31) + perm32(R & 31)) : R;
        voffA[i] = (unsigned)(R * K + C) * 2u; voffB[i] = (unsigned)(Rb * K + C) * 2u; }
#define PG8_STAGE_A(bufoff, kptr, UI, U, H) do { const char* _gb = (kptr) + S.abase(U, H, K); _Pragma("unroll") for (int _i = 0; _i < 2; ++_i) \
        glds16_s(_gb, S.alane(UI, U, H, _i, voffA[_i], K), ldsbase + (unsigned)((bufoff) + _i * 8192)); } while (0)
    const size_t kstep = (size_t)(BK * 2);
    const size_t hstep = (size_t)HALF * K * 2;
    const size_t tstep = 2 * hstep;
    const unsigned ldsw = (unsigned)wid * 1024u;
    const unsigned ldsbase = (unsigned)__builtin_amdgcn_readfirstlane((int)((unsigned)(size_t)lds + ldsw));
    const int aoff = lds_byte(wr * 64 + fr, fq * 8), boff = lds_byte(wc * 32 + fr, fq * 8);
#define PG8_SA(b, h) (((b) * 2 + (h)) * HTB)
#define PG8_SB(b, h) ((4 + (b) * 2 + (h)) * HTB)
#define PG8_STAGE(bufoff, gbase, voff) do { _Pragma("unroll") for (int _i = 0; _i < 2; ++_i) \
        glds16_s((const char*)(gbase), (voff)[_i], ldsbase + (unsigned)((bufoff) + _i * 8192)); } while (0)
#define PG8_LDA(dst, b, h) do { _Pragma("unroll") for (int m = 0; m < 4; ++m) _Pragma("unroll") for (int k = 0; k < 2; ++k) dst[m][k] = *(const PG8_LAS bf16x8*)(lds + PG8_SA(b, h) + aoff + m * 2048 + k * 1024); } while (0)
#define PG8_LDB(dst, b, h) do { _Pragma("unroll") for (int n = 0; n < 2; ++n) _Pragma("unroll") for (int k = 0; k < 2; ++k) dst[n][k] = *(const PG8_LAS bf16x8*)(lds + PG8_SB(b, h) + boff + n * 2048 + k * 1024); } while (0)
#define PG8_CAT(x) __builtin_shufflevector(__builtin_bit_cast(v4i_t, x[0]), __builtin_bit_cast(v4i_t, x[1]), 0, 1, 2, 3, 4, 5, 6, 7)
#define PG8_MMA(ai, bj, At, Bt) do { __builtin_amdgcn_s_setprio(1); _Pragma("unroll") for (int m = 0; m < 4; ++m) _Pragma("unroll") for (int n = 0; n < 2; ++n) { \
        if constexpr (F8) { acc[ai][bj][m][n] = __builtin_amdgcn_mfma_scale_f32_16x16x128_f8f6f4(PG8_CAT(Bt[n]), PG8_CAT(At[m]), acc[ai][bj][m][n], 0, 0, 0, 0, 0, 0); } \
        else { _Pragma("unroll") for (int k = 0; k < 2; ++k) acc[ai][bj][m][n] = __builtin_amdgcn_mfma_f32_16x16x32_bf16(Bt[n][k], At[m][k], acc[ai][bj][m][n], 0, 0, 0); } } \
        __builtin_amdgcn_s_setprio(0); } while (0)
#define PG8_WAIT_V(n) asm volatile("s_waitcnt vmcnt(" #n ")" ::: "memory")
#define PG8_WAIT_L(n) asm volatile("s_waitcnt lgkmcnt(" #n ")" ::: "memory")
#define PG8_BAR __builtin_amdgcn_s_barrier()
#define PG8_SCHED __builtin_amdgcn_sched_barrier(0)
    Unit cur, nxt; int ui = 0;
    if (!S.next(0, cur)) return;
    f32x4 acc[2][2][4][2];
#pragma unroll
    for (int a = 0; a < 2; ++a)
#pragma unroll
        for (int b = 0; b < 2; ++b)
#pragma unroll
            for (int m = 0; m < 4; ++m)
#pragma unroll
                for (int n = 0; n < 2; ++n) acc[a][b][m][n] = (f32x4){0.f, 0.f, 0.f, 0.f};
    bf16x8 At[4][2], B0[2][2], B1[2][2];
    const char* const A0 = (const char*)g.A; const char* cB = (const char*)g.Bt + S.bbase(cur, tstep);

    S.a_ready(cur);
    if constexpr (SP2) {
        PG8_STAGE(PG8_SB(0, 0), cB, voffB); PG8_STAGE(PG8_SB(0, 1), cB + hstep, voffB); PG8_STAGE_A(PG8_SA(0, 0), A0, 0, cur, 0); PG8_STAGE_A(PG8_SA(0, 1), A0, 0, cur, 1);
        if (wr == 1) PG8_BAR;
        PG8_WAIT_V(2); PG8_BAR;
        PG8_STAGE(PG8_SB(1, 0), cB + kstep, voffB); PG8_STAGE_A(PG8_SA(1, 0), A0 + kstep, 0, cur, 0); PG8_STAGE(PG8_SB(1, 1), cB + hstep + kstep, voffB);
        PG8_WAIT_V(6); PG8_BAR;
    } else {
        PG8_STAGE(PG8_SB(0, 0), cB, voffB); PG8_STAGE_A(PG8_SA(0, 0), A0, 0, cur, 0); PG8_STAGE(PG8_SB(0, 1), cB + hstep, voffB); PG8_STAGE_A(PG8_SA(0, 1), A0, 0, cur, 1);
        if (wr == 1) PG8_BAR;
        PG8_WAIT_V(4); PG8_BAR;
        PG8_STAGE(PG8_SB(1, 0), cB + kstep, voffB); PG8_STAGE_A(PG8_SA(1, 0), A0 + kstep, 0, cur, 0); PG8_STAGE(PG8_SB(1, 1), cB + hstep + kstep, voffB);
        PG8_WAIT_V(6); PG8_BAR;
    }
    for (;;) {
        const bool has_next = S.next(ui + 1, nxt);
        const char* nB = has_next ? (const char*)g.Bt + S.bbase(nxt, tstep) : cB;
        if (!has_next) nxt = cur;
        const int nui = has_next ? ui + 1 : ui;
#pragma unroll 1
        for (int t = 0; t < nt; t += 2) {
            const bool last = (t == nt - 2);
            const char* a1 = A0 + (size_t)(t + 1) * kstep;
            const char* a2 = last ? A0 : A0 + (size_t)(t + 2) * kstep; const char* b2 = last ? nB : cB + (size_t)(t + 2) * kstep;
            const int lui = last ? nui : ui; Unit lu; lu.pm = last ? nxt.pm : cur.pm; lu.pn = last ? nxt.pn : cur.pn; lu.e = last ? nxt.e : cur.e;
            const char* a3 = a2 + kstep; const char* b3 = b2 + kstep;
            if (last && has_next) S.a_ready(nxt);
            if constexpr (SP2) {
            PG8_LDB(B0, 0, 0); PG8_LDB(B1, 0, 1); PG8_SCHED; PG8_LDA(At, 0, 0); PG8_STAGE_A(PG8_SA(1, 1), a1, ui, cur, 1);
            PG8_WAIT_V(8); PG8_WAIT_L(0); PG8_BAR; PG8_MMA(0, 0, At, B0); PG8_MMA(0, 1, At, B1); PG8_BAR; PG8_SCHED;
            PG8_LDA(At, 0, 1); PG8_STAGE(PG8_SB(0, 0), b2, voffB); PG8_STAGE(PG8_SB(0, 1), b2 + hstep, voffB); PG8_STAGE_A(PG8_SA(0, 0), a2, lui, lu, 0);
            PG8_WAIT_V(8); PG8_WAIT_L(0); PG8_BAR; PG8_MMA(1, 0, At, B0); PG8_MMA(1, 1, At, B1); PG8_BAR; PG8_SCHED;
            PG8_LDB(B0, 1, 0); PG8_LDB(B1, 1, 1); PG8_SCHED; PG8_LDA(At, 1, 0); PG8_STAGE_A(PG8_SA(0, 1), a2, lui, lu, 1);
            PG8_WAIT_V(8); PG8_WAIT_L(0); PG8_BAR; PG8_MMA(0, 0, At, B0); PG8_MMA(0, 1, At, B1); PG8_BAR; PG8_SCHED;
            PG8_LDA(At, 1, 1); PG8_STAGE(PG8_SB(1, 0), b3, voffB); PG8_STAGE(PG8_SB(1, 1), b3 + hstep, voffB); PG8_STAGE_A(PG8_SA(1, 0), a3, lui, lu, 0);
            PG8_WAIT_V(8); PG8_WAIT_L(0); PG8_BAR; PG8_MMA(1, 0, At, B0); PG8_MMA(1, 1, At, B1); PG8_BAR; PG8_SCHED;
            } else {
            PG8_LDB(B0, 0, 0); PG8_SCHED; PG8_LDA(At, 0, 0); PG8_STAGE_A(PG8_SA(1, 1), a1, ui, cur, 1);
            PG8_WAIT_L(8); PG8_BAR; PG8_WAIT_L(0); PG8_MMA(0, 0, At, B0); PG8_BAR; PG8_SCHED;
            PG8_LDB(B1, 0, 1); PG8_STAGE(PG8_SB(0, 0), b2, voffB);
            PG8_BAR; PG8_WAIT_L(0); PG8_MMA(0, 1, At, B1); PG8_BAR;
            PG8_LDA(At, 0, 1); PG8_STAGE_A(PG8_SA(0, 0), a2, lui, lu, 0);
            PG8_BAR; PG8_WAIT_L(0); PG8_MMA(1, 0, At, B0); PG8_BAR; PG8_SCHED;
            PG8_STAGE(PG8_SB(0, 1), b2 + hstep, voffB);
            PG8_WAIT_V(6); PG8_BAR; PG8_MMA(1, 1, At, B1); PG8_BAR;
            PG8_LDB(B0, 1, 0); PG8_SCHED; PG8_LDA(At, 1, 0); PG8_STAGE_A(PG8_SA(0, 1), a2, lui, lu, 1);
            PG8_WAIT_L(8); PG8_BAR; PG8_WAIT_L(0); PG8_MMA(0, 0, At, B0); PG8_BAR; PG8_SCHED;
            PG8_LDB(B1, 1, 1); PG8_STAGE(PG8_SB(1, 0), b3, voffB);
            PG8_BAR; PG8_WAIT_L(0); PG8_MMA(0, 1, At, B1); PG8_BAR;
            PG8_LDA(At, 1, 1); PG8_STAGE_A(PG8_SA(1, 0), a3, lui, lu, 0);
            PG8_BAR; PG8_WAIT_L(0); PG8_MMA(1, 0, At, B0); PG8_BAR; PG8_SCHED;
            PG8_STAGE(PG8_SB(1, 1), b3 + hstep, voffB);
            PG8_WAIT_V(6); PG8_BAR; PG8_MMA(1, 1, At, B1); PG8_BAR;
            }
        }
        if constexpr (ALIGN_EPI) { if (wr == 0) PG8_BAR; }
        if constexpr (!Epi::AFTER_DRAIN) { E(acc, cur, wr, wc, fr, fq); S.done(cur); }
        if (!has_next) break;
#pragma unroll
        for (int a = 0; a < 2; ++a)
#pragma unroll
            for (int b = 0; b < 2; ++b)
#pragma unroll
                for (int m = 0; m < 4; ++m)
#pragma unroll
                    for (int n = 0; n < 2; ++n) acc[a][b][m][n] = (f32x4){0.f, 0.f, 0.f, 0.f};
        cur = nxt; cB = nB; ++ui;
        if constexpr (ALIGN_EPI) { if (wr == 1) PG8_BAR; }
    }
    PG8_WAIT_V(0);
    if constexpr (!ALIGN_EPI) { if (wr == 0) PG8_BAR; }
    PG8_BAR;
    if constexpr (Epi::AFTER_DRAIN) { E.fused(acc, cur, wr, wc, fr, fq, lds, wid, lane); S.done(cur); }
#undef PG8_STAGE_A
#undef PG8_SA
#undef PG8_SB
#undef PG8_STAGE
#undef PG8_LDA
#undef PG8_LDB
#undef PG8_MMA
#undef PG8_CAT
#undef PG8_WAIT_V
#undef PG8_WAIT_L
#undef PG8_BAR
#undef PG8_SCHED
}
}

constexpr size_t MiB = 1u << 20;
constexpr size_t WS_CTL = 0, CTL_ZERO_BYTES = 1 * MiB;
constexpr size_t WS_MODP = 1 * MiB;
constexpr size_t WS_MODF = 3 * MiB;
constexpr size_t WS_BIAS = 4 * MiB;
constexpr size_t WS_TOKE = 5 * MiB;
constexpr size_t WS_TOKP = 6 * MiB;
constexpr size_t WS_CNTC = 5 * MiB + 512 * 1024;
constexpr size_t WS_TOKW = 7 * MiB;
constexpr size_t WS_INV = 8 * MiB;
constexpr size_t WS_WIN = 10 * MiB;
constexpr size_t WS_WOUT = 15 * MiB;
constexpr size_t WS_X1 = 32 * MiB;
constexpr size_t WS_XN = 96 * MiB;
constexpr size_t WS_H2 = 128 * MiB;
constexpr size_t WS_PROJ = 160 * MiB;
constexpr size_t WS_O = 232 * MiB;
constexpr size_t WS_WGU = 264 * MiB;
constexpr size_t WS_WD = 392 * MiB;
constexpr size_t WS_ACT = 456 * MiB;
constexpr size_t WS_Y = 600 * MiB;
constexpr size_t WS_END = 744 * MiB;
constexpr int CW_TMO = 0, CW_CODE = 1;
constexpr int CW_CNT = 64;
constexpr int CW_BAR = 4096;
constexpr int CW_KSUM = 16384;
static_assert((CW_KSUM + 64 * 512) * 4 <= (int)CTL_ZERO_BYTES, "CTL region");
constexpr int RING_OFF = 0, RING_BYTES = 131072;
constexpr int LDSCTL_OFF = RING_BYTES, MISC_OFF = LDSCTL_OFF + 320;
constexpr int LDS_TILE_E = LDSCTL_OFF + 512;
constexpr int LDS_NT = LDS_TILE_E + MAXTILES * 4;
constexpr int LDS_TBASE = LDS_NT + 16;
constexpr int LDS_CNTE = LDS_TBASE + 128;
constexpr int LDS_RIDX = LDS_CNTE + 128;
constexpr int LDS_BYTES = 147456;
static_assert(LDS_RIDX % 16 == 0 && LDS_RIDX + 10 * 1024 <= LDS_BYTES, "LDS map");
constexpr int NWAVES = 8;

#define GAS __attribute__((address_space(1)))
#define LAS __attribute__((address_space(3)))
typedef unsigned short bf16;
typedef unsigned v4u __attribute__((ext_vector_type(4)));
typedef float f32x4 __attribute__((ext_vector_type(4)));
typedef short bf16x8 __attribute__((ext_vector_type(8)));
typedef GAS unsigned gu32;
typedef GAS unsigned long long gu64;
#define RLX_AGENT __ATOMIC_RELAXED, __HIP_MEMORY_SCOPE_AGENT
#define LDS_WAIT() asm volatile("s_waitcnt lgkmcnt(0)" ::: "memory")
#define VM_WAIT() asm volatile("s_waitcnt vmcnt(0)" ::: "memory")
__device__ __forceinline__ unsigned long long rt() { return __builtin_amdgcn_s_memrealtime(); }
__device__ __forceinline__ unsigned f2bf(float f) { unsigned u = __builtin_bit_cast(unsigned, f); return (u + 0x7fffu + ((u >> 16) & 1u)) >> 16; }
__device__ __forceinline__ unsigned pk2(float lo, float hi) { return f2bf(lo) | (f2bf(hi) << 16); }

#define XB_TMO      128
#define XB_XCNT(j)  (256  + 64 * (j))
#define XB_XSUB(j)  (1280 + 64 * (j))
#define XB_XGEN(j)  (2304 + 64 * (j))
#define XB_TOP      3328
#define XB_TOPGEN   3392
#define XCD_BAR_WORDS 3456
#define XB_SPIN_CAP (1u << 18)

__device__ __forceinline__ unsigned xb_ld(unsigned* p)              { return __hip_atomic_load(p, __ATOMIC_RELAXED, __HIP_MEMORY_SCOPE_AGENT); }
__device__ __forceinline__ unsigned xb_add(unsigned* p, unsigned v) { return __hip_atomic_fetch_add(p, v, __ATOMIC_RELAXED, __HIP_MEMORY_SCOPE_AGENT); }
__device__ __forceinline__ unsigned xb_xcc_id() { return (unsigned)__builtin_amdgcn_s_getreg((3 << 11) | 20) & 0xFu; }
#define XB_SPIN(cond, bar) do { unsigned _sp = 0; while (cond) { __builtin_amdgcn_s_sleep(1); \
    if ((++_sp & 255u) == 0u) { if (xb_ld(&(bar)[XB_TMO])) break; if (_sp > XB_SPIN_CAP) { atomicAdd(&(bar)[XB_TMO], 1u); break; } } } } while (0)

struct XcdBarrier {
    unsigned* bar; unsigned x;
    volatile LAS unsigned* st;
};

__device__ __forceinline__ XcdBarrier xcd_barrier_post(unsigned* bar, volatile LAS unsigned* st) {
    XcdBarrier b; b.bar = bar; b.x = xb_xcc_id(); b.st = st;
    if (threadIdx.x == 0) (void)xb_add(&bar[XB_XCNT(b.x)], 1u);
    return b;
}
__device__ __forceinline__ void xcd_barrier_complete(unsigned* bar, unsigned x, unsigned& nloc, unsigned& nx) {
    const unsigned G = gridDim.x * gridDim.y * gridDim.z;
    unsigned sum, cnt, mine, sp = 0u;
    for (;;) {
        sum = 0u; cnt = 0u; mine = 0u;
#pragma unroll
        for (unsigned j = 0; j < 16; ++j) { const unsigned c = xb_ld(&bar[XB_XCNT(j)]); sum += c; cnt += (c > 0u) ? 1u : 0u; mine = (j == x) ? c : mine; }
        if (sum == G) break;
        __builtin_amdgcn_s_sleep(1);
        if ((++sp & 255u) == 0u) { if (xb_ld(&bar[XB_TMO])) break; if (sp > XB_SPIN_CAP) { atomicAdd(&bar[XB_TMO], 1u); break; } }
    }
    nloc = mine > 0u ? mine : 1u; nx = cnt > 0u ? cnt : 1u;
}

__device__ __forceinline__ void xcd_barrier(const XcdBarrier& b) {
    asm volatile("s_waitcnt vmcnt(0)" ::: "memory");
    __syncthreads();
    if (threadIdx.x == 0) {
        unsigned* bar = b.bar;
        __builtin_amdgcn_s_waitcnt(0);
        unsigned nloc = b.st[0], nx = b.st[1];
        if (nloc == 0u) { xcd_barrier_complete(bar, b.x, nloc, nx); b.st[0] = nloc; b.st[1] = nx; }
        const unsigned old = xb_add(&bar[XB_XSUB(b.x)], 1u);
        const unsigned gen = old / nloc;
        if (old + 1u == (gen + 1u) * nloc) {
            __builtin_amdgcn_fence(__ATOMIC_RELEASE, "agent");
            asm volatile("s_waitcnt vmcnt(0)" ::: "memory");
            const unsigned og = xb_add(&bar[XB_TOP], 1u);
            const unsigned tg = og / nx;
            if (og + 1u == (tg + 1u) * nx) xb_add(&bar[XB_TOPGEN], 1u);
            else XB_SPIN(xb_ld(&bar[XB_TOPGEN]) == tg, bar);
            __builtin_amdgcn_fence(__ATOMIC_ACQUIRE, "agent");
            xb_add(&bar[XB_XGEN(b.x)], 1u);
            asm volatile("s_waitcnt vmcnt(0)" ::: "memory");
        } else {
            XB_SPIN(xb_ld(&bar[XB_XGEN(b.x)]) == gen, bar);
            __builtin_amdgcn_fence(__ATOMIC_ACQUIRE, "agent");
            asm volatile("s_waitcnt vmcnt(0)" ::: "memory");
        }
    }
    __syncthreads();
}

namespace att {
using bf16x8 = __attribute__((ext_vector_type(8))) short;
using s16x4 = __attribute__((ext_vector_type(4))) short;
using f32x16 = __attribute__((ext_vector_type(16))) float;
using u32x4 = __attribute__((ext_vector_type(4))) unsigned;
typedef unsigned short bf16;
constexpr int PITCH = D_IN, OPITCH = D;
constexpr int NSLOT = 4, SLOTB = 8192;
constexpr int TAB_PAD = 96;
constexpr int LDS_K = 0, LDS_V = NSLOT * SLOTB, LDS_WS = 2 * NSLOT * SLOTB, LDS_OST = LDS_WS + 8 * 64 * 4, LDS_TAB = LDS_OST + 8 * 4096, LDS_KMS = LDS_TAB + (TAB_PAD + SEQ) * 4, LDS_NINF = LDS_KMS + 8 * 64 * 4, LDS_END = LDS_NINF + 64 * 4;
static_assert(LDS_END <= 131072, "attention LDS");
__device__ __forceinline__ int crow(int r, int hi) { return (r & 3) + 8 * (r >> 2) + 4 * hi; }
__device__ __forceinline__ void glds16(const void* gsrc, unsigned lds_dst) { unsigned keep;
  asm volatile("s_mov_b32 %0, m0\n\ts_mov_b32 m0, %2\n\ts_nop 0\n\tglobal_load_lds_dwordx4 %1, off\n\ts_mov_b32 m0, %0" : "=&s"(keep) : "v"(gsrc), "s"(lds_dst) : "memory"); }
typedef float f32x2_t __attribute__((ext_vector_type(2))); typedef __bf16 bf16x2_t __attribute__((ext_vector_type(2)));
__device__ __forceinline__ unsigned cvtpk_s(float lo, float hi) { f32x2_t v = {lo, hi}; bf16x2_t b = __builtin_convertvector(v, bf16x2_t); return __builtin_bit_cast(unsigned, b); }
#define ATT_WAIT_BAR(N) asm volatile("s_waitcnt vmcnt(" #N ") lgkmcnt(0)\n\ts_barrier" ::: "memory")
#define ATT_LBAR() asm volatile("s_waitcnt lgkmcnt(0)\n\ts_barrier" ::: "memory")
typedef float f32x2v __attribute__((ext_vector_type(2)));
__device__ __forceinline__ void bias_loads(f32x2v (&bb)[16], unsigned tba) {
#pragma unroll
  for (int i = 0; i < 16; ++i) { asm volatile("ds_read2_b32 %0, %1 offset0:%c2 offset1:%c3" : "=v"(bb[i]) : "v"(tba), "i"((i >> 3) * 32 + ((2 * i) & 3) + 8 * (((2 * i) & 15) >> 2)), "i"((i >> 3) * 32 + ((2 * i) & 3) + 8 * (((2 * i) & 15) >> 2) + 1) : "memory"); }
}
__device__ __forceinline__ void k_loads(bf16x8 (&kf)[8], unsigned ka) {
#pragma unroll
  for (int i = 0; i < 8; ++i) asm volatile("ds_read_b128 %0, %1 offset:%c2" : "=v"(kf[i]) : "v"(ka), "i"((i >> 1) * 2048 + (i & 1) * 512) : "memory");
}
#define ATT_C16(bb, o) (f32x16){bb[o][0], bb[o][1], bb[o + 1][0], bb[o + 1][1], bb[o + 2][0], bb[o + 2][1], bb[o + 3][0], bb[o + 3][1], bb[o + 4][0], bb[o + 4][1], bb[o + 5][0], bb[o + 5][1], bb[o + 6][0], bb[o + 6][1], bb[o + 7][0], bb[o + 7][1]}
__device__ __forceinline__ void qk_mma(f32x16& p0, f32x16& p1, const bf16x8 (&kf)[8], const bf16x8* qr, const f32x2v (&bb)[16]) {
  p0 = __builtin_amdgcn_mfma_f32_32x32x16_bf16(kf[0], qr[0], ATT_C16(bb, 0), 0, 0, 0); p1 = __builtin_amdgcn_mfma_f32_32x32x16_bf16(kf[1], qr[0], ATT_C16(bb, 8), 0, 0, 0);
#pragma unroll
  for (int d0 = 1; d0 < 4; ++d0) { p0 = __builtin_amdgcn_mfma_f32_32x32x16_bf16(kf[2 * d0], qr[d0], p0, 0, 0, 0); p1 = __builtin_amdgcn_mfma_f32_32x32x16_bf16(kf[2 * d0 + 1], qr[d0], p1, 0, 0, 0); }
}
__device__ __forceinline__ void v_loads(s16x4 (&lo)[2][4], s16x4 (&hi)[2][4], int vb) {
#pragma unroll
  for (int d0 = 0; d0 < 2; ++d0)
#pragma unroll
    for (int ks = 0; ks < 4; ++ks) {
      asm volatile("ds_read_b64_tr_b16 %0,%1 offset:%c2" : "=&v"(lo[d0][ks]) : "v"(vb), "i"(d0 * 4096 + ks * 1024) : "memory");
      asm volatile("ds_read_b64_tr_b16 %0,%1 offset:%c2" : "=&v"(hi[d0][ks]) : "v"(vb), "i"(d0 * 4096 + ks * 1024 + 512) : "memory"); }
}
__device__ __forceinline__ void pv_mma(f32x16* o, const s16x4 (&lo)[2][4], const s16x4 (&hi)[2][4], bf16x8 pa0, bf16x8 pa1, bf16x8 pa2, bf16x8 pa3) {
#define ATT_PK(d, k) (bf16x8){lo[d][k][0], lo[d][k][1], lo[d][k][2], lo[d][k][3], hi[d][k][0], hi[d][k][1], hi[d][k][2], hi[d][k][3]}
#pragma unroll
  for (int d0 = 0; d0 < 2; ++d0) {
    o[d0] = __builtin_amdgcn_mfma_f32_32x32x16_bf16(pa0, ATT_PK(d0, 0), o[d0], 0, 0, 0);
    o[d0] = __builtin_amdgcn_mfma_f32_32x32x16_bf16(pa1, ATT_PK(d0, 1), o[d0], 0, 0, 0);
    o[d0] = __builtin_amdgcn_mfma_f32_32x32x16_bf16(pa2, ATT_PK(d0, 2), o[d0], 0, 0, 0);
    o[d0] = __builtin_amdgcn_mfma_f32_32x32x16_bf16(pa3, ATT_PK(d0, 3), o[d0], 0, 0, 0);
  }
#undef ATT_PK
}
#define ATT_LWAIT(N) do { asm volatile("s_waitcnt lgkmcnt(" #N ")" ::: "memory"); __builtin_amdgcn_sched_barrier(0); } while (0)
struct UnitDesc { int b, qb, moba, qcol, kcol, vcol, ocol, head, fill, fillk, gqa, q0; float sink2; };

__device__ __forceinline__ void attn_unit(const UnitDesc& u, const bf16* P, bf16* O, const float* biasT, const float* ksum, const float* sinks, char* shm) {
  int tid_ = threadIdx.x; asm volatile("" : "+v"(tid_));
  const int tid = tid_, lane = tid & 63, r32 = lane & 31, hi = lane >> 5; const int wid = __builtin_amdgcn_readfirstlane(tid >> 6);
  const long rowbase = (long)u.b * SEQ; const int q0 = u.q0;
  const int wg = u.gqa ? (wid & 3) : 0, wrow = u.gqa ? (wid >> 2) * 32 : wid * 32;
  constexpr int TSW = TAB_PAD + 192;
  const unsigned lds0 = (unsigned)(uintptr_t)shm;
  float* wsf = (float*)(shm + LDS_WS) + wid * 64;
  float* tab = (float*)(shm + LDS_TAB); float* kms = (float*)(shm + LDS_KMS);
  const int tlo = u.moba ? 0 : (q0 < 128 ? 0 : (q0 >> 6) - 2), thi = u.gqa ? (q0 >> 6) : u.qb * 4 + 3;
  const bf16* ksrc = P + (rowbase + lane) * PITCH + u.kcol + wid * 8;
  const bf16* vsrc = P + (rowbase + 16 * (wid & 3) + (lane >> 2)) * PITCH + u.vcol + (wid >> 2) * 32 + (lane & 3) * 8;
  const unsigned kdst = lds0 + LDS_K + wid * 1024, vdst = lds0 + LDS_V + wid * 1024;
#define ATT_DMA(t, slot) do { glds16(ksrc + (long)(t) * 64 * PITCH, (unsigned)__builtin_amdgcn_readfirstlane(kdst + (slot))); glds16(vsrc + (long)(t) * 64 * PITCH, (unsigned)__builtin_amdgcn_readfirstlane(vdst + (slot))); } while (0)
  const unsigned ka0 = lds0 + LDS_K + hi * 1024 + r32 * 16;
  const int vb0 = (int)(lds0 + LDS_V) + ((lane >> 4) & 1) * 32 + (lane & 3) * 8 + (4 * hi + ((lane & 15) >> 2)) * 64;
  ATT_DMA(tlo, 0); ATT_DMA(tlo + 1, SLOTB);
  if (u.fill) {
    if (u.gqa) { for (int i = tid; i < 4 * TSW; i += 512) { const int hh = i / TSW, j = i - hh * TSW; tab[i] = (j >= 192) ? 0.f : biasT[(u.head + hh) * SEQ + 191 - j]; } }
    else for (int i = tid; i < TAB_PAD + SEQ; i += 512) tab[i] = (i >= SEQ) ? 0.f : biasT[u.head * SEQ + SEQ - 1 - i];
    if (tid < 64) ((float*)(shm + LDS_NINF))[tid] = -INFINITY;
  }
  if (u.fillk) kms[tid] = ksum[(size_t)(u.b * 8 + (tid >> 6)) * D_MOBA + u.head * HD + (tid & 63)];
  const bf16* Qw = P + (rowbase + q0 + wrow) * PITCH + u.qcol + wg * HD;
  bf16x8 qr[4];
#pragma unroll
  for (int d0 = 0; d0 < 4; ++d0) qr[d0] = *reinterpret_cast<const bf16x8*>(&Qw[(long)r32 * PITCH + d0 * 16 + hi * 8]);
  if (u.fill || u.fillk) ATT_LBAR();
  unsigned selmask = 0u;
  if (u.moba) {
    if (u.qb <= MB_TOPK) selmask = (1u << u.qb) - 1u;
    else {
      float gate[MB_NB - 1];
#pragma unroll
      for (int n = 0; n < MB_NB - 1; ++n) { float s = 0.f;
        if (n < u.qb) {
#pragma unroll
          for (int d0 = 0; d0 < 4; ++d0)
#pragma unroll
            for (int j = 0; j < 8; ++j) s += __uint_as_float((unsigned)(unsigned short)qr[d0][j] << 16) * kms[n * 64 + d0 * 16 + hi * 8 + j];
          s += __shfl_xor(s, 32); }
        gate[n] = s; }
#pragma unroll
      for (int r = 0; r < MB_TOPK; ++r) { int best = -1; float bv = 0.f;
#pragma unroll
        for (int n = 0; n < MB_NB - 1; ++n) if (n < u.qb && !((selmask >> n) & 1u) && (best < 0 || gate[n] > bv)) { best = n; bv = gate[n]; }
        selmask |= 1u << best; }
    }
  }
  const int qrel = wrow + r32, qpos = q0 + qrel;
  const unsigned tabqa = lds0 + LDS_TAB + (unsigned)((wg * TSW + (u.gqa ? 191 : SEQ - 1) - qpos + 4 * hi) * 4), ninfa = lds0 + LDS_NINF;
  float m = -1e30f, l = 0.f; f32x16 o[2]; o[0] = f32x16{}; o[1] = f32x16{};
  const int wq0 = q0 + wrow;
#define ATT_FLAGS(tt, need_, emask_, lsel_) do { lsel_ = true; \
    if (u.moba) { const int n_ = (tt) >> 2; \
      if (n_ < u.qb) { lsel_ = ((selmask >> n_) & 1u) != 0u; need_ = __any(lsel_); emask_ = false; } \
      else { need_ = (64 * (tt) <= wq0 + 31); emask_ = (64 * (tt) + 63 > wq0); } } \
    else { need_ = (64 * (tt) <= wq0 + 31) && (64 * (tt) + 63 >= wq0 - (SWA_W - 1)); emask_ = (64 * (tt) + 63 > wq0) || (wq0 + 31 - 64 * (tt) >= SWA_W); } } while (0)
#define ATT_QK_LOADS(tt, kslot, lsel_) do { bias_loads(bb, (lsel_) ? tabqa + 256u * (unsigned)(tt) : ninfa); k_loads(kf, ka0 + (kslot)); } while (0)
  const int lim = u.moba ? 0x7fffffff : SWA_W;
  int slotp = 3 * SLOTB, slot = 0, slotn = SLOTB, slotf = 2 * SLOTB;
  f32x16 pc0 = {}, pc1 = {}, pn0 = {}, pn1 = {};
  u32x4 pw0 = {}, pw1 = {}, pw2 = {}, pw3 = {};
  bool needC, emaskC, lselC, needN = false, emaskN = false, lselN = true, needP = false;
  asm volatile("" :: "v"(qr[0]), "v"(qr[1]), "v"(qr[2]), "v"(qr[3]));
  ATT_WAIT_BAR(2);
  ATT_FLAGS(tlo, needC, emaskC, lselC);
  if (needC) { f32x2v bb[16]; bf16x8 kf[8]; ATT_QK_LOADS(tlo, slot, lselC); ATT_LWAIT(0); qk_mma(pc0, pc1, kf, qr, bb); }
  for (int t = tlo; t <= thi; ++t) {
    ATT_WAIT_BAR(0);
    if (t + 2 <= thi) ATT_DMA(t + 2, slotf);
    if (t + 1 <= thi) { ATT_FLAGS(t + 1, needN, emaskN, lselN); } else needN = false;
    if (needN) { f32x2v bb[16]; bf16x8 kf[8]; ATT_QK_LOADS(t + 1, slotn, lselN); ATT_LWAIT(0); qk_mma(pn0, pn1, kf, qr, bb); }
    if (needP) { s16x4 vlo[2][4], vhi[2][4]; v_loads(vlo, vhi, vb0 + slotp); ATT_LWAIT(0); pv_mma(o, vlo, vhi, __builtin_bit_cast(bf16x8, pw0), __builtin_bit_cast(bf16x8, pw1), __builtin_bit_cast(bf16x8, pw2), __builtin_bit_cast(bf16x8, pw3)); }
    __builtin_amdgcn_sched_barrier(0);
    if (needC) {
      f32x16 p0 = pc0, p1 = pc1;
      if (emaskC) { const int dq = qpos - 64 * t - 4 * hi;
#pragma unroll
        for (int r = 0; r < 16; ++r) { const int c = (r & 3) + 8 * (r >> 2);
          p0[r] = ((unsigned)(dq - c) < (unsigned)lim) ? p0[r] : -INFINITY; p1[r] = ((unsigned)(dq - c - 32) < (unsigned)lim) ? p1[r] : -INFINITY; } }
      float rm = fmaxf(p0[0], p1[0]);
#pragma unroll
      for (int r = 1; r < 16; ++r) rm = fmaxf(fmaxf(rm, p0[r]), p1[r]);
      rm = fmaxf(rm, __shfl_xor(rm, 32));
      if (__any(rm > m + 8.0f)) {
        const float mnew = fmaxf(m, rm), alpha = __builtin_amdgcn_exp2f(m - mnew);
        l *= alpha; m = mnew;
        if (hi == 0) wsf[r32] = alpha;
        asm volatile("s_waitcnt lgkmcnt(0)" ::: "memory");
#pragma unroll
        for (int r = 0; r < 16; ++r) { const float f = wsf[crow(r, hi)]; o[0][r] *= f; o[1][r] *= f; }
      }
      float ls = 0.f;
#pragma unroll
      for (int r = 0; r < 16; ++r) { p0[r] = __builtin_amdgcn_exp2f(p0[r] - m); p1[r] = __builtin_amdgcn_exp2f(p1[r] - m); ls += p0[r] + p1[r]; }
      l += ls;
#define ATT_PKW(Pv, B) cvtpk_s(Pv[B], Pv[B + 1])
      pw0 = (u32x4){ATT_PKW(p0, 0), ATT_PKW(p0, 2), ATT_PKW(p0, 4), ATT_PKW(p0, 6)}; pw1 = (u32x4){ATT_PKW(p0, 8), ATT_PKW(p0, 10), ATT_PKW(p0, 12), ATT_PKW(p0, 14)};
      pw2 = (u32x4){ATT_PKW(p1, 0), ATT_PKW(p1, 2), ATT_PKW(p1, 4), ATT_PKW(p1, 6)}; pw3 = (u32x4){ATT_PKW(p1, 8), ATT_PKW(p1, 10), ATT_PKW(p1, 12), ATT_PKW(p1, 14)};
#undef ATT_PKW
    }
    needP = needC; pc0 = pn0; pc1 = pn1; needC = needN; emaskC = emaskN; lselC = lselN;
    { const int s_ = slotp; slotp = slot; slot = slotn; slotn = slotf; slotf = s_; }
  }
  if (needP) { s16x4 vlo[2][4], vhi[2][4]; v_loads(vlo, vhi, vb0 + slotp); ATT_LWAIT(0); pv_mma(o, vlo, vhi, __builtin_bit_cast(bf16x8, pw0), __builtin_bit_cast(bf16x8, pw1), __builtin_bit_cast(bf16x8, pw2), __builtin_bit_cast(bf16x8, pw3)); }
#undef ATT_FLAGS
#undef ATT_QK_LOADS
  l += __shfl_xor(l, 32);
  if (!u.moba) l += __builtin_amdgcn_exp2f((u.gqa ? sinks[u.head - NH_M + wg] * LOG2E : u.sink2) - m);
  if (hi == 0) wsf[32 + r32] = l;
  asm volatile("s_waitcnt lgkmcnt(0)" ::: "memory");
  float rli[16];
#pragma unroll
  for (int r = 0; r < 16; ++r) rli[r] = __builtin_amdgcn_rcpf(wsf[32 + crow(r, hi)]);
  bf16* Ow = O + (rowbase + q0 + wrow) * OPITCH + u.ocol + wg * HD;
  { bf16* stg = (bf16*)(shm + LDS_OST) + wid * 2048;
#pragma unroll
    for (int r = 0; r < 16; ++r) { const int orow = crow(r, hi);
#pragma unroll
      for (int d0 = 0; d0 < 2; ++d0) stg[orow * 64 + d0 * 32 + r32] = (bf16)(cvtpk_s(o[d0][r] * rli[r], 0.f) & 0xffffu); }
    asm volatile("s_waitcnt lgkmcnt(0)" ::: "memory");
#pragma unroll
    for (int i = 0; i < 4; ++i) { const int row = i * 8 + (lane >> 3), ch = lane & 7; const u32x4 v = *(const u32x4*)(stg + row * 64 + ch * 8); *(u32x4*)(Ow + (long)row * OPITCH + ch * 8) = v; } }
  ATT_LBAR();
#undef ATT_DMA
}
}

struct Frame {
    LAS unsigned char* lds;
    volatile LAS unsigned* MISC;
    gu32* ctl;
    int tid, lane, wave, vcu, G;
};
__device__ __forceinline__ float wave_sum(float v) {
#pragma unroll
    for (int o = 1; o < 64; o <<= 1) v += __shfl_xor(v, o);
    return v;
}
__device__ __forceinline__ int rel_bucket(int dist) {
    const int n = dist > 0 ? dist : 0;
    if (n < 16) return n;
    const int th[15] = {21, 27, 35, 46, 59, 77, 99, 128, 166, 216, 280, 363, 470, 609, 790};
    int bk = 16;
#pragma unroll
    for (int i = 0; i < 15; ++i) bk += (n >= th[i]) ? 1 : 0;
    return bk;
}
__device__ __forceinline__ void p0_transpose_item(const float* W, int K, int N, bf16* WT, int k0, int n0, int dst_row0, LAS float* scr, int lane) {
    { float v[32]; const float* wp = W + (size_t)(k0 + (lane >> 5)) * N + n0 + (lane & 31);
#pragma unroll
        for (int i = 0; i < 32; ++i) v[i] = __builtin_nontemporal_load(wp + (size_t)(2 * i) * N);
#pragma unroll
        for (int i = 0; i < 32; ++i) scr[(2 * i + (lane >> 5)) * 33 + (lane & 31)] = v[i]; }
    LDS_WAIT(); asm volatile("" ::: "memory");
    const int c = lane & 7;
#pragma unroll
    for (int j = 0; j < 4; ++j) { const int n = (lane >> 3) + 8 * j; const LAS float* s = scr + (8 * c) * 33 + n;
        v4u o; o.x = pk2(s[0 * 33], s[1 * 33]); o.y = pk2(s[2 * 33], s[3 * 33]); o.z = pk2(s[4 * 33], s[5 * 33]); o.w = pk2(s[6 * 33], s[7 * 33]);
        *(GAS v4u*)(WT + (size_t)(dst_row0 + n) * K + k0 + 8 * c) = o; }
    LDS_WAIT(); asm volatile("" ::: "memory");
}
__device__ __forceinline__ void p0_transpose_item_f8(const float* W, int K, int N, unsigned char* WT, int k0, int n0, int dst_row0, LAS float* scr, int lane) {
    v4u o[2][2];
    const int c = lane & 3;
#pragma unroll
    for (int hf = 0; hf < 2; ++hf) {
        { float v[32]; const float* wp = W + (size_t)(k0 + 64 * hf + (lane >> 5)) * N + n0 + (lane & 31);
#pragma unroll
            for (int i = 0; i < 32; ++i) v[i] = __builtin_nontemporal_load(wp + (size_t)(2 * i) * N);
#pragma unroll
            for (int i = 0; i < 32; ++i) scr[(2 * i + (lane >> 5)) * 33 + (lane & 31)] = v[i]; }
        LDS_WAIT(); asm volatile("" ::: "memory");
#pragma unroll
        for (int j = 0; j < 2; ++j) { const int n = (lane >> 2) + 16 * j; const LAS float* s = scr + (16 * c) * 33 + n;
            o[hf][j].x = pg8::pk4_f8(s[0 * 33] * WSCALE, s[1 * 33] * WSCALE, s[2 * 33] * WSCALE, s[3 * 33] * WSCALE); o[hf][j].y = pg8::pk4_f8(s[4 * 33] * WSCALE, s[5 * 33] * WSCALE, s[6 * 33] * WSCALE, s[7 * 33] * WSCALE);
            o[hf][j].z = pg8::pk4_f8(s[8 * 33] * WSCALE, s[9 * 33] * WSCALE, s[10 * 33] * WSCALE, s[11 * 33] * WSCALE); o[hf][j].w = pg8::pk4_f8(s[12 * 33] * WSCALE, s[13 * 33] * WSCALE, s[14 * 33] * WSCALE, s[15 * 33] * WSCALE); }
        LDS_WAIT(); asm volatile("" ::: "memory");
    }
#pragma unroll
    for (int j = 0; j < 2; ++j) { const int n = (lane >> 2) + 16 * j; unsigned char* rp = WT + (size_t)(dst_row0 + n) * K + k0 + 16 * c;
        *(GAS v4u*)(rp) = o[0][j]; *(GAS v4u*)(rp + 64) = o[1][j]; }
}
__device__ __forceinline__ void conv_load_half(f32x4 (&x)[16], const float* src, int N, int hf, int lane) {
    const int q = lane >> 4, m = lane & 15; const float* sp = src + (size_t)(hf * 64 + 4 * q) * N + 4 * m;
#pragma unroll
    for (int g = 0; g < 4; ++g)
#pragma unroll
        for (int i = 0; i < 4; ++i) x[g * 4 + i] = __builtin_nontemporal_load((const f32x4*)(sp + (size_t)(16 * g + i) * N));
}
__device__ __forceinline__ void conv_cvt_half(const f32x4 (&x)[16], LAS unsigned* t8, int hf, int lane) {
    const int q = lane >> 4, m = lane & 15;
#pragma unroll
    for (int g = 0; g < 4; ++g)
#pragma unroll
        for (int j = 0; j < 4; ++j) t8[(4 * m + j) * 33 + hf * 16 + 4 * g + q] = pg8::pk4_f8(x[g * 4 + 0][j] * WSCALE, x[g * 4 + 1][j] * WSCALE, x[g * 4 + 2][j] * WSCALE, x[g * 4 + 3][j] * WSCALE);
}
__device__ __forceinline__ void conv_store(unsigned char* dst, const LAS unsigned* t8, int lane) {
#pragma unroll
    for (int jj = 0; jj < 8; ++jj) { const int n = (lane >> 3) + 8 * jj, c = lane & 7; const LAS unsigned* rp = t8 + n * 33 + 4 * c;
        *(GAS v4u*)(dst + (size_t)n * 1024 + 16 * c) = (v4u){rp[0], rp[1], rp[2], rp[3]}; }
}
struct Args { const float* in[19]; float* out; unsigned char* ws; int ph_lo, ph_hi; };

__device__ __forceinline__ void p0_prologue(Frame& F, const Args& a) {
    LAS float* scr = (LAS float*)(F.lds + RING_OFF + F.wave * 16384);
    const int gw = F.vcu * NWAVES + F.wave, NGW = F.G * NWAVES;
    const float* w_in = a.in[5]; const float* w_out = a.in[7];
    bf16* Win_t = (bf16*)(a.ws + WS_WIN); bf16* Wout_t = (bf16*)(a.ws + WS_WOUT);
    constexpr int I_IN = 16 * (D_IN / 32), I_OUT = 16 * (D / 32), I_MOD = 96 * 8, I_BIAS = 16 * SEQ / 64;
    constexpr int NITEMS = I_IN + I_OUT + I_MOD + I_BIAS;
    for (int k = 0; k * NGW < NITEMS; ++k) {
        const int it = k * NGW + ((k & 1) ? NGW - 1 - gw : gw); if (it >= NITEMS) continue;
        int r = it;
        if (r < I_MOD) {
            const int cc = r % 96, ks = r / 96, j = cc * 64 + F.lane;
            const float* c = a.in[1]; const float* w_ada = a.in[3];
            { const int b = F.lane >> 3, kq = (F.lane & 7) * 16;
#pragma unroll
                for (int i = 0; i < 16; ++i) { const float cv = c[b * D + ks * 128 + kq + i]; scr[b * 128 + kq + i] = cv / (1.f + expf(-cv)); } }
            LDS_WAIT(); asm volatile("" ::: "memory");
            float acc[BATCH];
#pragma unroll
            for (int b = 0; b < BATCH; ++b) acc[b] = 0.f;
            const float* wp = w_ada + (size_t)(ks * 128) * (6 * D) + j;
#pragma unroll 1
            for (int k0 = 0; k0 < 128; k0 += 64) { float w[64];
#pragma unroll
                for (int i = 0; i < 64; ++i) w[i] = wp[(size_t)(k0 + i) * (6 * D)];
#pragma unroll
                for (int i = 0; i < 64; ++i)
#pragma unroll
                    for (int b = 0; b < BATCH; ++b) acc[b] += scr[b * 128 + k0 + i] * w[i]; }
            LDS_WAIT(); asm volatile("" ::: "memory");
            float* mp = (float*)(a.ws + WS_MODP) + (size_t)ks * BATCH * 6 * D;
#pragma unroll
            for (int b = 0; b < BATCH; ++b) mp[(size_t)b * 6 * D + j] = acc[b];
            continue;
        }
        r -= I_MOD;
        if (r < I_BIAS) { const int i = r * 64 + F.lane, h = i / SEQ, d = i % SEQ; ((float*)(a.ws + WS_BIAS))[i] = a.in[9][rel_bucket(d) * 16 + h] * LOG2E; continue; }
        r -= I_BIAS;
        if (r < I_IN) { const int nb = r % (D_IN / 32), kb = r / (D_IN / 32); p0_transpose_item(w_in, D, D_IN, Win_t, kb * 64, nb * 32, nb * 32, scr, F.lane); continue; }
        r -= I_IN;
        { const int nb = r % (D / 32), kb = r / (D / 32); p0_transpose_item(w_out, D, D, Wout_t, kb * 64, nb * 32, nb * 32, scr, F.lane); }
    }
}
constexpr int CV_GU = NE * 8 * (2 * DFF / 64), CV_DN = NE * 8 * (D / 64), CV_ITEMS = CV_GU + CV_DN;
struct ConvItem { const float* src; unsigned char* dst; int N; };
__device__ __forceinline__ ConvItem conv_addr(const Args& a, int r) {
    const float* w_gu = a.in[14]; const float* w_down = a.in[16]; unsigned char* Wgu_t = a.ws + WS_WGU; unsigned char* Wd_t = a.ws + WS_WD; ConvItem c;
    if (r < CV_GU) { const int per = 8 * (2 * DFF / 64), e = r / per, q = r % per, nb = q % (2 * DFF / 64), kb = q / (2 * DFF / 64), n0 = nb * 64;
        const int drow = (n0 < DFF) ? ((n0 >> 7) * 256 + (n0 & 127)) : (((n0 - DFF) >> 7) * 256 + 128 + ((n0 - DFF) & 127));
        c.src = w_gu + (size_t)e * D * 2 * DFF + (size_t)(kb * 128) * (2 * DFF) + n0; c.N = 2 * DFF; c.dst = Wgu_t + (size_t)e * 2 * DFF * D + (size_t)drow * D + kb * 128; }
    else { const int rr = r - CV_GU, per = 8 * (D / 64), e = rr / per, q = rr % per, nb = q % (D / 64), kb = q / (D / 64), n0 = nb * 64;
        c.src = w_down + (size_t)e * DFF * D + (size_t)(kb * 128) * D + n0; c.N = D; c.dst = Wd_t + (size_t)e * D * DFF + (size_t)n0 * DFF + kb * 128; }
    return c;
}
__device__ __forceinline__ void conv_range(Frame& F, const Args& a, int lo, int hi, int first, int stride) {
    LAS unsigned* scr = (LAS unsigned*)(F.lds + RING_OFF + F.wave * 16384);
    int r = lo + first; if (r >= hi) return;
    ConvItem cur = conv_addr(a, r);
    f32x4 xa[16], xb[16];
    conv_load_half(xa, cur.src, cur.N, 0, F.lane); conv_load_half(xb, cur.src, cur.N, 1, F.lane);
#pragma unroll 1
    for (;;) {
        const int rn = r + stride; const bool more = rn < hi;
        const ConvItem nxt = conv_addr(a, more ? rn : r);
        conv_cvt_half(xa, scr, 0, F.lane); conv_load_half(xa, nxt.src, nxt.N, 0, F.lane);
        conv_cvt_half(xb, scr, 1, F.lane); conv_load_half(xb, nxt.src, nxt.N, 1, F.lane);
        LDS_WAIT(); asm volatile("" ::: "memory");
        conv_store(cur.dst, scr, F.lane);
        LDS_WAIT(); asm volatile("" ::: "memory");
        if (!more) break;
        cur = nxt; r = rn;
    }
}
__device__ __forceinline__ void p1_xn(Frame& F, const Args& a) {
    const float* modp = (const float*)(a.ws + WS_MODP); const float* b_ada = a.in[4]; float* modf = (float*)(a.ws + WS_MODF);
    for (int i = blockIdx.x * 512 + F.tid; i < BATCH * 6 * D; i += F.G * 512) { float s = b_ada[i % (6 * D)];
#pragma unroll
        for (int ks = 0; ks < 8; ++ks) s += modp[(size_t)ks * BATCH * 6 * D + i];
        modf[i] = s; }
    LAS float* tab = (LAS float*)(F.lds + RING_OFF);
    const float* x = a.in[0]; const float* g = a.in[2]; bf16* XN = (bf16*)(a.ws + WS_XN);
    for (int chunk = blockIdx.x; chunk < NTOK / 64; chunk += F.G) {
        const int b = chunk / (SEQ / 64);
        f32x4 v[8][4];
#pragma unroll
        for (int q = 0; q < 8; ++q) { const GAS f32x4* xr = (const GAS f32x4*)(x + (size_t)(chunk * 64 + F.wave + q * NWAVES) * D) + F.lane;
#pragma unroll
            for (int j = 0; j < 4; ++j) v[q][j] = xr[64 * j]; }
        __syncthreads();
        for (int i = F.tid; i < 2 * D; i += 512) { const int col = i & (D - 1), chunkid = (i < D) ? 1 : 0; float s = b_ada[chunkid * D + col];
#pragma unroll
            for (int ks = 0; ks < 8; ++ks) s += modp[(size_t)ks * BATCH * 6 * D + (size_t)b * 6 * D + chunkid * D + col];
            tab[i] = (i < D) ? g[col] * (1.f + s) : s; }
        __syncthreads();
#pragma unroll
        for (int q = 0; q < 8; ++q) { float s = 0.f;
#pragma unroll
            for (int j = 0; j < 4; ++j) s += (v[q][j].x * v[q][j].x + v[q][j].y * v[q][j].y) + (v[q][j].z * v[q][j].z + v[q][j].w * v[q][j].w);
            const float rstd = 1.f / sqrtf(wave_sum(s) * (1.f / D) + EPS);
            GAS unsigned long long* o8 = (GAS unsigned long long*)(XN + (size_t)(chunk * 64 + F.wave + q * NWAVES) * D) + F.lane;
#pragma unroll
            for (int j = 0; j < 4; ++j) { const int col = 4 * F.lane + 256 * j; const f32x4 gs = *(const LAS f32x4*)(tab + col), sh = *(const LAS f32x4*)(tab + D + col);
                const f32x4 h = v[q][j] * rstd * gs + sh;
                o8[64 * j] = (unsigned long long)pk2(h.x, h.y) | ((unsigned long long)pk2(h.z, h.w) << 32); } }
    }
}

__device__ __forceinline__ void p5_router(Frame& F, const Args& a) {
    typedef __attribute__((ext_vector_type(8))) short bx8; typedef __attribute__((ext_vector_type(16))) float fx16;
    const unsigned short* x1 = (const unsigned short*)(a.ws + WS_X1); const float* modf = (const float*)(a.ws + WS_MODF); const float* g_ffn = a.in[11]; const float* w_router = a.in[12]; const float* b_router = a.in[13];
    unsigned char* H2 = a.ws + WS_H2; int* inv = (int*)(a.ws + WS_INV); float* tok_w = (float*)(a.ws + WS_TOKW);
    LAS float* part = (LAS float*)(F.lds + RING_OFF);
    LAS float* ssq = (LAS float*)(F.lds + RING_OFF + 32768);
    LAS float* cpart = (LAS float*)(F.lds + RING_OFF + 32768 + 1024);
    LAS float* lg = (LAS float*)(F.lds + RING_OFF + 32768 + 3072);
    LAS float* rs = (LAS float*)(F.lds + RING_OFF + 32768 + 3072 + 4352);
    LAS int* cb = (LAS int*)(F.lds + RING_OFF + 32768 + 3072 + 4352 + 128);
    LAS float* gsl = (LAS float*)(F.lds + RING_OFF + 49152);
    LAS float* shl = (LAS float*)(F.lds + RING_OFF + 49152 + 4096);
    const int lane = F.lane, w = F.wave, r32 = lane & 31, hi = lane >> 5;
#pragma unroll 1
    for (int chunk = blockIdx.x; chunk < NTOK / 64; chunk += F.G) {
        const int b = chunk / (SEQ / 64);
        __syncthreads();
        for (int i = F.tid; i < D; i += NWAVES * 64) { gsl[i] = g_ffn[i] * (1.f + modf[(size_t)b * 6 * D + 4 * D + i]); shl[i] = modf[(size_t)b * 6 * D + 3 * D + i]; }
        if (F.tid < NE) cb[F.tid] = 0;
        __syncthreads();
        bx8 ahi[8], alo[8]; float cp = 0.f;
        const float* wrp = w_router + (size_t)(128 * w + 8 * hi) * NE + r32; const LAS float* gsp = gsl + 128 * w + 8 * hi; const LAS float* shp = shl + 128 * w + 8 * hi;
#pragma unroll
        for (int s = 0; s < 8; ++s) {
            unsigned ph[4], pl[4];
#pragma unroll
            for (int j2 = 0; j2 < 4; ++j2) { float v[2];
#pragma unroll
                for (int q = 0; q < 2; ++q) { const int kk = 16 * s + 2 * j2 + q; const float wr_ = wrp[kk * NE]; cp += shp[kk] * wr_; v[q] = gsp[kk] * wr_; }
                const unsigned h0 = f2bf(v[0]), h1 = f2bf(v[1]); ph[j2] = h0 | (h1 << 16);
                pl[j2] = f2bf(v[0] - __uint_as_float(h0 << 16)) | (f2bf(v[1] - __uint_as_float(h1 << 16)) << 16); }
            ahi[s] = __builtin_bit_cast(bx8, (v4u){ph[0], ph[1], ph[2], ph[3]}); alo[s] = __builtin_bit_cast(bx8, (v4u){pl[0], pl[1], pl[2], pl[3]});
        }
        cpart[(w * 2 + hi) * 32 + r32] = cp;
#pragma unroll 1
        for (int pass = 0; pass < 2; ++pass) {
            const int tok = chunk * 64 + pass * 32 + r32;
            const unsigned short* xr = x1 + (size_t)tok * D + 128 * w + 8 * hi;
            float ss = 0.f; fx16 acc = {};
#pragma unroll
            for (int s = 0; s < 8; ++s) {
                const v4u xw = *(const GAS v4u*)(xr + 16 * s);
#pragma unroll
                for (int q = 0; q < 4; ++q) { const float v0 = __uint_as_float(xw[q] << 16), v1 = __uint_as_float(xw[q] & 0xffff0000u); ss += v0 * v0 + v1 * v1; }
                const bx8 bhi = __builtin_bit_cast(bx8, xw);
                acc = __builtin_amdgcn_mfma_f32_32x32x16_bf16(ahi[s], bhi, acc, 0, 0, 0);
                acc = __builtin_amdgcn_mfma_f32_32x32x16_bf16(alo[s], bhi, acc, 0, 0, 0);
            }
            ss += __shfl_xor(ss, 32);
            __syncthreads();
#pragma unroll
            for (int r = 0; r < 16; ++r) part[(w * 32 + ((r & 3) + 8 * (r >> 2) + 4 * hi)) * 32 + r32] = acc[r];
            if (hi == 0) ssq[w * 32 + r32] = ss;
            __syncthreads();
            { const int tk = F.tid & 31, eg = F.tid >> 5;
                float sq = 0.f;
#pragma unroll
                for (int ww = 0; ww < 8; ++ww) sq += ssq[ww * 32 + tk];
                const float rstd = 1.f / sqrtf(sq * (1.f / D) + EPS);
                if (eg == 0) rs[tk] = rstd;
#pragma unroll
                for (int q = 0; q < 2; ++q) { const int e = 2 * eg + q; float sum = 0.f, c = b_router[e];
#pragma unroll
                    for (int ww = 0; ww < 8; ++ww) sum += part[(ww * 32 + e) * 32 + tk];
#pragma unroll
                    for (int ww = 0; ww < 16; ++ww) c += cpart[ww * 32 + e];
                    lg[tk * 33 + e] = rstd * sum + c; } }
            __syncthreads();
            { const float rstd = rs[r32]; unsigned char* hr = H2 + (size_t)tok * D + 128 * w + 8 * hi;
#pragma unroll
                for (int s = 0; s < 8; ++s) { unsigned pk[2]; const v4u xw = *(const GAS v4u*)(xr + 16 * s);
#pragma unroll
                    for (int q = 0; q < 2; ++q) { const f32x4 xv = {__uint_as_float(xw[2 * q] << 16), __uint_as_float(xw[2 * q] & 0xffff0000u), __uint_as_float(xw[2 * q + 1] << 16), __uint_as_float(xw[2 * q + 1] & 0xffff0000u)};
                        const f32x4 g4 = *(const LAS f32x4*)(gsp + 16 * s + 4 * q), h4 = *(const LAS f32x4*)(shp + 16 * s + 4 * q);
                        const f32x4 hv = xv * rstd * g4 + h4; pk[q] = pg8::pk4_f8(hv.x, hv.y, hv.z, hv.w); }
                    *(GAS unsigned long long*)(hr + 16 * s) = (unsigned long long)pk[0] | ((unsigned long long)pk[1] << 32); } }
            if (w == 0 && lane < 32) {
                float lgv[NE];
#pragma unroll
                for (int i = 0; i < NE; ++i) lgv[i] = lg[lane * 33 + i];
                int idx[TOPK]; float val[TOPK]; unsigned used = 0;
#pragma unroll
                for (int r = 0; r < TOPK; ++r) { int best = -1; float bv = 0.f;
#pragma unroll
                    for (int i = 0; i < NE; ++i) if (!((used >> i) & 1u) && (best < 0 || lgv[i] > bv)) { best = i; bv = lgv[i]; }
                    used |= 1u << best; idx[r] = best; val[r] = bv; }
                float wsum = 0.f, wv[TOPK];
#pragma unroll
                for (int r = 0; r < TOPK; ++r) { wv[r] = __expf(val[r] - val[0]); wsum += wv[r]; }
                const int tk = chunk * 64 + pass * 32 + lane; const float inv_ws = 1.f / wsum;
                const unsigned selbits = (1u << idx[0]) | (1u << idx[1]) | (1u << idx[2]) | (1u << idx[3]);
                int rk[TOPK] = {0, 0, 0, 0};
#pragma unroll 1
                for (int e = 0; e < NE; ++e) {
                    const unsigned long long mm = __ballot((selbits >> e) & 1u);
                    const int base = cb[e], rnk = base + __popcll(mm & ((1ull << lane) - 1ull));
#pragma unroll
                    for (int r = 0; r < TOPK; ++r) if (idx[r] == e) rk[r] = rnk;
                    if (lane == 0) cb[e] = base + __popcll(mm);
                }
#pragma unroll
                for (int r = 0; r < TOPK; ++r) { inv[((size_t)chunk * NE + idx[r]) * 64 + rk[r]] = tk * 4 + r; tok_w[tk * 4 + r] = wv[r] * inv_ws; }
            }
        }
        if (w == 0 && lane < NE) ((int*)(a.ws + WS_CNTC))[lane * 256 + chunk] = cb[lane];
    }
}
__device__ __forceinline__ void build_tiles(Frame& F, const Args& a) {
    LAS int* tile_e = (LAS int*)(F.lds + LDS_TILE_E); LAS int* ntl = (LAS int*)(F.lds + LDS_NT); LAS int* tbase = (LAS int*)(F.lds + LDS_TBASE); LAS int* cnte = (LAS int*)(F.lds + LDS_CNTE);
    LAS int* pre = (LAS int*)(F.lds + RING_OFF);
    __syncthreads();
    { const int e = F.tid >> 4, part = F.tid & 15; const int* cp = (const int*)(a.ws + WS_CNTC) + e * 256 + part * 16;
        int v[16]; int sum = 0;
#pragma unroll
        for (int q = 0; q < 4; ++q) { const int4 t4 = *(const int4*)(cp + 4 * q); v[4 * q] = t4.x; v[4 * q + 1] = t4.y; v[4 * q + 2] = t4.z; v[4 * q + 3] = t4.w; }
#pragma unroll
        for (int q = 0; q < 16; ++q) { const int t = v[q]; v[q] = sum; sum += t; }
        int inc = sum;
#pragma unroll
        for (int d = 1; d < 16; d <<= 1) { const int n = __shfl_up(inc, d, 16); if (part >= d) inc += n; }
        const int excl = inc - sum;
#pragma unroll
        for (int q = 0; q < 16; ++q) pre[e * 256 + part * 16 + q] = excl + v[q];
        if (part == 15) cnte[e] = inc; }
    __syncthreads();
    if (F.tid < NE) { const int e = F.tid, nt = (cnte[e] + 255) >> 8; int inc = nt;
#pragma unroll
        for (int d = 1; d < NE; d <<= 1) { const int n = __shfl_up(inc, d, NE); if (e >= d) inc += n; }
        const int base = inc - nt; tbase[e] = base; for (int j = 0; j < nt; ++j) tile_e[base + j] = e;
        if (e == NE - 1) ntl[0] = inc; }
    __syncthreads();
}
__device__ __forceinline__ void p8_final(Frame& F, const Args& a) {
    const unsigned short* x1 = (const unsigned short*)(a.ws + WS_X1); const unsigned char* Y = a.ws + WS_Y; const float* modf = (const float*)(a.ws + WS_MODF);
    const int* tok_slot = (const int*)(a.ws + WS_TOKP); const float* tok_w = (const float*)(a.ws + WS_TOKW);
    const float* gfin = a.in[18];
    const int gw = F.vcu * NWAVES + F.wave, NGW = F.G * NWAVES;
    constexpr int P8R = 4;
    typedef int i32x4 __attribute__((ext_vector_type(4)));
    i32x4 np[P8R]; f32x4 nw[P8R];
#define P8_ROUTE(r0) do { _Pragma("unroll") for (int _q = 0; _q < P8R; ++_q) { const int _r = (r0) + _q * NGW; if (_r < NTOK) { np[_q] = *(const GAS i32x4*)(tok_slot + _r * 4); nw[_q] = *(const GAS f32x4*)(tok_w + _r * 4); } } } while (0)
    P8_ROUTE(gw);
    for (int row0 = gw; row0 < NTOK; row0 += P8R * NGW) {
        i32x4 cp[P8R]; f32x4 cw[P8R];
#pragma unroll
        for (int q = 0; q < P8R; ++q) { cp[q] = np[q]; cw[q] = nw[q]; }
        unsigned yv[P8R][TOPK][4]; pg8::u32x2 xv[P8R][4];
#pragma unroll
        for (int q = 0; q < P8R; ++q) { const int row = row0 + q * NGW; if (row < NTOK) {
#pragma unroll
            for (int k = 0; k < TOPK; ++k) { const int slot = __builtin_amdgcn_readfirstlane(cp[q][k]);
                const GAS unsigned* yr = (const GAS unsigned*)(Y + (size_t)slot * D) + F.lane;
#pragma unroll
                for (int j = 0; j < 4; ++j) yv[q][k][j] = yr[64 * j]; }
            const GAS pg8::u32x2* xr = (const GAS pg8::u32x2*)(x1 + (size_t)row * D) + F.lane;
#pragma unroll
            for (int j = 0; j < 4; ++j) xv[q][j] = xr[64 * j]; } }
        P8_ROUTE(row0 + P8R * NGW);
#pragma unroll
        for (int q = 0; q < P8R; ++q) { const int row = row0 + q * NGW; if (row < NTOK) {
            const int b = row / SEQ; const float* gf = modf + (size_t)b * 6 * D + 5 * D;
            f32x4 acc[4];
#pragma unroll
            for (int j = 0; j < 4; ++j) acc[j] = (f32x4){0.f, 0.f, 0.f, 0.f};
#pragma unroll
            for (int k = 0; k < TOPK; ++k) { const float wk = cw[q][k] * (1.0f / YSCALE);
#pragma unroll
                for (int j = 0; j < 4; ++j) { const int qq = (int)yv[q][k][j]; const auto lo = __builtin_amdgcn_cvt_pk_f32_fp8(qq, false), hi = __builtin_amdgcn_cvt_pk_f32_fp8(qq, true);
                    acc[j].x += wk * lo[0]; acc[j].y += wk * lo[1]; acc[j].z += wk * hi[0]; acc[j].w += wk * hi[1]; } }
            float s = 0.f; f32x4 v[4];
#pragma unroll
            for (int j = 0; j < 4; ++j) { const f32x4 g4 = *(const GAS f32x4*)(gf + 4 * F.lane + 256 * j); const f32x4 x4 = {__uint_as_float(xv[q][j].x << 16), __uint_as_float(xv[q][j].x & 0xffff0000u), __uint_as_float(xv[q][j].y << 16), __uint_as_float(xv[q][j].y & 0xffff0000u)}; v[j] = x4 + g4 * acc[j]; s += (v[j].x * v[j].x + v[j].y * v[j].y) + (v[j].z * v[j].z + v[j].w * v[j].w); }
            const float rstd = 1.f / sqrtf(wave_sum(s) * (1.f / D) + EPS);
            GAS f32x4* orow = (GAS f32x4*)(a.out + (size_t)row * D) + F.lane;
#pragma unroll
            for (int j = 0; j < 4; ++j) { const f32x4 g4 = *(const GAS f32x4*)(gfin + 4 * F.lane + 256 * j); orow[64 * j] = v[j] * rstd * g4; } } }
    }
#undef P8_ROUTE
}
__device__ __forceinline__ void build_ridx(Frame& F, const Args& a, int nN) {
    const LAS int* tile_e = (const LAS int*)(F.lds + LDS_TILE_E); const LAS int* tbase = (const LAS int*)(F.lds + LDS_TBASE); const LAS int* cnte = (const LAS int*)(F.lds + LDS_CNTE);
    const LAS int* pre = (const LAS int*)(F.lds + RING_OFF); const int ntiles = *(const LAS int*)(F.lds + LDS_NT);
    LAS int* ridx = (LAS int*)(F.lds + LDS_RIDX); const int* lists = (const int*)(a.ws + WS_INV); int* tok_slot = (int*)(a.ws + WS_TOKP);
    int adr[5], slot[5], flag[5];
#pragma unroll
    for (int k = 0; k < 5; ++k) { const int it = F.tid + k * (NWAVES * 64), i = it >> 8, r = it & 255; int t, pn_; flag[k] = 0; adr[k] = 0; slot[k] = 0;
        if (pg8::moe_unit(i, (int)blockIdx.x, F.G, nN, cnte, tbase, ntiles, t, pn_)) {
            const int e = tile_e[t], j = t - tbase[e], c = cnte[e]; int pos = j * 256 + r; const bool real = pos < c; if (!real) pos = 0;
            int lo = 0;
#pragma unroll
            for (int st = 128; st >= 1; st >>= 1) if (pre[e * 256 + lo + st] <= pos) lo += st;
            adr[k] = (lo * NE + e) * 64 + (pos - pre[e * 256 + lo]); slot[k] = t * 256 + r; flag[k] = (pn_ == 0 && real) ? 2 : 1; } }
    int ent[5];
#pragma unroll
    for (int k = 0; k < 5; ++k) ent[k] = flag[k] ? lists[adr[k]] : 0;
#pragma unroll
    for (int k = 0; k < 5; ++k) if (flag[k]) { ridx[F.tid + k * (NWAVES * 64)] = ent[k] >> 2; if (flag[k] == 2) tok_slot[ent[k]] = slot[k]; }
    __syncthreads();
}

__global__ void __launch_bounds__(NWAVES * 64, 2) mega_fwd(Args args) {
    extern __shared__ __attribute__((aligned(16))) unsigned char lds[];
    Frame F;
    F.lds = (LAS unsigned char*)lds;
    F.MISC = (volatile LAS unsigned*)(F.lds + MISC_OFF);
    F.tid = threadIdx.x; F.lane = F.tid & 63; F.wave = __builtin_amdgcn_readfirstlane(F.tid >> 6);
    F.G = gridDim.x; { const int bx = blockIdx.x; F.vcu = (F.G % 8 == 0) ? (bx % 8) * (F.G / 8) + bx / 8 : bx; }
    unsigned char* ws = args.ws;
    F.ctl = (gu32*)(ws + WS_CTL);
    for (int u = F.tid; u < 512 / 4; u += NWAVES * 64) ((LAS unsigned*)(F.lds + LDSCTL_OFF))[u] = 0u;
    __syncthreads();
    XcdBarrier bar = xcd_barrier_post((unsigned*)(F.ctl + CW_BAR), F.MISC + 8);
    const int lo = args.ph_lo, hi = args.ph_hi;
#ifndef PHASE_MASK
#define PHASE_MASK 0x1ff
#endif
#define IN(k) (((PHASE_MASK >> (k)) & 1) && lo <= (k) && (k) < hi)
#define BOTH(k) (IN(k) && IN((k) + 1))
#define GRID_BAR() xcd_barrier(bar)
#define REFRESH() do { int t_ = threadIdx.x; asm volatile("" : "+v"(t_)); F.tid = t_; F.lane = t_ & 63; F.wave = __builtin_amdgcn_readfirstlane(t_ >> 6); } while (0)
    const bool split = (F.G == 256); constexpr int NCONV = 64, NCONV3 = 64;
    const bool is_conv = split && (int)blockIdx.x >= F.G - NCONV, is_conv3 = split && (int)blockIdx.x >= F.G - NCONV3;
    const int NC = split ? F.G - NCONV : F.G, NC3 = split ? F.G - NCONV3 : F.G, cidx = (int)blockIdx.x;
    const int nconvw = (split ? NCONV : F.G) * NWAVES, convw = (split ? (int)blockIdx.x - (F.G - NCONV) : (int)blockIdx.x) * NWAVES;
    const int nconvw3 = (split ? NCONV3 : F.G) * NWAVES, convw3 = (split ? (int)blockIdx.x - (F.G - NCONV3) : (int)blockIdx.x) * NWAVES;
    constexpr int CV_SPLIT = 4096;
    if (IN(0)) { p0_prologue(F, args); if (!split) conv_range(F, args, 0, CV_ITEMS, F.vcu * NWAVES + F.wave, F.G * NWAVES); if (BOTH(0)) GRID_BAR(); }
    if (IN(1)) { REFRESH(); p1_xn(F, args); if (BOTH(1)) GRID_BAR(); }
    if (IN(2)) {
        if (is_conv) { REFRESH(); conv_range(F, args, 0, CV_SPLIT, convw + F.wave, nconvw); }
        else {
            pg8::Gemm g{(const bf16*)(ws + WS_XN), (const bf16*)(ws + WS_WIN), NTOK, D_IN, D}; pg8::StaticOrder S; S.init(NTOK, D_IN, NC, cidx);
            pg8::EpiProj E{(bf16*)(ws + WS_PROJ), args.in[6], (float*)(F.ctl + CW_KSUM)};
            pg8::gemm_phase<pg8::EpiProj, pg8::StaticOrder, false, true>(F.lds + RING_OFF, g, S, E);
        }
        if (BOTH(2)) GRID_BAR();
    }
    if (IN(3)) {
        if (is_conv3) { REFRESH(); conv_range(F, args, CV_SPLIT, CV_ITEMS, convw3 + F.wave, nconvw3); }
        else {
            const float* sinks = args.in[10]; int prev_key = -1;
            for (int round = 0; ; ++round) {
                const int rank = round * NC3 + ((round & 1) ? (((NC3 & 7) == 0) ? ((NC3 - 1 - cidx) ^ 7) : NC3 - 1 - cidx) : cidx); if (rank >= 1024) break;
                att::UnitDesc u;
                if (rank < 512) { const int bh = rank & 63, h = bh & 7; u.b = bh >> 3; u.qb = 7 - (rank >> 6); u.q0 = u.qb * 256; u.gqa = 0; u.moba = 1;
                    u.qcol = h * 64; u.kcol = 512 + h * 64; u.vcol = 1024 + h * 64; u.ocol = h * 64; u.head = h; u.sink2 = 0.f; u.fill = (h != prev_key); prev_key = h; u.fillk = 1; }
                else { const int idx = rank - 512, bk = idx & 15, kvh = bk & 1; u.b = bk >> 1; u.q0 = (31 - (idx >> 4)) * 64; u.qb = u.q0 >> 8; u.gqa = 1; u.moba = 0;
                    u.qcol = 1536 + kvh * 256; u.kcol = 2048 + kvh * 64; u.vcol = 2176 + kvh * 64; u.ocol = 512 + kvh * 256; u.head = 8 + kvh * 4; u.sink2 = 0.f; u.fill = (64 + kvh != prev_key); prev_key = 64 + kvh; u.fillk = 0; }
                att::attn_unit(u, (const bf16*)(ws + WS_PROJ), (bf16*)(ws + WS_O), (const float*)(ws + WS_BIAS), (const float*)(F.ctl + CW_KSUM), sinks, (char*)lds + RING_OFF);
            }
        }
        if (BOTH(3)) GRID_BAR();
    }
    if (IN(4)) {
        pg8::Gemm g{(const bf16*)(ws + WS_O), (const bf16*)(ws + WS_WOUT), NTOK, D, D}; pg8::StaticOrder S; S.init(NTOK, D, F.G, (int)blockIdx.x);
        pg8::EpiX1 E{args.in[0], (pg8::bf16_t*)(ws + WS_X1), args.in[8], (const float*)(ws + WS_MODF)};
        pg8::gemm_phase<pg8::EpiX1, pg8::StaticOrder, false, true>(F.lds + RING_OFF, g, S, E);
        if (BOTH(4)) GRID_BAR();
    }
    if (IN(5)) { REFRESH(); p5_router(F, args); if (BOTH(5)) GRID_BAR(); }
    if (IN(6)) {
        REFRESH(); build_tiles(F, args); build_ridx(F, args, 2 * DFF / 256);
        pg8::Gemm g{(const bf16*)(ws + WS_H2), (const bf16*)(ws + WS_WGU), MAXSLOTS, 2 * DFF, D / 2};
        pg8::GroupedOrder S{2 * DFF / 256, F.G, (int)blockIdx.x, *(const LAS int*)(F.lds + LDS_NT), (const LAS int*)(F.lds + LDS_TILE_E), (const LAS int*)(F.lds + LDS_RIDX), (size_t)2 * DFF * D, (const LAS int*)(F.lds + LDS_CNTE), (const LAS int*)(F.lds + LDS_TBASE)};
        pg8::EpiSwiglu8 E{ws + WS_ACT, args.in[15]};
        pg8::gemm_phase<pg8::EpiSwiglu8, pg8::GroupedOrder, false, true, true>(F.lds + RING_OFF, g, S, E);
        if (BOTH(6)) GRID_BAR();
    }
    if (IN(7)) {
        REFRESH(); if (!IN(6)) build_tiles(F, args);
        pg8::Gemm g{(const bf16*)(ws + WS_ACT), (const bf16*)(ws + WS_WD), MAXSLOTS, D, DFF / 2};
        pg8::GroupedOrder S{D / 256, F.G, (int)blockIdx.x, *(const LAS int*)(F.lds + LDS_NT), (const LAS int*)(F.lds + LDS_TILE_E), (const LAS int*)nullptr, (size_t)D * DFF, (const LAS int*)(F.lds + LDS_CNTE), (const LAS int*)(F.lds + LDS_TBASE)};
        pg8::EpiDown8 E{ws + WS_Y, args.in[17]};
        pg8::gemm_phase<pg8::EpiDown8, pg8::GroupedOrder, false, true, true>(F.lds + RING_OFF, g, S, E);
        if (BOTH(7)) GRID_BAR();
    }
    if (IN(8)) { REFRESH(); p8_final(F, args); }
#undef IN
#undef BOTH
}

#ifndef MK_PER_PHASE
#define MK_PER_PHASE 0
#endif
extern "C" void kernel_launch(void* const* d_in, const int* in_sizes, int n_in, void* d_out, int out_size, void* d_ws, size_t ws_size, hipStream_t stream) {
    static int grid = 0;
    if (grid == 0) {
        if (n_in != 19 || ws_size < WS_END) { fprintf(stderr, "kernel_launch: unexpected n_in %d / ws %zu\n", n_in, ws_size); grid = -1; return; }
        int dev = 0, cus = 0, per_cu = 0;
        if (hipGetDevice(&dev) != hipSuccess || hipDeviceGetAttribute(&cus, hipDeviceAttributeMultiprocessorCount, dev) != hipSuccess) { grid = -1; return; }
        if (hipFuncSetAttribute((const void*)mega_fwd, hipFuncAttributeMaxDynamicSharedMemorySize, LDS_BYTES) != hipSuccess) { fprintf(stderr, "kernel_launch: hipFuncSetAttribute failed\n"); grid = -1; return; }
        if (hipOccupancyMaxActiveBlocksPerMultiprocessor(&per_cu, (const void*)mega_fwd, NWAVES * 64, LDS_BYTES) != hipSuccess || per_cu < 1) fprintf(stderr, "kernel_launch: occupancy query reports %d\n", per_cu);
        (void)hipGetLastError();
        grid = cus;
    }
    if (grid < 0) return;
    unsigned char* ws = (unsigned char*)d_ws;
    (void)hipMemsetAsync(ws + WS_CTL, 0, CTL_ZERO_BYTES, stream);
    Args a{};
    for (int i = 0; i < 19; ++i) a.in[i] = (const float*)d_in[i];
    a.out = (float*)d_out; a.ws = ws;
#if MK_PER_PHASE
    for (int ph = 0; ph < 9; ++ph) { a.ph_lo = ph; a.ph_hi = ph + 1; hipLaunchKernelGGL(mega_fwd, dim3(grid), dim3(NWAVES * 64), LDS_BYTES, stream, a); }
#else
    a.ph_lo = 0; a.ph_hi = 9; hipLaunchKernelGGL(mega_fwd, dim3(grid), dim3(NWAVES * 64), LDS_BYTES, stream, a);
#endif
}
```

```cpp
#include <hip/hip_runtime.h>
#include <hip/hip_bf16.h>
#include <cstdio>
#include <cstdint>
#include <cmath>

constexpr int D = 1024, BATCH = 8, SEQ = 2048, NTOK = BATCH * SEQ;
constexpr int HD = 64, NH_M = 8, NH_S = 8, NKV_S = 2;
constexpr int D_MOBA = 512, D_SWA_Q = 512, D_SWA_KV = 128, D_IN = 2304;
constexpr int MB_L = 256, MB_NB = SEQ / MB_L, MB_TOPK = 3;
constexpr int SWA_W = 128;
constexpr int NE = 32, TOPK = 4, DFF = 1024;
constexpr float EPS = 1e-5f, NEGF = -1e30f;
constexpr int MAXTILES = 288;
constexpr int MAXSLOTS = MAXTILES * 256;
constexpr float LOG2E = 1.4426950408889634f;
constexpr float YSCALE = 16.0f;
constexpr float WSCALE = 32.0f;
constexpr float QSCALE = 0.125f * LOG2E;

namespace pg8 {
#define PG8_LAS __attribute__((address_space(3)))
typedef unsigned short bf16_t;
typedef short bf16x8 __attribute__((ext_vector_type(8)));
typedef float f32x4 __attribute__((ext_vector_type(4)));
typedef unsigned u32x4 __attribute__((ext_vector_type(4)));
typedef int v4i_t __attribute__((ext_vector_type(4)));
constexpr int BM = 256, BK = 64, HALF = 128, HTB = HALF * BK * 2  , STAGE_BYTES = 8 * HTB, NXCD = 8, WGM = 8;

__host__ __device__ __forceinline__ int lds_byte(int r, int c) { const int st = (r >> 4) * 2 + (c >> 5), rr = r & 15, cc = c & 31, ob = rr * 64 + cc * 2; return st * 1024 + (ob ^ (((ob >> 9) & 1) << 5)); }
__host__ __device__ __forceinline__ void stage_rc(int b, int& R, int& C) { const int st = b / 1024, sb = b % 1024, swz = sb ^ (((sb >> 9) & 1) << 5); R = (st >> 1) * 16 + swz / 64; C = (st & 1) * 32 + (swz % 64) / 2; }
__host__ __device__ __forceinline__ int perm32(int rho) { const int n = rho >> 4, i = rho & 15; return 8 * (i >> 2) + 4 * n + (i & 3); }

struct Unit { int pm, pn, e; };
struct Gemm { const bf16_t* A; const bf16_t* Bt; int M, N, K; };

struct StaticOrder {
    int nM, nN, nwg, G, c;
    __host__ __device__ void init(int M, int N, int G_, int c_) { nM = M / BM; nN = N / BM; nwg = nM * nN; G = G_; c = c_; }
    __host__ __device__ bool next(int i, Unit& u) const {
        const long L = (long)i * G + c; if (L >= nwg) return false;
        int wgid = (int)L; { const int q = nwg / NXCD, r = nwg % NXCD, xcd = wgid % NXCD, off = wgid / NXCD; wgid = (xcd < r ? xcd * (q + 1) : r * (q + 1) + (xcd - r) * q) + off; }
        const int nig = WGM * nN, gid = wgid / nig, fm = gid * WGM, gsz = (nM - fm) < WGM ? (nM - fm) : WGM;
        u.pm = fm + ((wgid % nig) % gsz); u.pn = (wgid % nig) / gsz; u.e = 0; return true;
    }
    __device__ __forceinline__ size_t abase(const Unit& u, int h, int K) const { return (size_t)(u.pm * BM + h * HALF) * K * 2; }
    __device__ __forceinline__ unsigned alane(int, const Unit&, int, int, unsigned voff, int) const { return voff; }
    __device__ __forceinline__ size_t bbase(const Unit& u, size_t tstep) const { return (size_t)u.pn * tstep; }
    __device__ __forceinline__ void a_ready(const Unit&) const {}
    __device__ __forceinline__ void done(const Unit&) const {}
};
__device__ __forceinline__ bool moe_unit(int i, int c, int G, int nN, const PG8_LAS int* cnte, const PG8_LAS int* tbase, int ntiles, int& t, int& pn) {
    if ((G & 7) == 0) {
        const int x = c & 7, rank = c >> 3, W = G >> 3, lo = (x * ntiles) >> 3, hi = ((x + 1) * ntiles) >> 3, v = i * W + rank;
        if (v >= (hi - lo) * nN) return false;
        const int j = v / nN; t = lo + j; pn = v - j * nN; return true;
    }
    const int L = i * G + c; t = L / nN; if (t >= ntiles) return false; pn = L - t * nN; return true;
}
struct GroupedOrder {
    int nN, G, c, ntiles; const PG8_LAS int* tile_e; const PG8_LAS int* ridx; size_t bstride; const PG8_LAS int* cnte; const PG8_LAS int* tbase;
    __device__ __forceinline__ bool next(int i, Unit& u) const {
        int t, pn; if (!moe_unit(i, c, G, nN, cnte, tbase, ntiles, t, pn)) return false;
        u.pm = __builtin_amdgcn_readfirstlane(t); u.pn = __builtin_amdgcn_readfirstlane(pn); u.e = __builtin_amdgcn_readfirstlane(tile_e[t]); return true;
    }
    __device__ __forceinline__ size_t abase(const Unit& u, int h, int K) const { return ridx ? (size_t)0 : (size_t)(u.pm * BM + h * HALF) * K * 2; }
    __device__ __forceinline__ unsigned alane(int ui, const Unit&, int h, int piece, unsigned voff, int K) const {
        if (!ridx) return voff;
        int t_ = (int)threadIdx.x; asm volatile("" : "+v"(t_));
        int R, C; stage_rc(t_ * 16 + piece * 8192, R, C);
        return (unsigned)ridx[ui * BM + h * HALF + R] * (unsigned)K * 2u + (unsigned)C * 2u; }
    __device__ __forceinline__ size_t bbase(const Unit& u, size_t tstep) const { return (size_t)u.e * bstride + (size_t)u.pn * tstep; }
    __device__ __forceinline__ void a_ready(const Unit&) const {}
    __device__ __forceinline__ void done(const Unit&) const {}
};

__device__ __forceinline__ unsigned cvt_pk_bf16(float lo, float hi) { unsigned r; asm volatile("v_cvt_pk_bf16_f32 %0, %1, %2" : "=v"(r) : "v"(lo), "v"(hi)); return r; }

struct EpiProj {
    static constexpr bool PERM = true, AFTER_DRAIN = false;
    bf16_t* O; const float* bias; float* ksum;
    __device__ __forceinline__ void operator()(const f32x4 (&acc)[2][2][4][2], const Unit& u, int wr, int wc, int fr, int fq) const {
        const int row0 = u.pm * BM + wr * 64 + fr, col0 = u.pn * BM + wc * 32 + 8 * fq;
        const float sc = (u.pn < 2 || u.pn == 6 || u.pn == 7) ? QSCALE : 1.0f;
        f32x4 bv[2][2];
#pragma unroll
        for (int bj = 0; bj < 2; ++bj)
#pragma unroll
            for (int n = 0; n < 2; ++n) bv[bj][n] = *(const f32x4*)(bias + col0 + bj * HALF + 4 * n);
#pragma unroll
        for (int ai = 0; ai < 2; ++ai)
#pragma unroll
            for (int m = 0; m < 4; ++m) { bf16_t* rowp = O + (size_t)(row0 + ai * HALF + m * 16) * D_IN + col0;
#pragma unroll
                for (int bj = 0; bj < 2; ++bj) { f32x4 v0 = (acc[ai][bj][m][0] + bv[bj][0]) * sc, v1 = (acc[ai][bj][m][1] + bv[bj][1]) * sc;
                    u32x4 w; w.x = cvt_pk_bf16(v0[0], v0[1]); w.y = cvt_pk_bf16(v0[2], v0[3]); w.z = cvt_pk_bf16(v1[0], v1[1]); w.w = cvt_pk_bf16(v1[2], v1[3]);
                    *(u32x4*)(rowp + bj * HALF) = w; } }
        if (u.pn == 2 || u.pn == 3) {
#pragma unroll
            for (int bj = 0; bj < 2; ++bj)
#pragma unroll
                for (int n = 0; n < 2; ++n) {
                    f32x4 s = bv[bj][n] * 8.0f;
#pragma unroll
                    for (int ai = 0; ai < 2; ++ai)
#pragma unroll
                        for (int m = 0; m < 4; ++m) s += acc[ai][bj][m][n];
#pragma unroll
                    for (int j = 0; j < 4; ++j) { float t = s[j]; t += __shfl_xor(t, 1); t += __shfl_xor(t, 2); t += __shfl_xor(t, 4); t += __shfl_xor(t, 8);
                        if (fr == 0) atomicAdd(ksum + (size_t)u.pm * D_MOBA + (u.pn - 2) * BM + bj * HALF + wc * 32 + 8 * fq + 4 * n + j, t); }
                }
        }
    }
};
struct EpiX1 {
    static constexpr bool PERM = true, AFTER_DRAIN = false;
    const float* x; bf16_t* x1; const float* bias; const float* modf;
    __device__ __forceinline__ void operator()(const f32x4 (&acc)[2][2][4][2], const Unit& u, int wr, int wc, int fr, int fq) const {
        const int row0 = u.pm * BM + wr * 64 + fr, col0 = u.pn * BM + wc * 32 + 8 * fq;
        const float* ga = modf + (size_t)(u.pm >> 3) * 6 * D + 2 * D;
        f32x4 bv[2][2], gv[2][2];
#pragma unroll
        for (int bj = 0; bj < 2; ++bj)
#pragma unroll
            for (int n = 0; n < 2; ++n) { bv[bj][n] = *(const f32x4*)(bias + col0 + bj * HALF + 4 * n); gv[bj][n] = *(const f32x4*)(ga + col0 + bj * HALF + 4 * n); }
#pragma unroll
        for (int ai = 0; ai < 2; ++ai)
#pragma unroll
            for (int m = 0; m < 4; ++m) { const size_t off = (size_t)(row0 + ai * HALF + m * 16) * D + col0;
#pragma unroll
                for (int bj = 0; bj < 2; ++bj) { const f32x4 xr0 = *(const f32x4*)(x + off + bj * HALF), xr1 = *(const f32x4*)(x + off + bj * HALF + 4);
                    const f32x4 v0 = xr0 + gv[bj][0] * (acc[ai][bj][m][0] + bv[bj][0]), v1 = xr1 + gv[bj][1] * (acc[ai][bj][m][1] + bv[bj][1]);
                    u32x4 w; w.x = cvt_pk_bf16(v0[0], v0[1]); w.y = cvt_pk_bf16(v0[2], v0[3]); w.z = cvt_pk_bf16(v1[0], v1[1]); w.w = cvt_pk_bf16(v1[2], v1[3]);
                    *(u32x4*)(x1 + off + bj * HALF) = w; }
                if (m == 3) asm volatile("" ::: "memory"); }
    }
};
struct EpiSwiglu {
    static constexpr bool PERM = true, AFTER_DRAIN = false;
    bf16_t* act; const float* bias;
    __device__ __forceinline__ void operator()(const f32x4 (&acc)[2][2][4][2], const Unit& u, int wr, int wc, int fr, int fq) const {
        const int row0 = u.pm * BM + wr * 64 + fr, ff0 = u.pn * HALF + wc * 32 + 8 * fq;
        const float* bg = bias + (size_t)u.e * 2 * DFF + ff0;
        f32x4 bgv[2], buv[2];
#pragma unroll
        for (int n = 0; n < 2; ++n) { bgv[n] = *(const f32x4*)(bg + 4 * n); buv[n] = *(const f32x4*)(bg + DFF + 4 * n); }
#pragma unroll
        for (int ai = 0; ai < 2; ++ai)
#pragma unroll
            for (int m = 0; m < 4; ++m) {
                f32x4 o[2];
#pragma unroll
                for (int n = 0; n < 2; ++n) { const f32x4 gq = acc[ai][0][m][n] + bgv[n], uq = acc[ai][1][m][n] + buv[n];
#pragma unroll
                    for (int j = 0; j < 4; ++j) { const float g = fminf(gq[j], 7.0f), uu = fminf(fmaxf(uq[j], -7.0f), 7.0f);
                        const float sg = __builtin_amdgcn_rcpf(1.0f + __builtin_amdgcn_exp2f(-1.702f * LOG2E * g)); o[n][j] = (uu + 1.0f) * (g * sg); } }
                u32x4 w; w.x = cvt_pk_bf16(o[0][0], o[0][1]); w.y = cvt_pk_bf16(o[0][2], o[0][3]); w.z = cvt_pk_bf16(o[1][0], o[1][1]); w.w = cvt_pk_bf16(o[1][2], o[1][3]);
                *(u32x4*)(act + (size_t)(row0 + ai * HALF + m * 16) * DFF + ff0) = w; }
    }
};
struct EpiDown {
    static constexpr bool PERM = true, AFTER_DRAIN = false;
    bf16_t* y; const float* bias;
    __device__ __forceinline__ void operator()(const f32x4 (&acc)[2][2][4][2], const Unit& u, int wr, int wc, int fr, int fq) const {
        const int row0 = u.pm * BM + wr * 64 + fr, col0 = u.pn * BM + wc * 32 + 8 * fq;
        const float* bb = bias + (size_t)u.e * D + col0;
        f32x4 bv[2][2];
#pragma unroll
        for (int bj = 0; bj < 2; ++bj)
#pragma unroll
            for (int n = 0; n < 2; ++n) bv[bj][n] = *(const f32x4*)(bb + bj * HALF + 4 * n);
#pragma unroll
        for (int ai = 0; ai < 2; ++ai)
#pragma unroll
            for (int m = 0; m < 4; ++m) { bf16_t* rowp = y + (size_t)(row0 + ai * HALF + m * 16) * D + col0;
#pragma unroll
                for (int bj = 0; bj < 2; ++bj) { const f32x4 v0 = acc[ai][bj][m][0] + bv[bj][0], v1 = acc[ai][bj][m][1] + bv[bj][1];
                    u32x4 w; w.x = cvt_pk_bf16(v0[0], v0[1]); w.y = cvt_pk_bf16(v0[2], v0[3]); w.z = cvt_pk_bf16(v1[0], v1[1]); w.w = cvt_pk_bf16(v1[2], v1[3]);
                    *(u32x4*)(rowp + bj * HALF) = w; } }
    }
};

__device__ __forceinline__ unsigned pk4_f8(float a, float b, float c, float d) { int r = __builtin_amdgcn_cvt_pk_fp8_f32(a, b, 0, false); r = __builtin_amdgcn_cvt_pk_fp8_f32(c, d, r, true); return (unsigned)r; }
typedef unsigned u32x2 __attribute__((ext_vector_type(2)));
struct EpiSwiglu8 {
    static constexpr bool PERM = true, AFTER_DRAIN = false;
    unsigned char* act; const float* bias;
    __device__ __forceinline__ void operator()(const f32x4 (&acc)[2][2][4][2], const Unit& u, int wr, int wc, int fr, int fq) const {
        const int row0 = u.pm * BM + wr * 64 + fr, ff0 = u.pn * HALF + wc * 32 + 8 * fq;
        const float* bg = bias + (size_t)u.e * 2 * DFF + ff0;
        f32x4 bgv[2], buv[2];
#pragma unroll
        for (int n = 0; n < 2; ++n) { bgv[n] = *(const f32x4*)(bg + 4 * n); buv[n] = *(const f32x4*)(bg + DFF + 4 * n); }
#pragma unroll
        for (int ai = 0; ai < 2; ++ai)
#pragma unroll
            for (int m = 0; m < 4; ++m) {
                f32x4 o[2];
#pragma unroll
                for (int n = 0; n < 2; ++n) { const f32x4 gq = acc[ai][0][m][n] * (1.0f / WSCALE) + bgv[n], uq = acc[ai][1][m][n] * (1.0f / WSCALE) + buv[n];
#pragma unroll
                    for (int j = 0; j < 4; ++j) { const float g = fminf(gq[j], 7.0f), uu = fminf(fmaxf(uq[j], -7.0f), 7.0f);
                        const float sg = __builtin_amdgcn_rcpf(1.0f + __builtin_amdgcn_exp2f(-1.702f * LOG2E * g)); o[n][j] = (uu + 1.0f) * (g * sg); } }
                u32x2 w; w.x = pk4_f8(o[0][0], o[0][1], o[0][2], o[0][3]); w.y = pk4_f8(o[1][0], o[1][1], o[1][2], o[1][3]);
                *(u32x2*)(act + (size_t)(row0 + ai * HALF + m * 16) * DFF + ff0) = w;
                asm volatile("" ::: "memory"); }
    }
};
struct EpiDown8 {
    static constexpr bool PERM = true, AFTER_DRAIN = false;
    unsigned char* y; const float* bias;
    __device__ __forceinline__ void operator()(const f32x4 (&acc)[2][2][4][2], const Unit& u, int wr, int wc, int fr, int fq) const {
        const int row0 = u.pm * BM + wr * 64 + fr, col0 = u.pn * BM + wc * 32 + 8 * fq;
        const float* bb = bias + (size_t)u.e * D + col0;
        f32x4 bv[2][2];
#pragma unroll
        for (int bj = 0; bj < 2; ++bj)
#pragma unroll
            for (int n = 0; n < 2; ++n) bv[bj][n] = *(const f32x4*)(bb + bj * HALF + 4 * n) * YSCALE;
#pragma unroll
        for (int ai = 0; ai < 2; ++ai)
#pragma unroll
            for (int m = 0; m < 4; ++m) { unsigned char* rowp = y + (size_t)(row0 + ai * HALF + m * 16) * D + col0;
#pragma unroll
                for (int bj = 0; bj < 2; ++bj) { const f32x4 v0 = acc[ai][bj][m][0] * (YSCALE / WSCALE) + bv[bj][0], v1 = acc[ai][bj][m][1] * (YSCALE / WSCALE) + bv[bj][1];
                    u32x2 w; w.x = pk4_f8(v0[0], v0[1], v0[2], v0[3]); w.y = pk4_f8(v1[0], v1[1], v1[2], v1[3]);
                    *(u32x2*)(rowp + bj * HALF) = w; }
                asm volatile("" ::: "memory"); }
    }
};

__device__ __forceinline__ void glds16_s(const char* sbase, unsigned voff, unsigned lds_dst) { unsigned keep;
    asm volatile("s_mov_b32 %0, m0\n\ts_mov_b32 m0, %3\n\ts_nop 0\n\tglobal_load_lds_dwordx4 %1, %2\n\ts_mov_b32 m0, %0" : "=&s"(keep) : "v"(voff), "s"(sbase), "s"(lds_dst) : "memory"); }
template <class Epi, class Sched, bool ALIGN_EPI = false, bool SP2 = false, bool F8 = false>
__device__ __forceinline__ void gemm_phase(PG8_LAS unsigned char* lds, const Gemm g, const Sched& S, const Epi& E) {
    int tid_ = threadIdx.x; asm volatile("" : "+v"(tid_));
    const int tid = tid_, wid = __builtin_amdgcn_readfirstlane(tid >> 6), lane = tid & 63, wr = wid >> 2, wc = wid & 3, fr = lane & 15, fq = lane >> 4;
    const int K = g.K, nt = K / BK;
    unsigned voffA[2], voffB[2];
#pragma unroll
    for (int i = 0; i < 2; ++i) { int R, C; stage_rc(tid * 16 + i * 8192, R, C); const int Rb = Epi::PERM ? ((R & ~31) + perm32(R & 31)) : R;
        voffA[i] = (unsigned)(R * K + C) * 2u; voffB[i] = (unsigned)(Rb * K + C) * 2u; }
#define PG8_STAGE_A(bufoff, kptr, UI, U, H) do { const char* _gb = (kptr) + S.abase(U, H, K); _Pragma("unroll") for (int _i = 0; _i < 2; ++_i) \
        glds16_s(_gb, S.alane(UI, U, H, _i, voffA[_i], K), ldsbase + (unsigned)((bufoff) + _i * 8192)); } while (0)
    const size_t kstep = (size_t)(BK * 2);
    const size_t hstep = (size_t)HALF * K * 2;
    const size_t tstep = 2 * hstep;
    const unsigned ldsw = (unsigned)wid * 1024u;
    const unsigned ldsbase = (unsigned)__builtin_amdgcn_readfirstlane((int)((unsigned)(size_t)lds + ldsw));
    const int aoff = lds_byte(wr * 64 + fr, fq * 8), boff = lds_byte(wc * 32 + fr, fq * 8);
#define PG8_SA(b, h) (((b) * 2 + (h)) * HTB)
#define PG8_SB(b, h) ((4 + (b) * 2 + (h)) * HTB)
#define PG8_STAGE(bufoff, gbase, voff) do { _Pragma("unroll") for (int _i = 0; _i < 2; ++_i) \
        glds16_s((const char*)(gbase), (voff)[_i], ldsbase + (unsigned)((bufoff) + _i * 8192)); } while (0)
#define PG8_LDA(dst, b, h) do { _Pragma("unroll") for (int m = 0; m < 4; ++m) _Pragma("unroll") for (int k = 0; k < 2; ++k) dst[m][k] = *(const PG8_LAS bf16x8*)(lds + PG8_SA(b, h) + aoff + m * 2048 + k * 1024); } while (0)
#define PG8_LDB(dst, b, h) do { _Pragma("unroll") for (int n = 0; n < 2; ++n) _Pragma("unroll") for (int k = 0; k < 2; ++k) dst[n][k] = *(const PG8_LAS bf16x8*)(lds + PG8_SB(b, h) + boff + n * 2048 + k * 1024); } while (0)
#define PG8_CAT(x) __builtin_shufflevector(__builtin_bit_cast(v4i_t, x[0]), __builtin_bit_cast(v4i_t, x[1]), 0, 1, 2, 3, 4, 5, 6, 7)
#define PG8_MMA(ai, bj, At, Bt) do { __builtin_amdgcn_s_setprio(1); _Pragma("unroll") for (int m = 0; m < 4; ++m) _Pragma("unroll") for (int n = 0; n < 2; ++n) { \
        if constexpr (F8) { acc[ai][bj][m][n] = __builtin_amdgcn_mfma_scale_f32_16x16x128_f8f6f4(PG8_CAT(Bt[n]), PG8_CAT(At[m]), acc[ai][bj][m][n], 0, 0, 0, 0, 0, 0); } \
        else { _Pragma("unroll") for (int k = 0; k < 2; ++k) acc[ai][bj][m][n] = __builtin_amdgcn_mfma_f32_16x16x32_bf16(Bt[n][k], At[m][k], acc[ai][bj][m][n], 0, 0, 0); } } \
        __builtin_amdgcn_s_setprio(0); } while (0)
#define PG8_WAIT_V(n) asm volatile("s_waitcnt vmcnt(" #n ")" ::: "memory")
#define PG8_WAIT_L(n) asm volatile("s_waitcnt lgkmcnt(" #n ")" ::: "memory")
#define PG8_BAR __builtin_amdgcn_s_barrier()
#define PG8_SCHED __builtin_amdgcn_sched_barrier(0)
    Unit cur, nxt; int ui = 0;
    if (!S.next(0, cur)) return;
    f32x4 acc[2][2][4][2];
#pragma unroll
    for (int a = 0; a < 2; ++a)
#pragma unroll
        for (int b = 0; b < 2; ++b)
#pragma unroll
            for (int m = 0; m < 4; ++m)
#pragma unroll
                for (int n = 0; n < 2; ++n) acc[a][b][m][n] = (f32x4){0.f, 0.f, 0.f, 0.f};
    bf16x8 At[4][2], B0[2][2], B1[2][2];
    const char* const A0 = (const char*)g.A; const char* cB = (const char*)g.Bt + S.bbase(cur, tstep);

    S.a_ready(cur);
    if constexpr (SP2) {
        PG8_STAGE(PG8_SB(0, 0), cB, voffB); PG8_STAGE(PG8_SB(0, 1), cB + hstep, voffB); PG8_STAGE_A(PG8_SA(0, 0), A0, 0, cur, 0); PG8_STAGE_A(PG8_SA(0, 1), A0, 0, cur, 1);
        if (wr == 1) PG8_BAR;
        PG8_WAIT_V(2); PG8_BAR;
        PG8_STAGE(PG8_SB(1, 0), cB + kstep, voffB); PG8_STAGE_A(PG8_SA(1, 0), A0 + kstep, 0, cur, 0); PG8_STAGE(PG8_SB(1, 1), cB + hstep + kstep, voffB);
        PG8_WAIT_V(6); PG8_BAR;
    } else {
        PG8_STAGE(PG8_SB(0, 0), cB, voffB); PG8_STAGE_A(PG8_SA(0, 0), A0, 0, cur, 0); PG8_STAGE(PG8_SB(0, 1), cB + hstep, voffB); PG8_STAGE_A(PG8_SA(0, 1), A0, 0, cur, 1);
        if (wr == 1) PG8_BAR;
        PG8_WAIT_V(4); PG8_BAR;
        PG8_STAGE(PG8_SB(1, 0), cB + kstep, voffB); PG8_STAGE_A(PG8_SA(1, 0), A0 + kstep, 0, cur, 0); PG8_STAGE(PG8_SB(1, 1), cB + hstep + kstep, voffB);
        PG8_WAIT_V(6); PG8_BAR;
    }
    for (;;) {
        const bool has_next = S.next(ui + 1, nxt);
        const char* nB = has_next ? (const char*)g.Bt + S.bbase(nxt, tstep) : cB;
        if (!has_next) nxt = cur;
        const int nui = has_next ? ui + 1 : ui;
#pragma unroll 1
        for (int t = 0; t < nt; t += 2) {
            const bool last = (t == nt - 2);
            const char* a1 = A0 + (size_t)(t + 1) * kstep;
            const char* a2 = last ? A0 : A0 + (size_t)(t + 2) * kstep; const char* b2 = last ? nB : cB + (size_t)(t + 2) * kstep;
            const int lui = last ? nui : ui; Unit lu; lu.pm = last ? nxt.pm : cur.pm; lu.pn = last ? nxt.pn : cur.pn; lu.e = last ? nxt.e : cur.e;
            const char* a3 = a2 + kstep; const char* b3 = b2 + kstep;
            if (last && has_next) S.a_ready(nxt);
            if constexpr (SP2) {
            PG8_LDB(B0, 0, 0); PG8_LDB(B1, 0, 1); PG8_SCHED; PG8_LDA(At, 0, 0); PG8_STAGE_A(PG8_SA(1, 1), a1, ui, cur, 1);
            PG8_WAIT_V(8); PG8_WAIT_L(0); PG8_BAR; PG8_MMA(0, 0, At, B0); PG8_MMA(0, 1, At, B1); PG8_BAR; PG8_SCHED;
            PG8_LDA(At, 0, 1); PG8_STAGE(PG8_SB(0, 0), b2, voffB); PG8_STAGE(PG8_SB(0, 1), b2 + hstep, voffB); PG8_STAGE_A(PG8_SA(0, 0), a2, lui, lu, 0);
            PG8_WAIT_V(8); PG8_WAIT_L(0); PG8_BAR; PG8_MMA(1, 0, At, B0); PG8_MMA(1, 1, At, B1); PG8_BAR; PG8_SCHED;
            PG8_LDB(B0, 1, 0); PG8_LDB(B1, 1, 1); PG8_SCHED; PG8_LDA(At, 1, 0); PG8_STAGE_A(PG8_SA(0, 1), a2, lui, lu, 1);
            PG8_WAIT_V(8); PG8_WAIT_L(0); PG8_BAR; PG8_MMA(0, 0, At, B0); PG8_MMA(0, 1, At, B1); PG8_BAR; PG8_SCHED;
            PG8_LDA(At, 1, 1); PG8_STAGE(PG8_SB(1, 0), b3, voffB); PG8_STAGE(PG8_SB(1, 1), b3 + hstep, voffB); PG8_STAGE_A(PG8_SA(1, 0), a3, lui, lu, 0);
            PG8_WAIT_V(8); PG8_WAIT_L(0); PG8_BAR; PG8_MMA(1, 0, At, B0); PG8_MMA(1, 1, At, B1); PG8_BAR; PG8_SCHED;
            } else {
            PG8_LDB(B0, 0, 0); PG8_SCHED; PG8_LDA(At, 0, 0); PG8_STAGE_A(PG8_SA(1, 1), a1, ui, cur, 1);
            PG8_WAIT_L(8); PG8_BAR; PG8_WAIT_L(0); PG8_MMA(0, 0, At, B0); PG8_BAR; PG8_SCHED;
            PG8_LDB(B1, 0, 1); PG8_STAGE(PG8_SB(0, 0), b2, voffB);
            PG8_BAR; PG8_WAIT_L(0); PG8_MMA(0, 1, At, B1); PG8_BAR;
            PG8_LDA(At, 0, 1); PG8_STAGE_A(PG8_SA(0, 0), a2, lui, lu, 0);
            PG8_BAR; PG8_WAIT_L(0); PG8_MMA(1, 0, At, B0); PG8_BAR; PG8_SCHED;
            PG8_STAGE(PG8_SB(0, 1), b2 + hstep, voffB);
            PG8_WAIT_V(6); PG8_BAR; PG8_MMA(1, 1, At, B1); PG8_BAR;
            PG8_LDB(B0, 1, 0); PG8_SCHED; PG8_LDA(At, 1, 0); PG8_STAGE_A(PG8_SA(0, 1), a2, lui, lu, 1);
            PG8_WAIT_L(8); PG8_BAR; PG8_WAIT_L(0); PG8_MMA(0, 0, At, B0); PG8_BAR; PG8_SCHED;
            PG8_LDB(B1, 1, 1); PG8_STAGE(PG8_SB(1, 0), b3, voffB);
            PG8_BAR; PG8_WAIT_L(0); PG8_MMA(0, 1, At, B1); PG8_BAR;
            PG8_LDA(At, 1, 1); PG8_STAGE_A(PG8_SA(1, 0), a3, lui, lu, 0);
            PG8_BAR; PG8_WAIT_L(0); PG8_MMA(1, 0, At, B0); PG8_BAR; PG8_SCHED;
            PG8_STAGE(PG8_SB(1, 1), b3 + hstep, voffB);
            PG8_WAIT_V(6); PG8_BAR; PG8_MMA(1, 1, At, B1); PG8_BAR;
            }
        }
        if constexpr (ALIGN_EPI) { if (wr == 0) PG8_BAR; }
        if constexpr (!Epi::AFTER_DRAIN) { E(acc, cur, wr, wc, fr, fq); S.done(cur); }
        if (!has_next) break;
#pragma unroll
        for (int a = 0; a < 2; ++a)
#pragma unroll
            for (int b = 0; b < 2; ++b)
#pragma unroll
                for (int m = 0; m < 4; ++m)
#pragma unroll
                    for (int n = 0; n < 2; ++n) acc[a][b][m][n] = (f32x4){0.f, 0.f, 0.f, 0.f};
        cur = nxt; cB = nB; ++ui;
        if constexpr (ALIGN_EPI) { if (wr == 1) PG8_BAR; }
    }
    PG8_WAIT_V(0);
    if constexpr (!ALIGN_EPI) { if (wr == 0) PG8_BAR; }
    PG8_BAR;
    if constexpr (Epi::AFTER_DRAIN) { E.fused(acc, cur, wr, wc, fr, fq, lds, wid, lane); S.done(cur); }
#undef PG8_STAGE_A
#undef PG8_SA
#undef PG8_SB
#undef PG8_STAGE
#undef PG8_LDA
#undef PG8_LDB
#undef PG8_MMA
#undef PG8_CAT
#undef PG8_WAIT_V
#undef PG8_WAIT_L
#undef PG8_BAR
#undef PG8_SCHED
}
}

constexpr size_t MiB = 1u << 20;
constexpr size_t WS_CTL = 0, CTL_ZERO_BYTES = 1 * MiB;
constexpr size_t WS_MODP = 1 * MiB;
constexpr size_t WS_MODF = 3 * MiB;
constexpr size_t WS_BIAS = 4 * MiB;
constexpr size_t WS_TOKE = 5 * MiB;
constexpr size_t WS_TOKP = 6 * MiB;
constexpr size_t WS_CNTC = 5 * MiB + 512 * 1024;
constexpr size_t WS_TOKW = 7 * MiB;
constexpr size_t WS_INV = 8 * MiB;
constexpr size_t WS_WIN = 10 * MiB;
constexpr size_t WS_WOUT = 15 * MiB;
constexpr size_t WS_X1 = 32 * MiB;
constexpr size_t WS_XN = 96 * MiB;
constexpr size_t WS_H2 = 128 * MiB;
constexpr size_t WS_PROJ = 160 * MiB;
constexpr size_t WS_O = 232 * MiB;
constexpr size_t WS_WGU = 264 * MiB;
constexpr size_t WS_WD = 392 * MiB;
constexpr size_t WS_ACT = 456 * MiB;
constexpr size_t WS_Y = 600 * MiB;
constexpr size_t WS_END = 744 * MiB;
constexpr int CW_TMO = 0, CW_CODE = 1;
constexpr int CW_CNT = 64;
constexpr int CW_BAR = 4096;
constexpr int CW_KSUM = 16384;
static_assert((CW_KSUM + 64 * 512) * 4 <= (int)CTL_ZERO_BYTES, "CTL region");
constexpr int RING_OFF = 0, RING_BYTES = 131072;
constexpr int LDSCTL_OFF = RING_BYTES, MISC_OFF = LDSCTL_OFF + 320;
constexpr int LDS_TILE_E = LDSCTL_OFF + 512;
constexpr int LDS_NT = LDS_TILE_E + MAXTILES * 4;
constexpr int LDS_TBASE = LDS_NT + 16;
constexpr int LDS_CNTE = LDS_TBASE + 128;
constexpr int LDS_RIDX = LDS_CNTE + 128;
constexpr int LDS_BYTES = 147456;
static_assert(LDS_RIDX % 16 == 0 && LDS_RIDX + 10 * 1024 <= LDS_BYTES, "LDS map");
constexpr int NWAVES = 8;

#define GAS __attribute__((address_space(1)))
#define LAS __attribute__((address_space(3)))
typedef unsigned short bf16;
typedef unsigned v4u __attribute__((ext_vector_type(4)));
typedef float f32x4 __attribute__((ext_vector_type(4)));
typedef short bf16x8 __attribute__((ext_vector_type(8)));
typedef GAS unsigned gu32;
typedef GAS unsigned long long gu64;
#define RLX_AGENT __ATOMIC_RELAXED, __HIP_MEMORY_SCOPE_AGENT
#define LDS_WAIT() asm volatile("s_waitcnt lgkmcnt(0)" ::: "memory")
#define VM_WAIT() asm volatile("s_waitcnt vmcnt(0)" ::: "memory")
__device__ __forceinline__ unsigned long long rt() { return __builtin_amdgcn_s_memrealtime(); }
__device__ __forceinline__ unsigned f2bf(float f) { unsigned u = __builtin_bit_cast(unsigned, f); return (u + 0x7fffu + ((u >> 16) & 1u)) >> 16; }
__device__ __forceinline__ unsigned pk2(float lo, float hi) { return f2bf(lo) | (f2bf(hi) << 16); }

#define XB_TMO      128
#define XB_XCNT(j)  (256  + 64 * (j))
#define XB_XSUB(j)  (1280 + 64 * (j))
#define XB_XGEN(j)  (2304 + 64 * (j))
#define XB_TOP      3328
#define XB_TOPGEN   3392
#define XCD_BAR_WORDS 3456
#define XB_SPIN_CAP (1u << 18)

__device__ __forceinline__ unsigned xb_ld(unsigned* p)              { return __hip_atomic_load(p, __ATOMIC_RELAXED, __HIP_MEMORY_SCOPE_AGENT); }
__device__ __forceinline__ unsigned xb_add(unsigned* p, unsigned v) { return __hip_atomic_fetch_add(p, v, __ATOMIC_RELAXED, __HIP_MEMORY_SCOPE_AGENT); }
__device__ __forceinline__ unsigned xb_xcc_id() { return (unsigned)__builtin_amdgcn_s_getreg((3 << 11) | 20) & 0xFu; }
#define XB_SPIN(cond, bar) do { unsigned _sp = 0; while (cond) { __builtin_amdgcn_s_sleep(1); \
    if ((++_sp & 255u) == 0u) { if (xb_ld(&(bar)[XB_TMO])) break; if (_sp > XB_SPIN_CAP) { atomicAdd(&(bar)[XB_TMO], 1u); break; } } } } while (0)

struct XcdBarrier {
    unsigned* bar; unsigned x;
    volatile LAS unsigned* st;
};

__device__ __forceinline__ XcdBarrier xcd_barrier_post(unsigned* bar, volatile LAS unsigned* st) {
    XcdBarrier b; b.bar = bar; b.x = xb_xcc_id(); b.st = st;
    if (threadIdx.x == 0) (void)xb_add(&bar[XB_XCNT(b.x)], 1u);
    return b;
}
__device__ __forceinline__ void xcd_barrier_complete(unsigned* bar, unsigned x, unsigned& nloc, unsigned& nx) {
    const unsigned G = gridDim.x * gridDim.y * gridDim.z;
    unsigned sum, cnt, mine, sp = 0u;
    for (;;) {
        sum = 0u; cnt = 0u; mine = 0u;
#pragma unroll
        for (unsigned j = 0; j < 16; ++j) { const unsigned c = xb_ld(&bar[XB_XCNT(j)]); sum += c; cnt += (c > 0u) ? 1u : 0u; mine = (j == x) ? c : mine; }
        if (sum == G) break;
        __builtin_amdgcn_s_sleep(1);
        if ((++sp & 255u) == 0u) { if (xb_ld(&bar[XB_TMO])) break; if (sp > XB_SPIN_CAP) { atomicAdd(&bar[XB_TMO], 1u); break; } }
    }
    nloc = mine > 0u ? mine : 1u; nx = cnt > 0u ? cnt : 1u;
}

__device__ __forceinline__ void xcd_barrier(const XcdBarrier& b) {
    asm volatile("s_waitcnt vmcnt(0)" ::: "memory");
    __syncthreads();
    if (threadIdx.x == 0) {
        unsigned* bar = b.bar;
        __builtin_amdgcn_s_waitcnt(0);
        unsigned nloc = b.st[0], nx = b.st[1];
        if (nloc == 0u) { xcd_barrier_complete(bar, b.x, nloc, nx); b.st[0] = nloc; b.st[1] = nx; }
        const unsigned old = xb_add(&bar[XB_XSUB(b.x)], 1u);
        const unsigned gen = old / nloc;
        if (old + 1u == (gen + 1u) * nloc) {
            __builtin_amdgcn_fence(__ATOMIC_RELEASE, "agent");
            asm volatile("s_waitcnt vmcnt(0)" ::: "memory");
            const unsigned og = xb_add(&bar[XB_TOP], 1u);
            const unsigned tg = og / nx;
            if (og + 1u == (tg + 1u) * nx) xb_add(&bar[XB_TOPGEN], 1u);
            else XB_SPIN(xb_ld(&bar[XB_TOPGEN]) == tg, bar);
            __builtin_amdgcn_fence(__ATOMIC_ACQUIRE, "agent");
            xb_add(&bar[XB_XGEN(b.x)], 1u);
            asm volatile("s_waitcnt vmcnt(0)" ::: "memory");
        } else {
            XB_SPIN(xb_ld(&bar[XB_XGEN(b.x)]) == gen, bar);
            __builtin_amdgcn_fence(__ATOMIC_ACQUIRE, "agent");
            asm volatile("s_waitcnt vmcnt(0)" ::: "memory");
        }
    }
    __syncthreads();
}

namespace att {
using bf16x8 = __attribute__((ext_vector_type(8))) short;
using s16x4 = __attribute__((ext_vector_type(4))) short;
using f32x16 = __attribute__((ext_vector_type(16))) float;
using u32x4 = __attribute__((ext_vector_type(4))) unsigned;
typedef unsigned short bf16;
constexpr int PITCH = D_IN, OPITCH = D;
constexpr int NSLOT = 4, SLOTB = 8192;
constexpr int TAB_PAD = 96;
constexpr int LDS_K = 0, LDS_V = NSLOT * SLOTB, LDS_WS = 2 * NSLOT * SLOTB, LDS_OST = LDS_WS + 8 * 64 * 4, LDS_TAB = LDS_OST + 8 * 4096, LDS_KMS = LDS_TAB + (TAB_PAD + SEQ) * 4, LDS_NINF = LDS_KMS + 8 * 64 * 4, LDS_END = LDS_NINF + 64 * 4;
static_assert(LDS_END <= 131072, "attention LDS");
__device__ __forceinline__ int crow(int r, int hi) { return (r & 3) + 8 * (r >> 2) + 4 * hi; }
__device__ __forceinline__ void glds16(const void* gsrc, unsigned lds_dst) { unsigned keep;
  asm volatile("s_mov_b32 %0, m0\n\ts_mov_b32 m0, %2\n\ts_nop 0\n\tglobal_load_lds_dwordx4 %1, off\n\ts_mov_b32 m0, %0" : "=&s"(keep) : "v"(gsrc), "s"(lds_dst) : "memory"); }
typedef float f32x2_t __attribute__((ext_vector_type(2))); typedef __bf16 bf16x2_t __attribute__((ext_vector_type(2)));
__device__ __forceinline__ unsigned cvtpk_s(float lo, float hi) { f32x2_t v = {lo, hi}; bf16x2_t b = __builtin_convertvector(v, bf16x2_t); return __builtin_bit_cast(unsigned, b); }
#define ATT_WAIT_BAR(N) asm volatile("s_waitcnt vmcnt(" #N ") lgkmcnt(0)\n\ts_barrier" ::: "memory")
#define ATT_LBAR() asm volatile("s_waitcnt lgkmcnt(0)\n\ts_barrier" ::: "memory")
typedef float f32x2v __attribute__((ext_vector_type(2)));
__device__ __forceinline__ void bias_loads(f32x2v (&bb)[16], unsigned tba) {
#pragma unroll
  for (int i = 0; i < 16; ++i) { asm volatile("ds_read2_b32 %0, %1 offset0:%c2 offset1:%c3" : "=v"(bb[i]) : "v"(tba), "i"((i >> 3) * 32 + ((2 * i) & 3) + 8 * (((2 * i) & 15) >> 2)), "i"((i >> 3) * 32 + ((2 * i) & 3) + 8 * (((2 * i) & 15) >> 2) + 1) : "memory"); }
}
__device__ __forceinline__ void k_loads(bf16x8 (&kf)[8], unsigned ka) {
#pragma unroll
  for (int i = 0; i < 8; ++i) asm volatile("ds_read_b128 %0, %1 offset:%c2" : "=v"(kf[i]) : "v"(ka), "i"((i >> 1) * 2048 + (i & 1) * 512) : "memory");
}
#define ATT_C16(bb, o) (f32x16){bb[o][0], bb[o][1], bb[o + 1][0], bb[o + 1][1], bb[o + 2][0], bb[o + 2][1], bb[o + 3][0], bb[o + 3][1], bb[o + 4][0], bb[o + 4][1], bb[o + 5][0], bb[o + 5][1], bb[o + 6][0], bb[o + 6][1], bb[o + 7][0], bb[o + 7][1]}
__device__ __forceinline__ void qk_mma(f32x16& p0, f32x16& p1, const bf16x8 (&kf)[8], const bf16x8* qr, const f32x2v (&bb)[16]) {
  p0 = __builtin_amdgcn_mfma_f32_32x32x16_bf16(kf[0], qr[0], ATT_C16(bb, 0), 0, 0, 0); p1 = __builtin_amdgcn_mfma_f32_32x32x16_bf16(kf[1], qr[0], ATT_C16(bb, 8), 0, 0, 0);
#pragma unroll
  for (int d0 = 1; d0 < 4; ++d0) { p0 = __builtin_amdgcn_mfma_f32_32x32x16_bf16(kf[2 * d0], qr[d0], p0, 0, 0, 0); p1 = __builtin_amdgcn_mfma_f32_32x32x16_bf16(kf[2 * d0 + 1], qr[d0], p1, 0, 0, 0); }
}
__device__ __forceinline__ void v_loads(s16x4 (&lo)[2][4], s16x4 (&hi)[2][4], int vb) {
#pragma unroll
  for (int d0 = 0; d0 < 2; ++d0)
#pragma unroll
    for (int ks = 0; ks < 4; ++ks) {
      asm volatile("ds_read_b64_tr_b16 %0,%1 offset:%c2" : "=&v"(lo[d0][ks]) : "v"(vb), "i"(d0 * 4096 + ks * 1024) : "memory");
      asm volatile("ds_read_b64_tr_b16 %0,%1 offset:%c2" : "=&v"(hi[d0][ks]) : "v"(vb), "i"(d0 * 4096 + ks * 1024 + 512) : "memory"); }
}
__device__ __forceinline__ void pv_mma(f32x16* o, const s16x4 (&lo)[2][4], const s16x4 (&hi)[2][4], bf16x8 pa0, bf16x8 pa1, bf16x8 pa2, bf16x8 pa3) {
#define ATT_PK(d, k) (bf16x8){lo[d][k][0], lo[d][k][1], lo[d][k][2], lo[d][k][3], hi[d][k][0], hi[d][k][1], hi[d][k][2], hi[d][k][3]}
#pragma unroll
  for (int d0 = 0; d0 < 2; ++d0) {
    o[d0] = __builtin_amdgcn_mfma_f32_32x32x16_bf16(pa0, ATT_PK(d0, 0), o[d0], 0, 0, 0);
    o[d0] = __builtin_amdgcn_mfma_f32_32x32x16_bf16(pa1, ATT_PK(d0, 1), o[d0], 0, 0, 0);
    o[d0] = __builtin_amdgcn_mfma_f32_32x32x16_bf16(pa2, ATT_PK(d0, 2), o[d0], 0, 0, 0);
    o[d0] = __builtin_amdgcn_mfma_f32_32x32x16_bf16(pa3, ATT_PK(d0, 3), o[d0], 0, 0, 0);
  }
#undef ATT_PK
}
#define ATT_LWAIT(N) do { asm volatile("s_waitcnt lgkmcnt(" #N ")" ::: "memory"); __builtin_amdgcn_sched_barrier(0); } while (0)
struct UnitDesc { int b, qb, moba, qcol, kcol, vcol, ocol, head, fill, fillk, gqa, q0; float sink2; };

__device__ __forceinline__ void attn_unit(const UnitDesc& u, const bf16* P, bf16* O, const float* biasT, const float* ksum, const float* sinks, char* shm) {
  int tid_ = threadIdx.x; asm volatile("" : "+v"(tid_));
  const int tid = tid_, lane = tid & 63, r32 = lane & 31, hi = lane >> 5; const int wid = __builtin_amdgcn_readfirstlane(tid >> 6);
  const long rowbase = (long)u.b * SEQ; const int q0 = u.q0;
  const int wg = u.gqa ? (wid & 3) : 0, wrow = u.gqa ? (wid >> 2) * 32 : wid * 32;
  constexpr int TSW = TAB_PAD + 192;
  const unsigned lds0 = (unsigned)(uintptr_t)shm;
  float* wsf = (float*)(shm + LDS_WS) + wid * 64;
  float* tab = (float*)(shm + LDS_TAB); float* kms = (float*)(shm + LDS_KMS);
  const int tlo = u.moba ? 0 : (q0 < 128 ? 0 : (q0 >> 6) - 2), thi = u.gqa ? (q0 >> 6) : u.qb * 4 + 3;
  const bf16* ksrc = P + (rowbase + lane) * PITCH + u.kcol + wid * 8;
  const bf16* vsrc = P + (rowbase + 16 * (wid & 3) + (lane >> 2)) * PITCH + u.vcol + (wid >> 2) * 32 + (lane & 3) * 8;
  const unsigned kdst = lds0 + LDS_K + wid * 1024, vdst = lds0 + LDS_V + wid * 1024;
#define ATT_DMA(t, slot) do { glds16(ksrc + (long)(t) * 64 * PITCH, (unsigned)__builtin_amdgcn_readfirstlane(kdst + (slot))); glds16(vsrc + (long)(t) * 64 * PITCH, (unsigned)__builtin_amdgcn_readfirstlane(vdst + (slot))); } while (0)
  const unsigned ka0 = lds0 + LDS_K + hi * 1024 + r32 * 16;
  const int vb0 = (int)(lds0 + LDS_V) + ((lane >> 4) & 1) * 32 + (lane & 3) * 8 + (4 * hi + ((lane & 15) >> 2)) * 64;
  ATT_DMA(tlo, 0); ATT_DMA(tlo + 1, SLOTB);
  if (u.fill) {
    if (u.gqa) { for (int i = tid; i < 4 * TSW; i += 512) { const int hh = i / TSW, j = i - hh * TSW; tab[i] = (j >= 192) ? 0.f : biasT[(u.head + hh) * SEQ + 191 - j]; } }
    else for (int i = tid; i < TAB_PAD + SEQ; i += 512) tab[i] = (i >= SEQ) ? 0.f : biasT[u.head * SEQ + SEQ - 1 - i];
    if (tid < 64) ((float*)(shm + LDS_NINF))[tid] = -INFINITY;
  }
  if (u.fillk) kms[tid] = ksum[(size_t)(u.b * 8 + (tid >> 6)) * D_MOBA + u.head * HD + (tid & 63)];
  const bf16* Qw = P + (rowbase + q0 + wrow) * PITCH + u.qcol + wg * HD;
  bf16x8 qr[4];
#pragma unroll
  for (int d0 = 0; d0 < 4; ++d0) qr[d0] = *reinterpret_cast<const bf16x8*>(&Qw[(long)r32 * PITCH + d0 * 16 + hi * 8]);
  if (u.fill || u.fillk) ATT_LBAR();
  unsigned selmask = 0u;
  if (u.moba) {
    if (u.qb <= MB_TOPK) selmask = (1u << u.qb) - 1u;
    else {
      float gate[MB_NB - 1];
#pragma unroll
      for (int n = 0; n < MB_NB - 1; ++n) { float s = 0.f;
        if (n < u.qb) {
#pragma unroll
          for (int d0 = 0; d0 < 4; ++d0)
#pragma unroll
            for (int j = 0; j < 8; ++j) s += __uint_as_float((unsigned)(unsigned short)qr[d0][j] << 16) * kms[n * 64 + d0 * 16 + hi * 8 + j];
          s += __shfl_xor(s, 32); }
        gate[n] = s; }
#pragma unroll
      for (int r = 0; r < MB_TOPK; ++r) { int best = -1; float bv = 0.f;
#pragma unroll
        for (int n = 0; n < MB_NB - 1; ++n) if (n < u.qb && !((selmask >> n) & 1u) && (best < 0 || gate[n] > bv)) { best = n; bv = gate[n]; }
        selmask |= 1u << best; }
    }
  }
  const int qrel = wrow + r32, qpos = q0 + qrel;
  const unsigned tabqa = lds0 + LDS_TAB + (unsigned)((wg * TSW + (u.gqa ? 191 : SEQ - 1) - qpos + 4 * hi) * 4), ninfa = lds0 + LDS_NINF;
  float m = -1e30f, l = 0.f; f32x16 o[2]; o[0] = f32x16{}; o[1] = f32x16{};
  const int wq0 = q0 + wrow;
#define ATT_FLAGS(tt, need_, emask_, lsel_) do { lsel_ = true; \
    if (u.moba) { const int n_ = (tt) >> 2; \
      if (n_ < u.qb) { lsel_ = ((selmask >> n_) & 1u) != 0u; need_ = __any(lsel_); emask_ = false; } \
      else { need_ = (64 * (tt) <= wq0 + 31); emask_ = (64 * (tt) + 63 > wq0); } } \
    else { need_ = (64 * (tt) <= wq0 + 31) && (64 * (tt) + 63 >= wq0 - (SWA_W - 1)); emask_ = (64 * (tt) + 63 > wq0) || (wq0 + 31 - 64 * (tt) >= SWA_W); } } while (0)
#define ATT_QK_LOADS(tt, kslot, lsel_) do { bias_loads(bb, (lsel_) ? tabqa + 256u * (unsigned)(tt) : ninfa); k_loads(kf, ka0 + (kslot)); } while (0)
  const int lim = u.moba ? 0x7fffffff : SWA_W;
  int slotp = 3 * SLOTB, slot = 0, slotn = SLOTB, slotf = 2 * SLOTB;
  f32x16 pc0 = {}, pc1 = {}, pn0 = {}, pn1 = {};
  u32x4 pw0 = {}, pw1 = {}, pw2 = {}, pw3 = {};
  bool needC, emaskC, lselC, needN = false, emaskN = false, lselN = true, needP = false;
  asm volatile("" :: "v"(qr[0]), "v"(qr[1]), "v"(qr[2]), "v"(qr[3]));
  ATT_WAIT_BAR(2);
  ATT_FLAGS(tlo, needC, emaskC, lselC);
  if (needC) { f32x2v bb[16]; bf16x8 kf[8]; ATT_QK_LOADS(tlo, slot, lselC); ATT_LWAIT(0); qk_mma(pc0, pc1, kf, qr, bb); }
  for (int t = tlo; t <= thi; ++t) {
    ATT_WAIT_BAR(0);
    if (t + 2 <= thi) ATT_DMA(t + 2, slotf);
    if (t + 1 <= thi) { ATT_FLAGS(t + 1, needN, emaskN, lselN); } else needN = false;
    if (needN) { f32x2v bb[16]; bf16x8 kf[8]; ATT_QK_LOADS(t + 1, slotn, lselN); ATT_LWAIT(0); qk_mma(pn0, pn1, kf, qr, bb); }
    if (needP) { s16x4 vlo[2][4], vhi[2][4]; v_loads(vlo, vhi, vb0 + slotp); ATT_LWAIT(0); pv_mma(o, vlo, vhi, __builtin_bit_cast(bf16x8, pw0), __builtin_bit_cast(bf16x8, pw1), __builtin_bit_cast(bf16x8, pw2), __builtin_bit_cast(bf16x8, pw3)); }
    __builtin_amdgcn_sched_barrier(0);
    if (needC) {
      f32x16 p0 = pc0, p1 = pc1;
      if (emaskC) { const int dq = qpos - 64 * t - 4 * hi;
#pragma unroll
        for (int r = 0; r < 16; ++r) { const int c = (r & 3) + 8 * (r >> 2);
          p0[r] = ((unsigned)(dq - c) < (unsigned)lim) ? p0[r] : -INFINITY; p1[r] = ((unsigned)(dq - c - 32) < (unsigned)lim) ? p1[r] : -INFINITY; } }
      float rm = fmaxf(p0[0], p1[0]);
#pragma unroll
      for (int r = 1; r < 16; ++r) rm = fmaxf(fmaxf(rm, p0[r]), p1[r]);
      rm = fmaxf(rm, __shfl_xor(rm, 32));
      if (__any(rm > m + 8.0f)) {
        const float mnew = fmaxf(m, rm), alpha = __builtin_amdgcn_exp2f(m - mnew);
        l *= alpha; m = mnew;
        if (hi == 0) wsf[r32] = alpha;
        asm volatile("s_waitcnt lgkmcnt(0)" ::: "memory");
#pragma unroll
        for (int r = 0; r < 16; ++r) { const float f = wsf[crow(r, hi)]; o[0][r] *= f; o[1][r] *= f; }
      }
      float ls = 0.f;
#pragma unroll
      for (int r = 0; r < 16; ++r) { p0[r] = __builtin_amdgcn_exp2f(p0[r] - m); p1[r] = __builtin_amdgcn_exp2f(p1[r] - m); ls += p0[r] + p1[r]; }
      l += ls;
#define ATT_PKW(Pv, B) cvtpk_s(Pv[B], Pv[B + 1])
      pw0 = (u32x4){ATT_PKW(p0, 0), ATT_PKW(p0, 2), ATT_PKW(p0, 4), ATT_PKW(p0, 6)}; pw1 = (u32x4){ATT_PKW(p0, 8), ATT_PKW(p0, 10), ATT_PKW(p0, 12), ATT_PKW(p0, 14)};
      pw2 = (u32x4){ATT_PKW(p1, 0), ATT_PKW(p1, 2), ATT_PKW(p1, 4), ATT_PKW(p1, 6)}; pw3 = (u32x4){ATT_PKW(p1, 8), ATT_PKW(p1, 10), ATT_PKW(p1, 12), ATT_PKW(p1, 14)};
#undef ATT_PKW
    }
    needP = needC; pc0 = pn0; pc1 = pn1; needC = needN; emaskC = emaskN; lselC = lselN;
    { const int s_ = slotp; slotp = slot; slot = slotn; slotn = slotf; slotf = s_; }
  }
  if (needP) { s16x4 vlo[2][4], vhi[2][4]; v_loads(vlo, vhi, vb0 + slotp); ATT_LWAIT(0); pv_mma(o, vlo, vhi, __builtin_bit_cast(bf16x8, pw0), __builtin_bit_cast(bf16x8, pw1), __builtin_bit_cast(bf16x8, pw2), __builtin_bit_cast(bf16x8, pw3)); }
#undef ATT_FLAGS
#undef ATT_QK_LOADS
  l += __shfl_xor(l, 32);
  if (!u.moba) l += __builtin_amdgcn_exp2f((u.gqa ? sinks[u.head - NH_M + wg] * LOG2E : u.sink2) - m);
  if (hi == 0) wsf[32 + r32] = l;
  asm volatile("s_waitcnt lgkmcnt(0)" ::: "memory");
  float rli[16];
#pragma unroll
  for (int r = 0; r < 16; ++r) rli[r] = __builtin_amdgcn_rcpf(wsf[32 + crow(r, hi)]);
  bf16* Ow = O + (rowbase + q0 + wrow) * OPITCH + u.ocol + wg * HD;
  { bf16* stg = (bf16*)(shm + LDS_OST) + wid * 2048;
#pragma unroll
    for (int r = 0; r < 16; ++r) { const int orow = crow(r, hi);
#pragma unroll
      for (int d0 = 0; d0 < 2; ++d0) stg[orow * 64 + d0 * 32 + r32] = (bf16)(cvtpk_s(o[d0][r] * rli[r], 0.f) & 0xffffu); }
    asm volatile("s_waitcnt lgkmcnt(0)" ::: "memory");
#pragma unroll
    for (int i = 0; i < 4; ++i) { const int row = i * 8 + (lane >> 3), ch = lane & 7; const u32x4 v = *(const u32x4*)(stg + row * 64 + ch * 8); *(u32x4*)(Ow + (long)row * OPITCH + ch * 8) = v; } }
  ATT_LBAR();
#undef ATT_DMA
}
}

struct Frame {
    LAS unsigned char* lds;
    volatile LAS unsigned* MISC;
    gu32* ctl;
    int tid, lane, wave, vcu, G;
};
__device__ __forceinline__ float wave_sum(float v) {
#pragma unroll
    for (int o = 1; o < 64; o <<= 1) v += __shfl_xor(v, o);
    return v;
}
__device__ __forceinline__ int rel_bucket(int dist) {
    const int n = dist > 0 ? dist : 0;
    if (n < 16) return n;
    const int th[15] = {21, 27, 35, 46, 59, 77, 99, 128, 166, 216, 280, 363, 470, 609, 790};
    int bk = 16;
#pragma unroll
    for (int i = 0; i < 15; ++i) bk += (n >= th[i]) ? 1 : 0;
    return bk;
}
__device__ __forceinline__ void p0_transpose_item(const float* W, int K, int N, bf16* WT, int k0, int n0, int dst_row0, LAS float* scr, int lane) {
    { float v[32]; const float* wp = W + (size_t)(k0 + (lane >> 5)) * N + n0 + (lane & 31);
#pragma unroll
        for (int i = 0; i < 32; ++i) v[i] = __builtin_nontemporal_load(wp + (size_t)(2 * i) * N);
#pragma unroll
        for (int i = 0; i < 32; ++i) scr[(2 * i + (lane >> 5)) * 33 + (lane & 31)] = v[i]; }
    LDS_WAIT(); asm volatile("" ::: "memory");
    const int c = lane & 7;
#pragma unroll
    for (int j = 0; j < 4; ++j) { const int n = (lane >> 3) + 8 * j; const LAS float* s = scr + (8 * c) * 33 + n;
        v4u o; o.x = pk2(s[0 * 33], s[1 * 33]); o.y = pk2(s[2 * 33], s[3 * 33]); o.z = pk2(s[4 * 33], s[5 * 33]); o.w = pk2(s[6 * 33], s[7 * 33]);
        *(GAS v4u*)(WT + (size_t)(dst_row0 + n) * K + k0 + 8 * c) = o; }
    LDS_WAIT(); asm volatile("" ::: "memory");
}
__device__ __forceinline__ void p0_transpose_item_f8(const float* W, int K, int N, unsigned char* WT, int k0, int n0, int dst_row0, LAS float* scr, int lane) {
    v4u o[2][2];
    const int c = lane & 3;
#pragma unroll
    for (int hf = 0; hf < 2; ++hf) {
        { float v[32]; const float* wp = W + (size_t)(k0 + 64 * hf + (lane >> 5)) * N + n0 + (lane & 31);
#pragma unroll
            for (int i = 0; i < 32; ++i) v[i] = __builtin_nontemporal_load(wp + (size_t)(2 * i) * N);
#pragma unroll
            for (int i = 0; i < 32; ++i) scr[(2 * i + (lane >> 5)) * 33 + (lane & 31)] = v[i]; }
        LDS_WAIT(); asm volatile("" ::: "memory");
#pragma unroll
        for (int j = 0; j < 2; ++j) { const int n = (lane >> 2) + 16 * j; const LAS float* s = scr + (16 * c) * 33 + n;
            o[hf][j].x = pg8::pk4_f8(s[0 * 33] * WSCALE, s[1 * 33] * WSCALE, s[2 * 33] * WSCALE, s[3 * 33] * WSCALE); o[hf][j].y = pg8::pk4_f8(s[4 * 33] * WSCALE, s[5 * 33] * WSCALE, s[6 * 33] * WSCALE, s[7 * 33] * WSCALE);
            o[hf][j].z = pg8::pk4_f8(s[8 * 33] * WSCALE, s[9 * 33] * WSCALE, s[10 * 33] * WSCALE, s[11 * 33] * WSCALE); o[hf][j].w = pg8::pk4_f8(s[12 * 33] * WSCALE, s[13 * 33] * WSCALE, s[14 * 33] * WSCALE, s[15 * 33] * WSCALE); }
        LDS_WAIT(); asm volatile("" ::: "memory");
    }
#pragma unroll
    for (int j = 0; j < 2; ++j) { const int n = (lane >> 2) + 16 * j; unsigned char* rp = WT + (size_t)(dst_row0 + n) * K + k0 + 16 * c;
        *(GAS v4u*)(rp) = o[0][j]; *(GAS v4u*)(rp + 64) = o[1][j]; }
}
__device__ __forceinline__ void conv_load_half(f32x4 (&x)[16], const float* src, int N, int hf, int lane) {
    const int q = lane >> 4, m = lane & 15; const float* sp = src + (size_t)(hf * 64 + 4 * q) * N + 4 * m;
#pragma unroll
    for (int g = 0; g < 4; ++g)
#pragma unroll
        for (int i = 0; i < 4; ++i) x[g * 4 + i] = __builtin_nontemporal_load((const f32x4*)(sp + (size_t)(16 * g + i) * N));
}
__device__ __forceinline__ void conv_cvt_half(const f32x4 (&x)[16], LAS unsigned* t8, int hf, int lane) {
    const int q = lane >> 4, m = lane & 15;
#pragma unroll
    for (int g = 0; g < 4; ++g)
#pragma unroll
        for (int j = 0; j < 4; ++j) t8[(4 * m + j) * 33 + hf * 16 + 4 * g + q] = pg8::pk4_f8(x[g * 4 + 0][j] * WSCALE, x[g * 4 + 1][j] * WSCALE, x[g * 4 + 2][j] * WSCALE, x[g * 4 + 3][j] * WSCALE);
}
__device__ __forceinline__ void conv_store(unsigned char* dst, const LAS unsigned* t8, int lane) {
#pragma unroll
    for (int jj = 0; jj < 8; ++jj) { const int n = (lane >> 3) + 8 * jj, c = lane & 7; const LAS unsigned* rp = t8 + n * 33 + 4 * c;
        *(GAS v4u*)(dst + (size_t)n * 1024 + 16 * c) = (v4u){rp[0], rp[1], rp[2], rp[3]}; }
}
struct Args { const float* in[19]; float* out; unsigned char* ws; int ph_lo, ph_hi; };

__device__ __forceinline__ void p0_prologue(Frame& F, const Args& a) {
    LAS float* scr = (LAS float*)(F.lds + RING_OFF + F.wave * 16384);
    const int gw = F.vcu * NWAVES + F.wave, NGW = F.G * NWAVES;
    const float* w_in = a.in[5]; const float* w_out = a.in[7];
    bf16* Win_t = (bf16*)(a.ws + WS_WIN); bf16* Wout_t = (bf16*)(a.ws + WS_WOUT);
    constexpr int I_IN = 16 * (D_IN / 32), I_OUT = 16 * (D / 32), I_MOD = 96 * 8, I_BIAS = 16 * SEQ / 64;
    constexpr int NITEMS = I_IN + I_OUT + I_MOD + I_BIAS;
    for (int k = 0; k * NGW < NITEMS; ++k) {
        const int it = k * NGW + ((k & 1) ? NGW - 1 - gw : gw); if (it >= NITEMS) continue;
        int r = it;
        if (r < I_MOD) {
            const int cc = r % 96, ks = r / 96, j = cc * 64 + F.lane;
            const float* c = a.in[1]; const float* w_ada = a.in[3];
            { const int b = F.lane >> 3, kq = (F.lane & 7) * 16;
#pragma unroll
                for (int i = 0; i < 16; ++i) { const float cv = c[b * D + ks * 128 + kq + i]; scr[b * 128 + kq + i] = cv / (1.f + expf(-cv)); } }
            LDS_WAIT(); asm volatile("" ::: "memory");
            float acc[BATCH];
#pragma unroll
            for (int b = 0; b < BATCH; ++b) acc[b] = 0.f;
            const float* wp = w_ada + (size_t)(ks * 128) * (6 * D) + j;
#pragma unroll 1
            for (int k0 = 0; k0 < 128; k0 += 128) { float w[128];
#pragma unroll
                for (int i = 0; i < 128; ++i) w[i] = wp[(size_t)(k0 + i) * (6 * D)];
#pragma unroll
                for (int i = 0; i < 128; ++i)
#pragma unroll
                    for (int b = 0; b < BATCH; ++b) acc[b] += scr[b * 128 + k0 + i] * w[i]; }
            LDS_WAIT(); asm volatile("" ::: "memory");
            float* mp = (float*)(a.ws + WS_MODP) + (size_t)ks * BATCH * 6 * D;
#pragma unroll
            for (int b = 0; b < BATCH; ++b) mp[(size_t)b * 6 * D + j] = acc[b];
            continue;
        }
        r -= I_MOD;
        if (r < I_BIAS) { const int i = r * 64 + F.lane, h = i / SEQ, d = i % SEQ; ((float*)(a.ws + WS_BIAS))[i] = a.in[9][rel_bucket(d) * 16 + h] * LOG2E; continue; }
        r -= I_BIAS;
        if (r < I_IN) { const int nb = r % (D_IN / 32), kb = r / (D_IN / 32); p0_transpose_item(w_in, D, D_IN, Win_t, kb * 64, nb * 32, nb * 32, scr, F.lane); continue; }
        r -= I_IN;
        { const int nb = r % (D / 32), kb = r / (D / 32); p0_transpose_item(w_out, D, D, Wout_t, kb * 64, nb * 32, nb * 32, scr, F.lane); }
    }
}
constexpr int CV_GU = NE * 8 * (2 * DFF / 64), CV_DN = NE * 8 * (D / 64), CV_ITEMS = CV_GU + CV_DN;
struct ConvItem { const float* src; unsigned char* dst; int N; };
__device__ __forceinline__ ConvItem conv_addr(const Args& a, int r) {
    const float* w_gu = a.in[14]; const float* w_down = a.in[16]; unsigned char* Wgu_t = a.ws + WS_WGU; unsigned char* Wd_t = a.ws + WS_WD; ConvItem c;
    if (r < CV_GU) { const int per = 8 * (2 * DFF / 64), e = r / per, q = r % per, nb = q % (2 * DFF / 64), kb = q / (2 * DFF / 64), n0 = nb * 64;
        const int drow = (n0 < DFF) ? ((n0 >> 7) * 256 + (n0 & 127)) : (((n0 - DFF) >> 7) * 256 + 128 + ((n0 - DFF) & 127));
        c.src = w_gu + (size_t)e * D * 2 * DFF + (size_t)(kb * 128) * (2 * DFF) + n0; c.N = 2 * DFF; c.dst = Wgu_t + (size_t)e * 2 * DFF * D + (size_t)drow * D + kb * 128; }
    else { const int rr = r - CV_GU, per = 8 * (D / 64), e = rr / per, q = rr % per, nb = q % (D / 64), kb = q / (D / 64), n0 = nb * 64;
        c.src = w_down + (size_t)e * DFF * D + (size_t)(kb * 128) * D + n0; c.N = D; c.dst = Wd_t + (size_t)e * D * DFF + (size_t)n0 * DFF + kb * 128; }
    return c;
}
__device__ __forceinline__ void conv_range(Frame& F, const Args& a, int lo, int hi, int first, int stride) {
    LAS unsigned* scr = (LAS unsigned*)(F.lds + RING_OFF + F.wave * 16384);
    int r = lo + first; if (r >= hi) return;
    ConvItem cur = conv_addr(a, r);
    f32x4 xa[16], xb[16];
    conv_load_half(xa, cur.src, cur.N, 0, F.lane); conv_load_half(xb, cur.src, cur.N, 1, F.lane);
#pragma unroll 1
    for (;;) {
        const int rn = r + stride; const bool more = rn < hi;
        const ConvItem nxt = conv_addr(a, more ? rn : r);
        conv_cvt_half(xa, scr, 0, F.lane); conv_load_half(xa, nxt.src, nxt.N, 0, F.lane);
        conv_cvt_half(xb, scr, 1, F.lane); conv_load_half(xb, nxt.src, nxt.N, 1, F.lane);
        LDS_WAIT(); asm volatile("" ::: "memory");
        conv_store(cur.dst, scr, F.lane);
        LDS_WAIT(); asm volatile("" ::: "memory");
        if (!more) break;
        cur = nxt; r = rn;
    }
}
__device__ __forceinline__ void p1_xn(Frame& F, const Args& a) {
    const float* modp = (const float*)(a.ws + WS_MODP); const float* b_ada = a.in[4]; float* modf = (float*)(a.ws + WS_MODF);
    for (int i = blockIdx.x * 512 + F.tid; i < BATCH * 6 * D; i += F.G * 512) { float s = b_ada[i % (6 * D)];
#pragma unroll
        for (int ks = 0; ks < 8; ++ks) s += modp[(size_t)ks * BATCH * 6 * D + i];
        modf[i] = s; }
    LAS float* tab = (LAS float*)(F.lds + RING_OFF);
    const float* x = a.in[0]; const float* g = a.in[2]; bf16* XN = (bf16*)(a.ws + WS_XN);
    for (int chunk = blockIdx.x; chunk < NTOK / 64; chunk += F.G) {
        const int b = chunk / (SEQ / 64);
        f32x4 v[8][4];
#pragma unroll
        for (int q = 0; q < 8; ++q) { const GAS f32x4* xr = (const GAS f32x4*)(x + (size_t)(chunk * 64 + F.wave + q * NWAVES) * D) + F.lane;
#pragma unroll
            for (int j = 0; j < 4; ++j) v[q][j] = xr[64 * j]; }
        __syncthreads();
        for (int i = F.tid; i < 2 * D; i += 512) { const int col = i & (D - 1), chunkid = (i < D) ? 1 : 0; float s = b_ada[chunkid * D + col];
#pragma unroll
            for (int ks = 0; ks < 8; ++ks) s += modp[(size_t)ks * BATCH * 6 * D + (size_t)b * 6 * D + chunkid * D + col];
            tab[i] = (i < D) ? g[col] * (1.f + s) : s; }
        __syncthreads();
#pragma unroll
        for (int q = 0; q < 8; ++q) { float s = 0.f;
#pragma unroll
            for (int j = 0; j < 4; ++j) s += (v[q][j].x * v[q][j].x + v[q][j].y * v[q][j].y) + (v[q][j].z * v[q][j].z + v[q][j].w * v[q][j].w);
            const float rstd = 1.f / sqrtf(wave_sum(s) * (1.f / D) + EPS);
            GAS unsigned long long* o8 = (GAS unsigned long long*)(XN + (size_t)(chunk * 64 + F.wave + q * NWAVES) * D) + F.lane;
#pragma unroll
            for (int j = 0; j < 4; ++j) { const int col = 4 * F.lane + 256 * j; const f32x4 gs = *(const LAS f32x4*)(tab + col), sh = *(const LAS f32x4*)(tab + D + col);
                const f32x4 h = v[q][j] * rstd * gs + sh;
                o8[64 * j] = (unsigned long long)pk2(h.x, h.y) | ((unsigned long long)pk2(h.z, h.w) << 32); } }
    }
}

__device__ __forceinline__ void p5_router(Frame& F, const Args& a) {
    typedef __attribute__((ext_vector_type(8))) short bx8; typedef __attribute__((ext_vector_type(16))) float fx16;
    const unsigned short* x1 = (const unsigned short*)(a.ws + WS_X1); const float* modf = (const float*)(a.ws + WS_MODF); const float* g_ffn = a.in[11]; const float* w_router = a.in[12]; const float* b_router = a.in[13];
    unsigned char* H2 = a.ws + WS_H2; int* inv = (int*)(a.ws + WS_INV); float* tok_w = (float*)(a.ws + WS_TOKW);
    LAS float* part = (LAS float*)(F.lds + RING_OFF);
    LAS float* ssq = (LAS float*)(F.lds + RING_OFF + 32768);
    LAS float* cpart = (LAS float*)(F.lds + RING_OFF + 32768 + 1024);
    LAS float* lg = (LAS float*)(F.lds + RING_OFF + 57344);
    LAS float* rs = (LAS float*)(F.lds + RING_OFF + 32768 + 3072 + 4352);
    LAS float* gsl = (LAS float*)(F.lds + RING_OFF + 49152);
    LAS float* shl = (LAS float*)(F.lds + RING_OFF + 49152 + 4096);
    const int lane = F.lane, w = F.wave, r32 = lane & 31, hi = lane >> 5;
#pragma unroll 1
    for (int chunk = blockIdx.x; chunk < NTOK / 64; chunk += F.G) {
        const int b = chunk / (SEQ / 64);
        __syncthreads();
        for (int i = F.tid; i < D; i += NWAVES * 64) { gsl[i] = g_ffn[i] * (1.f + modf[(size_t)b * 6 * D + 4 * D + i]); shl[i] = modf[(size_t)b * 6 * D + 3 * D + i]; }
        __syncthreads();
        bx8 ahi[8], alo[8]; float cp = 0.f;
        const float* wrp = w_router + (size_t)(128 * w + 8 * hi) * NE + r32; const LAS float* gsp = gsl + 128 * w + 8 * hi; const LAS float* shp = shl + 128 * w + 8 * hi;
#pragma unroll
        for (int s = 0; s < 8; ++s) {
            unsigned ph[4], pl[4];
#pragma unroll
            for (int j2 = 0; j2 < 4; ++j2) { float v[2];
#pragma unroll
                for (int q = 0; q < 2; ++q) { const int kk = 16 * s + 2 * j2 + q; const float wr_ = wrp[kk * NE]; cp += shp[kk] * wr_; v[q] = gsp[kk] * wr_; }
                const unsigned h0 = f2bf(v[0]), h1 = f2bf(v[1]); ph[j2] = h0 | (h1 << 16);
                pl[j2] = f2bf(v[0] - __uint_as_float(h0 << 16)) | (f2bf(v[1] - __uint_as_float(h1 << 16)) << 16); }
            ahi[s] = __builtin_bit_cast(bx8, (v4u){ph[0], ph[1], ph[2], ph[3]}); alo[s] = __builtin_bit_cast(bx8, (v4u){pl[0], pl[1], pl[2], pl[3]});
        }
        cpart[(w * 2 + hi) * 32 + r32] = cp;
#pragma unroll 1
        for (int pass = 0; pass < 2; ++pass) {
            const int tok = chunk * 64 + pass * 32 + r32;
            const unsigned short* xr = x1 + (size_t)tok * D + 128 * w + 8 * hi;
            float ss = 0.f; fx16 acc = {};
#pragma unroll
            for (int s = 0; s < 8; ++s) {
                const v4u xw = *(const GAS v4u*)(xr + 16 * s);
#pragma unroll
                for (int q = 0; q < 4; ++q) { const float v0 = __uint_as_float(xw[q] << 16), v1 = __uint_as_float(xw[q] & 0xffff0000u); ss += v0 * v0 + v1 * v1; }
                const bx8 bhi = __builtin_bit_cast(bx8, xw);
                acc = __builtin_amdgcn_mfma_f32_32x32x16_bf16(ahi[s], bhi, acc, 0, 0, 0);
                acc = __builtin_amdgcn_mfma_f32_32x32x16_bf16(alo[s], bhi, acc, 0, 0, 0);
            }
            ss += __shfl_xor(ss, 32);
            __syncthreads();
#pragma unroll
            for (int r = 0; r < 16; ++r) part[(w * 32 + ((r & 3) + 8 * (r >> 2) + 4 * hi)) * 32 + r32] = acc[r];
            if (hi == 0) ssq[w * 32 + r32] = ss;
            __syncthreads();
            { const int tk = F.tid & 31, eg = F.tid >> 5;
                float sq = 0.f;
#pragma unroll
                for (int ww = 0; ww < 8; ++ww) sq += ssq[ww * 32 + tk];
                const float rstd = 1.f / sqrtf(sq * (1.f / D) + EPS);
                if (eg == 0) rs[tk] = rstd;
#pragma unroll
                for (int q = 0; q < 2; ++q) { const int e = 2 * eg + q; float sum = 0.f, c = b_router[e];
#pragma unroll
                    for (int ww = 0; ww < 8; ++ww) sum += part[(ww * 32 + e) * 32 + tk];
#pragma unroll
                    for (int ww = 0; ww < 16; ++ww) c += cpart[ww * 32 + e];
                    lg[(pass * 32 + tk) * 33 + e] = rstd * sum + c; } }
            __syncthreads();
            { const float rstd = rs[r32]; unsigned char* hr = H2 + (size_t)tok * D + 128 * w + 8 * hi;
#pragma unroll
                for (int s = 0; s < 8; ++s) { unsigned pk[2]; const v4u xw = *(const GAS v4u*)(xr + 16 * s);
#pragma unroll
                    for (int q = 0; q < 2; ++q) { const f32x4 xv = {__uint_as_float(xw[2 * q] << 16), __uint_as_float(xw[2 * q] & 0xffff0000u), __uint_as_float(xw[2 * q + 1] << 16), __uint_as_float(xw[2 * q + 1] & 0xffff0000u)};
                        const f32x4 g4 = *(const LAS f32x4*)(gsp + 16 * s + 4 * q), h4 = *(const LAS f32x4*)(shp + 16 * s + 4 * q);
                        const f32x4 hv = xv * rstd * g4 + h4; pk[q] = pg8::pk4_f8(hv.x, hv.y, hv.z, hv.w); }
                    *(GAS unsigned long long*)(hr + 16 * s) = (unsigned long long)pk[0] | ((unsigned long long)pk[1] << 32); } }
        }
        __syncthreads();
        if (w == 0) {
            float lgv[NE];
#pragma unroll
            for (int i = 0; i < NE; ++i) lgv[i] = lg[lane * 33 + i];
            int idx[TOPK]; float val[TOPK]; unsigned used = 0;
#pragma unroll
            for (int r = 0; r < TOPK; ++r) { int best = -1; float bv = 0.f;
#pragma unroll
                for (int i = 0; i < NE; ++i) if (!((used >> i) & 1u) && (best < 0 || lgv[i] > bv)) { best = i; bv = lgv[i]; }
                used |= 1u << best; idx[r] = best; val[r] = bv; }
            float wsum = 0.f, wv[TOPK];
#pragma unroll
            for (int r = 0; r < TOPK; ++r) { wv[r] = __expf(val[r] - val[0]); wsum += wv[r]; }
            const int tk = chunk * 64 + lane; const float inv_ws = 1.f / wsum;
            const unsigned selbits = (1u << idx[0]) | (1u << idx[1]) | (1u << idx[2]) | (1u << idx[3]);
            int rk[TOPK] = {0, 0, 0, 0}; int cnt = 0;
#pragma unroll 1
            for (int e = 0; e < NE; ++e) {
                const unsigned long long mm = __ballot((selbits >> e) & 1u);
                const int rnk = __popcll(mm & ((1ull << lane) - 1ull));
#pragma unroll
                for (int r = 0; r < TOPK; ++r) if (idx[r] == e) rk[r] = rnk;
                if (lane == e) cnt = __popcll(mm);
            }
#pragma unroll
            for (int r = 0; r < TOPK; ++r) { inv[((size_t)chunk * NE + idx[r]) * 64 + rk[r]] = tk * 4 + r; tok_w[tk * 4 + r] = wv[r] * inv_ws; }
            if (lane < NE) ((int*)(a.ws + WS_CNTC))[lane * 256 + chunk] = cnt;
        }
    }
}
__device__ __forceinline__ void build_tiles(Frame& F, const Args& a) {
    LAS int* tile_e = (LAS int*)(F.lds + LDS_TILE_E); LAS int* ntl = (LAS int*)(F.lds + LDS_NT); LAS int* tbase = (LAS int*)(F.lds + LDS_TBASE); LAS int* cnte = (LAS int*)(F.lds + LDS_CNTE);
    LAS int* pre = (LAS int*)(F.lds + RING_OFF);
    __syncthreads();
    { const int e = F.tid >> 4, part = F.tid & 15; const int* cp = (const int*)(a.ws + WS_CNTC) + e * 256 + part * 16;
        int v[16]; int sum = 0;
#pragma unroll
        for (int q = 0; q < 4; ++q) { const int4 t4 = *(const int4*)(cp + 4 * q); v[4 * q] = t4.x; v[4 * q + 1] = t4.y; v[4 * q + 2] = t4.z; v[4 * q + 3] = t4.w; }
#pragma unroll
        for (int q = 0; q < 16; ++q) { const int t = v[q]; v[q] = sum; sum += t; }
        int inc = sum;
#pragma unroll
        for (int d = 1; d < 16; d <<= 1) { const int n = __shfl_up(inc, d, 16); if (part >= d) inc += n; }
        const int excl = inc - sum;
#pragma unroll
        for (int q = 0; q < 16; ++q) pre[e * 256 + part * 16 + q] = excl + v[q];
        if (part == 15) cnte[e] = inc; }
    __syncthreads();
    if (F.tid < NE) { const int e = F.tid, nt = (cnte[e] + 255) >> 8; int inc = nt;
#pragma unroll
        for (int d = 1; d < NE; d <<= 1) { const int n = __shfl_up(inc, d, NE); if (e >= d) inc += n; }
        const int base = inc - nt; tbase[e] = base; for (int j = 0; j < nt; ++j) tile_e[base + j] = e;
        if (e == NE - 1) ntl[0] = inc; }
    __syncthreads();
}
__device__ __forceinline__ void p8_final(Frame& F, const Args& a) {
    const unsigned short* x1 = (const unsigned short*)(a.ws + WS_X1); const unsigned char* Y = a.ws + WS_Y; const float* modf = (const float*)(a.ws + WS_MODF);
    const int* tok_slot = (const int*)(a.ws + WS_TOKP); const float* tok_w = (const float*)(a.ws + WS_TOKW);
    const float* gfin = a.in[18];
    const int gw = F.vcu * NWAVES + F.wave, NGW = F.G * NWAVES;
    constexpr int P8R = 4;
    typedef int i32x4 __attribute__((ext_vector_type(4)));
    i32x4 np[P8R]; f32x4 nw[P8R];
#define P8_ROUTE(r0) do { _Pragma("unroll") for (int _q = 0; _q < P8R; ++_q) { const int _r = (r0) + _q * NGW; if (_r < NTOK) { np[_q] = *(const GAS i32x4*)(tok_slot + _r * 4); nw[_q] = *(const GAS f32x4*)(tok_w + _r * 4); } } } while (0)
    P8_ROUTE(gw);
    for (int row0 = gw; row0 < NTOK; row0 += P8R * NGW) {
        i32x4 cp[P8R]; f32x4 cw[P8R];
#pragma unroll
        for (int q = 0; q < P8R; ++q) { cp[q] = np[q]; cw[q] = nw[q]; }
        unsigned yv[P8R][TOPK][4]; pg8::u32x2 xv[P8R][4];
#pragma unroll
        for (int q = 0; q < P8R; ++q) { const int row = row0 + q * NGW; if (row < NTOK) {
#pragma unroll
            for (int k = 0; k < TOPK; ++k) { const int slot = __builtin_amdgcn_readfirstlane(cp[q][k]);
                const GAS unsigned* yr = (const GAS unsigned*)(Y + (size_t)slot * D) + F.lane;
#pragma unroll
                for (int j = 0; j < 4; ++j) yv[q][k][j] = yr[64 * j]; }
            const GAS pg8::u32x2* xr = (const GAS pg8::u32x2*)(x1 + (size_t)row * D) + F.lane;
#pragma unroll
            for (int j = 0; j < 4; ++j) xv[q][j] = xr[64 * j]; } }
        P8_ROUTE(row0 + P8R * NGW);
#pragma unroll
        for (int q = 0; q < P8R; ++q) { const int row = row0 + q * NGW; if (row < NTOK) {
            const int b = row / SEQ; const float* gf = modf + (size_t)b * 6 * D + 5 * D;
            f32x4 acc[4];
#pragma unroll
            for (int j = 0; j < 4; ++j) acc[j] = (f32x4){0.f, 0.f, 0.f, 0.f};
#pragma unroll
            for (int k = 0; k < TOPK; ++k) { const float wk = cw[q][k] * (1.0f / YSCALE);
#pragma unroll
                for (int j = 0; j < 4; ++j) { const int qq = (int)yv[q][k][j]; const auto lo = __builtin_amdgcn_cvt_pk_f32_fp8(qq, false), hi = __builtin_amdgcn_cvt_pk_f32_fp8(qq, true);
                    acc[j].x += wk * lo[0]; acc[j].y += wk * lo[1]; acc[j].z += wk * hi[0]; acc[j].w += wk * hi[1]; } }
            float s = 0.f; f32x4 v[4];
#pragma unroll
            for (int j = 0; j < 4; ++j) { const f32x4 g4 = *(const GAS f32x4*)(gf + 4 * F.lane + 256 * j); const f32x4 x4 = {__uint_as_float(xv[q][j].x << 16), __uint_as_float(xv[q][j].x & 0xffff0000u), __uint_as_float(xv[q][j].y << 16), __uint_as_float(xv[q][j].y & 0xffff0000u)}; v[j] = x4 + g4 * acc[j]; s += (v[j].x * v[j].x + v[j].y * v[j].y) + (v[j].z * v[j].z + v[j].w * v[j].w); }
            const float rstd = 1.f / sqrtf(wave_sum(s) * (1.f / D) + EPS);
            GAS f32x4* orow = (GAS f32x4*)(a.out + (size_t)row * D) + F.lane;
#pragma unroll
            for (int j = 0; j < 4; ++j) { const f32x4 g4 = *(const GAS f32x4*)(gfin + 4 * F.lane + 256 * j); orow[64 * j] = v[j] * rstd * g4; } } }
    }
#undef P8_ROUTE
}
__device__ __forceinline__ void build_ridx(Frame& F, const Args& a, int nN) {
    const LAS int* tile_e = (const LAS int*)(F.lds + LDS_TILE_E); const LAS int* tbase = (const LAS int*)(F.lds + LDS_TBASE); const LAS int* cnte = (const LAS int*)(F.lds + LDS_CNTE);
    const LAS int* pre = (const LAS int*)(F.lds + RING_OFF); const int ntiles = *(const LAS int*)(F.lds + LDS_NT);
    LAS int* ridx = (LAS int*)(F.lds + LDS_RIDX); const int* lists = (const int*)(a.ws + WS_INV); int* tok_slot = (int*)(a.ws + WS_TOKP);
    int adr[5], slot[5], flag[5];
#pragma unroll
    for (int k = 0; k < 5; ++k) { const int it = F.tid + k * (NWAVES * 64), i = it >> 8, r = it & 255; int t, pn_; flag[k] = 0; adr[k] = 0; slot[k] = 0;
        if (pg8::moe_unit(i, (int)blockIdx.x, F.G, nN, cnte, tbase, ntiles, t, pn_)) {
            const int e = tile_e[t], j = t - tbase[e], c = cnte[e]; int pos = j * 256 + r; const bool real = pos < c; if (!real) pos = 0;
            int lo = 0;
#pragma unroll
            for (int st = 128; st >= 1; st >>= 1) if (pre[e * 256 + lo + st] <= pos) lo += st;
            adr[k] = (lo * NE + e) * 64 + (pos - pre[e * 256 + lo]); slot[k] = t * 256 + r; flag[k] = (pn_ == 0 && real) ? 2 : 1; } }
    int ent[5];
#pragma unroll
    for (int k = 0; k < 5; ++k) ent[k] = flag[k] ? lists[adr[k]] : 0;
#pragma unroll
    for (int k = 0; k < 5; ++k) if (flag[k]) { ridx[F.tid + k * (NWAVES * 64)] = ent[k] >> 2; if (flag[k] == 2) tok_slot[ent[k]] = slot[k]; }
    __syncthreads();
}

__global__ void __launch_bounds__(NWAVES * 64, 2) mega_fwd(Args args) {
    extern __shared__ __attribute__((aligned(16))) unsigned char lds[];
    Frame F;
    F.lds = (LAS unsigned char*)lds;
    F.MISC = (volatile LAS unsigned*)(F.lds + MISC_OFF);
    F.tid = threadIdx.x; F.lane = F.tid & 63; F.wave = __builtin_amdgcn_readfirstlane(F.tid >> 6);
    F.G = gridDim.x; { const int bx = blockIdx.x; F.vcu = (F.G % 8 == 0) ? (bx % 8) * (F.G / 8) + bx / 8 : bx; }
    unsigned char* ws = args.ws;
    F.ctl = (gu32*)(ws + WS_CTL);
    for (int u = F.tid; u < 512 / 4; u += NWAVES * 64) ((LAS unsigned*)(F.lds + LDSCTL_OFF))[u] = 0u;
    __syncthreads();
    XcdBarrier bar = xcd_barrier_post((unsigned*)(F.ctl + CW_BAR), F.MISC + 8);
    const int lo = args.ph_lo, hi = args.ph_hi;
#ifndef PHASE_MASK
#define PHASE_MASK 0x1ff
#endif
#define IN(k) (((PHASE_MASK >> (k)) & 1) && lo <= (k) && (k) < hi)
#define BOTH(k) (IN(k) && IN((k) + 1))
#define GRID_BAR() xcd_barrier(bar)
#define REFRESH() do { int t_ = threadIdx.x; asm volatile("" : "+v"(t_)); F.tid = t_; F.lane = t_ & 63; F.wave = __builtin_amdgcn_readfirstlane(t_ >> 6); } while (0)
    const bool split = (F.G == 256); constexpr int NCONV = 64, NCONV3 = 64;
    const bool is_conv = split && (int)blockIdx.x >= F.G - NCONV, is_conv3 = split && (int)blockIdx.x >= F.G - NCONV3;
    const int NC = split ? F.G - NCONV : F.G, NC3 = split ? F.G - NCONV3 : F.G, cidx = (int)blockIdx.x;
    const int nconvw = (split ? NCONV : F.G) * NWAVES, convw = (split ? (int)blockIdx.x - (F.G - NCONV) : (int)blockIdx.x) * NWAVES;
    const int nconvw3 = (split ? NCONV3 : F.G) * NWAVES, convw3 = (split ? (int)blockIdx.x - (F.G - NCONV3) : (int)blockIdx.x) * NWAVES;
    constexpr int CV_SPLIT = 4096;
    if (IN(0)) { p0_prologue(F, args); if (!split) conv_range(F, args, 0, CV_ITEMS, F.vcu * NWAVES + F.wave, F.G * NWAVES); if (BOTH(0)) GRID_BAR(); }
    if (IN(1)) { REFRESH(); p1_xn(F, args); if (BOTH(1)) GRID_BAR(); }
    if (IN(2)) {
        if (is_conv) { REFRESH(); conv_range(F, args, 0, CV_SPLIT, convw + F.wave, nconvw); }
        else {
            pg8::Gemm g{(const bf16*)(ws + WS_XN), (const bf16*)(ws + WS_WIN), NTOK, D_IN, D}; pg8::StaticOrder S; S.init(NTOK, D_IN, NC, cidx);
            pg8::EpiProj E{(bf16*)(ws + WS_PROJ), args.in[6], (float*)(F.ctl + CW_KSUM)};
            pg8::gemm_phase<pg8::EpiProj, pg8::StaticOrder, false, true>(F.lds + RING_OFF, g, S, E);
        }
        if (BOTH(2)) GRID_BAR();
    }
    if (IN(3)) {
        if (is_conv3) { REFRESH(); conv_range(F, args, CV_SPLIT, CV_ITEMS, convw3 + F.wave, nconvw3); }
        else {
            const float* sinks = args.in[10]; int prev_key = -1;
            for (int round = 0; ; ++round) {
                const int rank = round * NC3 + ((round & 1) ? (((NC3 & 7) == 0) ? ((NC3 - 1 - cidx) ^ 7) : NC3 - 1 - cidx) : cidx); if (rank >= 1024) break;
                att::UnitDesc u;
                if (rank < 512) { const int bh = rank & 63, h = bh & 7; u.b = bh >> 3; u.qb = 7 - (rank >> 6); u.q0 = u.qb * 256; u.gqa = 0; u.moba = 1;
                    u.qcol = h * 64; u.kcol = 512 + h * 64; u.vcol = 1024 + h * 64; u.ocol = h * 64; u.head = h; u.sink2 = 0.f; u.fill = (h != prev_key); prev_key = h; u.fillk = 1; }
                else { const int idx = rank - 512, bk = idx & 15, kvh = bk & 1; u.b = bk >> 1; u.q0 = (31 - (idx >> 4)) * 64; u.qb = u.q0 >> 8; u.gqa = 1; u.moba = 0;
                    u.qcol = 1536 + kvh * 256; u.kcol = 2048 + kvh * 64; u.vcol = 2176 + kvh * 64; u.ocol = 512 + kvh * 256; u.head = 8 + kvh * 4; u.sink2 = 0.f; u.fill = (64 + kvh != prev_key); prev_key = 64 + kvh; u.fillk = 0; }
                att::attn_unit(u, (const bf16*)(ws + WS_PROJ), (bf16*)(ws + WS_O), (const float*)(ws + WS_BIAS), (const float*)(F.ctl + CW_KSUM), sinks, (char*)lds + RING_OFF);
            }
        }
        if (BOTH(3)) GRID_BAR();
    }
    if (IN(4)) {
        pg8::Gemm g{(const bf16*)(ws + WS_O), (const bf16*)(ws + WS_WOUT), NTOK, D, D}; pg8::StaticOrder S; S.init(NTOK, D, F.G, (int)blockIdx.x);
        pg8::EpiX1 E{args.in[0], (pg8::bf16_t*)(ws + WS_X1), args.in[8], (const float*)(ws + WS_MODF)};
        pg8::gemm_phase<pg8::EpiX1, pg8::StaticOrder, false, true>(F.lds + RING_OFF, g, S, E);
        if (BOTH(4)) GRID_BAR();
    }
    if (IN(5)) { REFRESH(); p5_router(F, args); if (BOTH(5)) GRID_BAR(); }
    if (IN(6)) {
        REFRESH(); build_tiles(F, args); build_ridx(F, args, 2 * DFF / 256);
        pg8::Gemm g{(const bf16*)(ws + WS_H2), (const bf16*)(ws + WS_WGU), MAXSLOTS, 2 * DFF, D / 2};
        pg8::GroupedOrder S{2 * DFF / 256, F.G, (int)blockIdx.x, *(const LAS int*)(F.lds + LDS_NT), (const LAS int*)(F.lds + LDS_TILE_E), (const LAS int*)(F.lds + LDS_RIDX), (size_t)2 * DFF * D, (const LAS int*)(F.lds + LDS_CNTE), (const LAS int*)(F.lds + LDS_TBASE)};
        pg8::EpiSwiglu8 E{ws + WS_ACT, args.in[15]};
        pg8::gemm_phase<pg8::EpiSwiglu8, pg8::GroupedOrder, false, true, true>(F.lds + RING_OFF, g, S, E);
        if (BOTH(6)) GRID_BAR();
    }
    if (IN(7)) {
        REFRESH(); if (!IN(6)) build_tiles(F, args);
        pg8::Gemm g{(const bf16*)(ws + WS_ACT), (const bf16*)(ws + WS_WD), MAXSLOTS, D, DFF / 2};
        pg8::GroupedOrder S{D / 256, F.G, (int)blockIdx.x, *(const LAS int*)(F.lds + LDS_NT), (const LAS int*)(F.lds + LDS_TILE_E), (const LAS int*)nullptr, (size_t)D * DFF, (const LAS int*)(F.lds + LDS_CNTE), (const LAS int*)(F.lds + LDS_TBASE)};
        pg8::EpiDown8 E{ws + WS_Y, args.in[17]};
        pg8::gemm_phase<pg8::EpiDown8, pg8::GroupedOrder, false, true, true>(F.lds + RING_OFF, g, S, E);
        if (BOTH(7)) GRID_BAR();
    }
    if (IN(8)) { REFRESH(); p8_final(F, args); }
#undef IN
#undef BOTH
}

#ifndef MK_PER_PHASE
#define MK_PER_PHASE 0
#endif
extern "C" void kernel_launch(void* const* d_in, const int* in_sizes, int n_in, void* d_out, int out_size, void* d_ws, size_t ws_size, hipStream_t stream) {
    static int grid = 0;
    if (grid == 0) {
        if (n_in != 19 || ws_size < WS_END) { fprintf(stderr, "kernel_launch: unexpected n_in %d / ws %zu\n", n_in, ws_size); grid = -1; return; }
        int dev = 0, cus = 0, per_cu = 0;
        if (hipGetDevice(&dev) != hipSuccess || hipDeviceGetAttribute(&cus, hipDeviceAttributeMultiprocessorCount, dev) != hipSuccess) { grid = -1; return; }
        if (hipFuncSetAttribute((const void*)mega_fwd, hipFuncAttributeMaxDynamicSharedMemorySize, LDS_BYTES) != hipSuccess) { fprintf(stderr, "kernel_launch: hipFuncSetAttribute failed\n"); grid = -1; return; }
        if (hipOccupancyMaxActiveBlocksPerMultiprocessor(&per_cu, (const void*)mega_fwd, NWAVES * 64, LDS_BYTES) != hipSuccess || per_cu < 1) fprintf(stderr, "kernel_launch: occupancy query reports %d\n", per_cu);
        (void)hipGetLastError();
        grid = cus;
    }
    if (grid < 0) return;
    unsigned char* ws = (unsigned char*)d_ws;
    (void)hipMemsetAsync(ws + WS_CTL, 0, CTL_ZERO_BYTES, stream);
    Args a{};
    for (int i = 0; i < 19; ++i) a.in[i] = (const float*)d_in[i];
    a.out = (float*)d_out; a.ws = ws;
#if MK_PER_PHASE
    for (int ph = 0; ph < 9; ++ph) { a.ph_lo = ph; a.ph_hi = ph + 1; hipLaunchKernelGGL(mega_fwd, dim3(grid), dim3(NWAVES * 64), LDS_BYTES, stream, a); }
#else
    a.ph_lo = 0; a.ph_hi = 9; hipLaunchKernelGGL(mega_fwd, dim3(grid), dim3(NWAVES * 64), LDS_BYTES, stream, a);
#endif
}
```

```cpp
#include <hip/hip_runtime.h>
#include <hip/hip_bf16.h>
#include <cstdio>
#include <cstdint>
#include <cmath>

constexpr int D = 1024, BATCH = 8, SEQ = 2048, NTOK = BATCH * SEQ;
constexpr int HD = 64, NH_M = 8, NH_S = 8, NKV_S = 2;
constexpr int D_MOBA = 512, D_SWA_Q = 512, D_SWA_KV = 128, D_IN = 2304;
constexpr int MB_L = 256, MB_NB = SEQ / MB_L, MB_TOPK = 3;
constexpr int SWA_W = 128;
constexpr int NE = 32, TOPK = 4, DFF = 1024;
constexpr float EPS = 1e-5f, NEGF = -1e30f;
constexpr int MAXTILES = 288;
constexpr int MAXSLOTS = MAXTILES * 256;
constexpr float LOG2E = 1.4426950408889634f;
constexpr float OSCALE = 16.0f;
constexpr float YSCALE = 16.0f;
constexpr float WSCALE = 32.0f;
constexpr float QSCALE = 0.125f * LOG2E;

namespace pg8 {
#define PG8_LAS __attribute__((address_space(3)))
typedef unsigned short bf16_t;
typedef short bf16x8 __attribute__((ext_vector_type(8)));
typedef float f32x4 __attribute__((ext_vector_type(4)));
typedef unsigned u32x4 __attribute__((ext_vector_type(4)));
typedef int v4i_t __attribute__((ext_vector_type(4)));
constexpr int BM = 256, BK = 64, HALF = 128, HTB = HALF * BK * 2  , STAGE_BYTES = 8 * HTB, NXCD = 8, WGM = 8;

__host__ __device__ __forceinline__ int lds_byte(int r, int c) { const int st = (r >> 4) * 2 + (c >> 5), rr = r & 15, cc = c & 31, ob = rr * 64 + cc * 2; return st * 1024 + (ob ^ (((ob >> 9) & 1) << 5)); }
__host__ __device__ __forceinline__ void stage_rc(int b, int& R, int& C) { const int st = b / 1024, sb = b % 1024, swz = sb ^ (((sb >> 9) & 1) << 5); R = (st >> 1) * 16 + swz / 64; C = (st & 1) * 32 + (swz % 64) / 2; }
__host__ __device__ __forceinline__ int perm32(int rho) { const int n = rho >> 4, i = rho & 15; return 8 * (i >> 2) + 4 * n + (i & 3); }

struct Unit { int pm, pn, e; };
struct Gemm { const bf16_t* A; const bf16_t* Bt; int M, N, K; };

struct StaticOrder {
    int nM, nN, nwg, G, c;
    __host__ __device__ void init(int M, int N, int G_, int c_) { nM = M / BM; nN = N / BM; nwg = nM * nN; G = G_; c = c_; }
    __host__ __device__ bool next(int i, Unit& u) const {
        const long L = (long)i * G + c; if (L >= nwg) return false;
        int wgid = (int)L; { const int q = nwg / NXCD, r = nwg % NXCD, xcd = wgid % NXCD, off = wgid / NXCD; wgid = (xcd < r ? xcd * (q + 1) : r * (q + 1) + (xcd - r) * q) + off; }
        const int nig = WGM * nN, gid = wgid / nig, fm = gid * WGM, gsz = (nM - fm) < WGM ? (nM - fm) : WGM;
        u.pm = fm + ((wgid % nig) % gsz); u.pn = (wgid % nig) / gsz; u.e = 0; return true;
    }
    __device__ __forceinline__ size_t abase(const Unit& u, int h, int K) const { return (size_t)(u.pm * BM + h * HALF) * K * 2; }
    __device__ __forceinline__ unsigned alane(int, const Unit&, int, int, unsigned voff, int) const { return voff; }
    __device__ __forceinline__ size_t bbase(const Unit& u, size_t tstep) const { return (size_t)u.pn * tstep; }
    __device__ __forceinline__ void a_ready(const Unit&) const {}
    __device__ __forceinline__ void done(const Unit&) const {}
};
__device__ __forceinline__ bool moe_unit(int i, int c, int G, int nN, const PG8_LAS int* cnte, const PG8_LAS int* tbase, int ntiles, int& t, int& pn) {
    if ((G & 7) == 0) {
        const int x = c & 7, rank = c >> 3, W = G >> 3, lo = (x * ntiles) >> 3, hi = ((x + 1) * ntiles) >> 3, v = i * W + rank;
        if (v >= (hi - lo) * nN) return false;
        const int j = v / nN; t = lo + j; pn = v - j * nN; return true;
    }
    const int L = i * G + c; t = L / nN; if (t >= ntiles) return false; pn = L - t * nN; return true;
}
struct GroupedOrder {
    int nN, G, c, ntiles; const PG8_LAS int* tile_e; const PG8_LAS int* ridx; size_t bstride; const PG8_LAS int* cnte; const PG8_LAS int* tbase;
    __device__ __forceinline__ bool next(int i, Unit& u) const {
        int t, pn; if (!moe_unit(i, c, G, nN, cnte, tbase, ntiles, t, pn)) return false;
        u.pm = __builtin_amdgcn_readfirstlane(t); u.pn = __builtin_amdgcn_readfirstlane(pn); u.e = __builtin_amdgcn_readfirstlane(tile_e[t]); return true;
    }
    __device__ __forceinline__ size_t abase(const Unit& u, int h, int K) const { return ridx ? (size_t)0 : (size_t)(u.pm * BM + h * HALF) * K * 2; }
    __device__ __forceinline__ unsigned alane(int ui, const Unit&, int h, int piece, unsigned voff, int K) const {
        if (!ridx) return voff;
        int t_ = (int)threadIdx.x; asm volatile("" : "+v"(t_));
        int R, C; stage_rc(t_ * 16 + piece * 8192, R, C);
        return (unsigned)ridx[ui * BM + h * HALF + R] * (unsigned)K * 2u + (unsigned)C * 2u; }
    __device__ __forceinline__ size_t bbase(const Unit& u, size_t tstep) const { return (size_t)u.e * bstride + (size_t)u.pn * tstep; }
    __device__ __forceinline__ void a_ready(const Unit&) const {}
    __device__ __forceinline__ void done(const Unit&) const {}
};

__device__ __forceinline__ unsigned cvt_pk_bf16(float lo, float hi) { unsigned r; asm volatile("v_cvt_pk_bf16_f32 %0, %1, %2" : "=v"(r) : "v"(lo), "v"(hi)); return r; }

struct EpiProj {
    static constexpr bool PERM = true, AFTER_DRAIN = false;
    bf16_t* O; const float* bias; float* ksum;
    __device__ __forceinline__ void operator()(const f32x4 (&acc)[2][2][4][2], const Unit& u, int wr, int wc, int fr, int fq) const {
        const int row0 = u.pm * BM + wr * 64 + fr, col0 = u.pn * BM + wc * 32 + 8 * fq;
        const float sc = (u.pn < 2 || u.pn == 6 || u.pn == 7) ? QSCALE : 1.0f;
        f32x4 bv[2][2];
#pragma unroll
        for (int bj = 0; bj < 2; ++bj)
#pragma unroll
            for (int n = 0; n < 2; ++n) bv[bj][n] = *(const f32x4*)(bias + col0 + bj * HALF + 4 * n);
#pragma unroll
        for (int ai = 0; ai < 2; ++ai)
#pragma unroll
            for (int m = 0; m < 4; ++m) { bf16_t* rowp = O + (size_t)(row0 + ai * HALF + m * 16) * D_IN + col0;
#pragma unroll
                for (int bj = 0; bj < 2; ++bj) { f32x4 v0 = (acc[ai][bj][m][0] + bv[bj][0]) * sc, v1 = (acc[ai][bj][m][1] + bv[bj][1]) * sc;
                    u32x4 w; w.x = cvt_pk_bf16(v0[0], v0[1]); w.y = cvt_pk_bf16(v0[2], v0[3]); w.z = cvt_pk_bf16(v1[0], v1[1]); w.w = cvt_pk_bf16(v1[2], v1[3]);
                    *(u32x4*)(rowp + bj * HALF) = w; } }
        if (u.pn == 2 || u.pn == 3) {
#pragma unroll
            for (int bj = 0; bj < 2; ++bj)
#pragma unroll
                for (int n = 0; n < 2; ++n) {
                    f32x4 s = bv[bj][n] * 8.0f;
#pragma unroll
                    for (int ai = 0; ai < 2; ++ai)
#pragma unroll
                        for (int m = 0; m < 4; ++m) s += acc[ai][bj][m][n];
#pragma unroll
                    for (int j = 0; j < 4; ++j) { float t = s[j]; t += __shfl_xor(t, 1); t += __shfl_xor(t, 2); t += __shfl_xor(t, 4); t += __shfl_xor(t, 8);
                        if (fr == 0) atomicAdd(ksum + (size_t)u.pm * D_MOBA + (u.pn - 2) * BM + bj * HALF + wc * 32 + 8 * fq + 4 * n + j, t); }
                }
        }
    }
};
struct EpiX1 {
    static constexpr bool PERM = true, AFTER_DRAIN = false;
    const float* x; bf16_t* x1; const float* bias; const float* modf;
    __device__ __forceinline__ void operator()(const f32x4 (&acc)[2][2][4][2], const Unit& u, int wr, int wc, int fr, int fq) const {
        const int row0 = u.pm * BM + wr * 64 + fr, col0 = u.pn * BM + wc * 32 + 8 * fq;
        const float* ga = modf + (size_t)(u.pm >> 3) * 6 * D + 2 * D;
        f32x4 bv[2][2], gv[2][2];
#pragma unroll
        for (int bj = 0; bj < 2; ++bj)
#pragma unroll
            for (int n = 0; n < 2; ++n) { bv[bj][n] = *(const f32x4*)(bias + col0 + bj * HALF + 4 * n); gv[bj][n] = *(const f32x4*)(ga + col0 + bj * HALF + 4 * n); }
#pragma unroll
        for (int ai = 0; ai < 2; ++ai)
#pragma unroll
            for (int m = 0; m < 4; ++m) { const size_t off = (size_t)(row0 + ai * HALF + m * 16) * D + col0;
#pragma unroll
                for (int bj = 0; bj < 2; ++bj) { const f32x4 xr0 = *(const f32x4*)(x + off + bj * HALF), xr1 = *(const f32x4*)(x + off + bj * HALF + 4);
                    const f32x4 v0 = xr0 + gv[bj][0] * (acc[ai][bj][m][0] * (1.0f / (WSCALE * OSCALE)) + bv[bj][0]), v1 = xr1 + gv[bj][1] * (acc[ai][bj][m][1] * (1.0f / (WSCALE * OSCALE)) + bv[bj][1]);
                    u32x4 w; w.x = cvt_pk_bf16(v0[0], v0[1]); w.y = cvt_pk_bf16(v0[2], v0[3]); w.z = cvt_pk_bf16(v1[0], v1[1]); w.w = cvt_pk_bf16(v1[2], v1[3]);
                    *(u32x4*)(x1 + off + bj * HALF) = w; }
                if (m == 3) asm volatile("" ::: "memory"); }
    }
};
struct EpiSwiglu {
    static constexpr bool PERM = true, AFTER_DRAIN = false;
    bf16_t* act; const float* bias;
    __device__ __forceinline__ void operator()(const f32x4 (&acc)[2][2][4][2], const Unit& u, int wr, int wc, int fr, int fq) const {
        const int row0 = u.pm * BM + wr * 64 + fr, ff0 = u.pn * HALF + wc * 32 + 8 * fq;
        const float* bg = bias + (size_t)u.e * 2 * DFF + ff0;
        f32x4 bgv[2], buv[2];
#pragma unroll
        for (int n = 0; n < 2; ++n) { bgv[n] = *(const f32x4*)(bg + 4 * n); buv[n] = *(const f32x4*)(bg + DFF + 4 * n); }
#pragma unroll
        for (int ai = 0; ai < 2; ++ai)
#pragma unroll
            for (int m = 0; m < 4; ++m) {
                f32x4 o[2];
#pragma unroll
                for (int n = 0; n < 2; ++n) { const f32x4 gq = acc[ai][0][m][n] + bgv[n], uq = acc[ai][1][m][n] + buv[n];
#pragma unroll
                    for (int j = 0; j < 4; ++j) { const float g = fminf(gq[j], 7.0f), uu = fminf(fmaxf(uq[j], -7.0f), 7.0f);
                        const float sg = __builtin_amdgcn_rcpf(1.0f + __builtin_amdgcn_exp2f(-1.702f * LOG2E * g)); o[n][j] = (uu + 1.0f) * (g * sg); } }
                u32x4 w; w.x = cvt_pk_bf16(o[0][0], o[0][1]); w.y = cvt_pk_bf16(o[0][2], o[0][3]); w.z = cvt_pk_bf16(o[1][0], o[1][1]); w.w = cvt_pk_bf16(o[1][2], o[1][3]);
                *(u32x4*)(act + (size_t)(row0 + ai * HALF + m * 16) * DFF + ff0) = w; }
    }
};
struct EpiDown {
    static constexpr bool PERM = true, AFTER_DRAIN = false;
    bf16_t* y; const float* bias;
    __device__ __forceinline__ void operator()(const f32x4 (&acc)[2][2][4][2], const Unit& u, int wr, int wc, int fr, int fq) const {
        const int row0 = u.pm * BM + wr * 64 + fr, col0 = u.pn * BM + wc * 32 + 8 * fq;
        const float* bb = bias + (size_t)u.e * D + col0;
        f32x4 bv[2][2];
#pragma unroll
        for (int bj = 0; bj < 2; ++bj)
#pragma unroll
            for (int n = 0; n < 2; ++n) bv[bj][n] = *(const f32x4*)(bb + bj * HALF + 4 * n);
#pragma unroll
        for (int ai = 0; ai < 2; ++ai)
#pragma unroll
            for (int m = 0; m < 4; ++m) { bf16_t* rowp = y + (size_t)(row0 + ai * HALF + m * 16) * D + col0;
#pragma unroll
                for (int bj = 0; bj < 2; ++bj) { const f32x4 v0 = acc[ai][bj][m][0] + bv[bj][0], v1 = acc[ai][bj][m][1] + bv[bj][1];
                    u32x4 w; w.x = cvt_pk_bf16(v0[0], v0[1]); w.y = cvt_pk_bf16(v0[2], v0[3]); w.z = cvt_pk_bf16(v1[0], v1[1]); w.w = cvt_pk_bf16(v1[2], v1[3]);
                    *(u32x4*)(rowp + bj * HALF) = w; } }
    }
};

__device__ __forceinline__ unsigned pk4_f8(float a, float b, float c, float d) { int r = __builtin_amdgcn_cvt_pk_fp8_f32(a, b, 0, false); r = __builtin_amdgcn_cvt_pk_fp8_f32(c, d, r, true); return (unsigned)r; }
typedef unsigned u32x2 __attribute__((ext_vector_type(2)));
struct EpiSwiglu8 {
    static constexpr bool PERM = true, AFTER_DRAIN = false;
    unsigned char* act; const float* bias;
    __device__ __forceinline__ void operator()(const f32x4 (&acc)[2][2][4][2], const Unit& u, int wr, int wc, int fr, int fq) const {
        const int row0 = u.pm * BM + wr * 64 + fr, ff0 = u.pn * HALF + wc * 32 + 8 * fq;
        const float* bg = bias + (size_t)u.e * 2 * DFF + ff0;
        f32x4 bgv[2], buv[2];
#pragma unroll
        for (int n = 0; n < 2; ++n) { bgv[n] = *(const f32x4*)(bg + 4 * n); buv[n] = *(const f32x4*)(bg + DFF + 4 * n); }
#pragma unroll
        for (int ai = 0; ai < 2; ++ai)
#pragma unroll
            for (int m = 0; m < 4; ++m) {
                f32x4 o[2];
#pragma unroll
                for (int n = 0; n < 2; ++n) { const f32x4 gq = acc[ai][0][m][n] * (1.0f / WSCALE) + bgv[n], uq = acc[ai][1][m][n] * (1.0f / WSCALE) + buv[n];
#pragma unroll
                    for (int j = 0; j < 4; ++j) { const float g = fminf(gq[j], 7.0f), uu = fminf(fmaxf(uq[j], -7.0f), 7.0f);
                        const float sg = __builtin_amdgcn_rcpf(1.0f + __builtin_amdgcn_exp2f(-1.702f * LOG2E * g)); o[n][j] = (uu + 1.0f) * (g * sg); } }
                u32x2 w; w.x = pk4_f8(o[0][0], o[0][1], o[0][2], o[0][3]); w.y = pk4_f8(o[1][0], o[1][1], o[1][2], o[1][3]);
                *(u32x2*)(act + (size_t)(row0 + ai * HALF + m * 16) * DFF + ff0) = w;
                asm volatile("" ::: "memory"); }
    }
};
struct EpiDown8 {
    static constexpr bool PERM = true, AFTER_DRAIN = false;
    unsigned char* y; const float* bias;
    __device__ __forceinline__ void operator()(const f32x4 (&acc)[2][2][4][2], const Unit& u, int wr, int wc, int fr, int fq) const {
        const int row0 = u.pm * BM + wr * 64 + fr, col0 = u.pn * BM + wc * 32 + 8 * fq;
        const float* bb = bias + (size_t)u.e * D + col0;
        f32x4 bv[2][2];
#pragma unroll
        for (int bj = 0; bj < 2; ++bj)
#pragma unroll
            for (int n = 0; n < 2; ++n) bv[bj][n] = *(const f32x4*)(bb + bj * HALF + 4 * n) * YSCALE;
#pragma unroll
        for (int ai = 0; ai < 2; ++ai)
#pragma unroll
            for (int m = 0; m < 4; ++m) { unsigned char* rowp = y + (size_t)(row0 + ai * HALF + m * 16) * D + col0;
#pragma unroll
                for (int bj = 0; bj < 2; ++bj) { const f32x4 v0 = acc[ai][bj][m][0] * (YSCALE / WSCALE) + bv[bj][0], v1 = acc[ai][bj][m][1] * (YSCALE / WSCALE) + bv[bj][1];
                    u32x2 w; w.x = pk4_f8(v0[0], v0[1], v0[2], v0[3]); w.y = pk4_f8(v1[0], v1[1], v1[2], v1[3]);
                    *(u32x2*)(rowp + bj * HALF) = w; }
                asm volatile("" ::: "memory"); }
    }
};

__device__ __forceinline__ void glds16_s(const char* sbase, unsigned voff, unsigned lds_dst) { unsigned keep;
    asm volatile("s_mov_b32 %0, m0\n\ts_mov_b32 m0, %3\n\ts_nop 0\n\tglobal_load_lds_dwordx4 %1, %2\n\ts_mov_b32 m0, %0" : "=&s"(keep) : "v"(voff), "s"(sbase), "s"(lds_dst) : "memory"); }
template <class Epi, class Sched, bool ALIGN_EPI = false, bool SP2 = false, bool F8 = false>
__device__ __forceinline__ void gemm_phase(PG8_LAS unsigned char* lds, const Gemm g, const Sched& S, const Epi& E) {
    int tid_ = threadIdx.x; asm volatile("" : "+v"(tid_));
    const int tid = tid_, wid = __builtin_amdgcn_readfirstlane(tid >> 6), lane = tid & 63, wr = wid >> 2, wc = wid & 3, fr = lane & 15, fq = lane >> 4;
    const int K = g.K, nt = K / BK;
    unsigned voffA[2], voffB[2];
#pragma unroll
    for (int i = 0; i < 2; ++i) { int R, C; stage_rc(tid * 16 + i * 8192, R, C); const int Rb = Epi::PERM ? ((R & ~31) + perm32(R & 31)) : R;
        voffA[i] = (unsigned)(R * K + C) * 2u; voffB[i] = (unsigned)(Rb * K + C) * 2u; }
#define PG8_STAGE_A(bufoff, kptr, UI, U, H) do { const char* _gb = (kptr) + S.abase(U, H, K); _Pragma("unroll") for (int _i = 0; _i < 2; ++_i) \
        glds16_s(_gb, S.alane(UI, U, H, _i, voffA[_i], K), ldsbase + (unsigned)((bufoff) + _i * 8192)); } while (0)
    const size_t kstep = (size_t)(BK * 2);
    const size_t hstep = (size_t)HALF * K * 2;
    const size_t tstep = 2 * hstep;
    const unsigned ldsw = (unsigned)wid * 1024u;
    const unsigned ldsbase = (unsigned)__builtin_amdgcn_readfirstlane((int)((unsigned)(size_t)lds + ldsw));
    const int aoff = lds_byte(wr * 64 + fr, fq * 8), boff = lds_byte(wc * 32 + fr, fq * 8);
#define PG8_SA(b, h) (((b) * 2 + (h)) * HTB)
#define PG8_SB(b, h) ((4 + (b) * 2 + (h)) * HTB)
#define PG8_STAGE(bufoff, gbase, voff) do { _Pragma("unroll") for (int _i = 0; _i < 2; ++_i) \
        glds16_s((const char*)(gbase), (voff)[_i], ldsbase + (unsigned)((bufoff) + _i * 8192)); } while (0)
#define PG8_LDA(dst, b, h) do { _Pragma("unroll") for (int m = 0; m < 4; ++m) _Pragma("unroll") for (int k = 0; k < 2; ++k) dst[m][k] = *(const PG8_LAS bf16x8*)(lds + PG8_SA(b, h) + aoff + m * 2048 + k * 1024); } while (0)
#define PG8_LDB(dst, b, h) do { _Pragma("unroll") for (int n = 0; n < 2; ++n) _Pragma("unroll") for (int k = 0; k < 2; ++k) dst[n][k] = *(const PG8_LAS bf16x8*)(lds + PG8_SB(b, h) + boff + n * 2048 + k * 1024); } while (0)
#define PG8_CAT(x) __builtin_shufflevector(__builtin_bit_cast(v4i_t, x[0]), __builtin_bit_cast(v4i_t, x[1]), 0, 1, 2, 3, 4, 5, 6, 7)
#define PG8_MMA(ai, bj, At, Bt) do { __builtin_amdgcn_s_setprio(1); _Pragma("unroll") for (int m = 0; m < 4; ++m) _Pragma("unroll") for (int n = 0; n < 2; ++n) { \
        if constexpr (F8) { acc[ai][bj][m][n] = __builtin_amdgcn_mfma_scale_f32_16x16x128_f8f6f4(PG8_CAT(Bt[n]), PG8_CAT(At[m]), acc[ai][bj][m][n], 0, 0, 0, 0, 0, 0); } \
        else { _Pragma("unroll") for (int k = 0; k < 2; ++k) acc[ai][bj][m][n] = __builtin_amdgcn_mfma_f32_16x16x32_bf16(Bt[n][k], At[m][k], acc[ai][bj][m][n], 0, 0, 0); } } \
        __builtin_amdgcn_s_setprio(0); } while (0)
#define PG8_WAIT_V(n) asm volatile("s_waitcnt vmcnt(" #n ")" ::: "memory")
#define PG8_WAIT_L(n) asm volatile("s_waitcnt lgkmcnt(" #n ")" ::: "memory")
#define PG8_BAR __builtin_amdgcn_s_barrier()
#define PG8_SCHED __builtin_amdgcn_sched_barrier(0)
    Unit cur, nxt; int ui = 0;
    if (!S.next(0, cur)) return;
    f32x4 acc[2][2][4][2];
#pragma unroll
    for (int a = 0; a < 2; ++a)
#pragma unroll
        for (int b = 0; b < 2; ++b)
#pragma unroll
            for (int m = 0; m < 4; ++m)
#pragma unroll
                for (int n = 0; n < 2; ++n) acc[a][b][m][n] = (f32x4){0.f, 0.f, 0.f, 0.f};
    bf16x8 At[4][2], B0[2][2], B1[2][2];
    const char* const A0 = (const char*)g.A; const char* cB = (const char*)g.Bt + S.bbase(cur, tstep);

    S.a_ready(cur);
    if constexpr (SP2) {
        PG8_STAGE(PG8_SB(0, 0), cB, voffB); PG8_STAGE(PG8_SB(0, 1), cB + hstep, voffB); PG8_STAGE_A(PG8_SA(0, 0), A0, 0, cur, 0); PG8_STAGE_A(PG8_SA(0, 1), A0, 0, cur, 1);
        if (wr == 1) PG8_BAR;
        PG8_WAIT_V(2); PG8_BAR;
        PG8_STAGE(PG8_SB(1, 0), cB + kstep, voffB); PG8_STAGE_A(PG8_SA(1, 0), A0 + kstep, 0, cur, 0); PG8_STAGE(PG8_SB(1, 1), cB + hstep + kstep, voffB);
        PG8_WAIT_V(6); PG8_BAR;
    } else {
        PG8_STAGE(PG8_SB(0, 0), cB, voffB); PG8_STAGE_A(PG8_SA(0, 0), A0, 0, cur, 0); PG8_STAGE(PG8_SB(0, 1), cB + hstep, voffB); PG8_STAGE_A(PG8_SA(0, 1), A0, 0, cur, 1);
        if (wr == 1) PG8_BAR;
        PG8_WAIT_V(4); PG8_BAR;
        PG8_STAGE(PG8_SB(1, 0), cB + kstep, voffB); PG8_STAGE_A(PG8_SA(1, 0), A0 + kstep, 0, cur, 0); PG8_STAGE(PG8_SB(1, 1), cB + hstep + kstep, voffB);
        PG8_WAIT_V(6); PG8_BAR;
    }
    for (;;) {
        const bool has_next = S.next(ui + 1, nxt);
        const char* nB = has_next ? (const char*)g.Bt + S.bbase(nxt, tstep) : cB;
        if (!has_next) nxt = cur;
        const int nui = has_next ? ui + 1 : ui;
#pragma unroll 1
        for (int t = 0; t < nt; t += 2) {
            const bool last = (t == nt - 2);
            const char* a1 = A0 + (size_t)(t + 1) * kstep;
            const char* a2 = last ? A0 : A0 + (size_t)(t + 2) * kstep; const char* b2 = last ? nB : cB + (size_t)(t + 2) * kstep;
            const int lui = last ? nui : ui; Unit lu; lu.pm = last ? nxt.pm : cur.pm; lu.pn = last ? nxt.pn : cur.pn; lu.e = last ? nxt.e : cur.e;
            const char* a3 = a2 + kstep; const char* b3 = b2 + kstep;
            if (last && has_next) S.a_ready(nxt);
            if constexpr (SP2) {
            PG8_LDB(B0, 0, 0); PG8_LDB(B1, 0, 1); PG8_SCHED; PG8_LDA(At, 0, 0); PG8_STAGE_A(PG8_SA(1, 1), a1, ui, cur, 1);
            PG8_WAIT_V(8); PG8_WAIT_L(0); PG8_BAR; PG8_MMA(0, 0, At, B0); PG8_MMA(0, 1, At, B1); PG8_BAR; PG8_SCHED;
            PG8_LDA(At, 0, 1); PG8_STAGE(PG8_SB(0, 0), b2, voffB); PG8_STAGE(PG8_SB(0, 1), b2 + hstep, voffB); PG8_STAGE_A(PG8_SA(0, 0), a2, lui, lu, 0);
            PG8_WAIT_V(8); PG8_WAIT_L(0); PG8_BAR; PG8_MMA(1, 0, At, B0); PG8_MMA(1, 1, At, B1); PG8_BAR; PG8_SCHED;
            PG8_LDB(B0, 1, 0); PG8_LDB(B1, 1, 1); PG8_SCHED; PG8_LDA(At, 1, 0); PG8_STAGE_A(PG8_SA(0, 1), a2, lui, lu, 1);
            PG8_WAIT_V(8); PG8_WAIT_L(0); PG8_BAR; PG8_MMA(0, 0, At, B0); PG8_MMA(0, 1, At, B1); PG8_BAR; PG8_SCHED;
            PG8_LDA(At, 1, 1); PG8_STAGE(PG8_SB(1, 0), b3, voffB); PG8_STAGE(PG8_SB(1, 1), b3 + hstep, voffB); PG8_STAGE_A(PG8_SA(1, 0), a3, lui, lu, 0);
            PG8_WAIT_V(8); PG8_WAIT_L(0); PG8_BAR; PG8_MMA(1, 0, At, B0); PG8_MMA(1, 1, At, B1); PG8_BAR; PG8_SCHED;
            } else {
            PG8_LDB(B0, 0, 0); PG8_SCHED; PG8_LDA(At, 0, 0); PG8_STAGE_A(PG8_SA(1, 1), a1, ui, cur, 1);
            PG8_WAIT_L(8); PG8_BAR; PG8_WAIT_L(0); PG8_MMA(0, 0, At, B0); PG8_BAR; PG8_SCHED;
            PG8_LDB(B1, 0, 1); PG8_STAGE(PG8_SB(0, 0), b2, voffB);
            PG8_BAR; PG8_WAIT_L(0); PG8_MMA(0, 1, At, B1); PG8_BAR;
            PG8_LDA(At, 0, 1); PG8_STAGE_A(PG8_SA(0, 0), a2, lui, lu, 0);
            PG8_BAR; PG8_WAIT_L(0); PG8_MMA(1, 0, At, B0); PG8_BAR; PG8_SCHED;
            PG8_STAGE(PG8_SB(0, 1), b2 + hstep, voffB);
            PG8_WAIT_V(6); PG8_BAR; PG8_MMA(1, 1, At, B1); PG8_BAR;
            PG8_LDB(B0, 1, 0); PG8_SCHED; PG8_LDA(At, 1, 0); PG8_STAGE_A(PG8_SA(0, 1), a2, lui, lu, 1);
            PG8_WAIT_L(8); PG8_BAR; PG8_WAIT_L(0); PG8_MMA(0, 0, At, B0); PG8_BAR; PG8_SCHED;
            PG8_LDB(B1, 1, 1); PG8_STAGE(PG8_SB(1, 0), b3, voffB);
            PG8_BAR; PG8_WAIT_L(0); PG8_MMA(0, 1, At, B1); PG8_BAR;
            PG8_LDA(At, 1, 1); PG8_STAGE_A(PG8_SA(1, 0), a3, lui, lu, 0);
            PG8_BAR; PG8_WAIT_L(0); PG8_MMA(1, 0, At, B0); PG8_BAR; PG8_SCHED;
            PG8_STAGE(PG8_SB(1, 1), b3 + hstep, voffB);
            PG8_WAIT_V(6); PG8_BAR; PG8_MMA(1, 1, At, B1); PG8_BAR;
            }
        }
        if constexpr (ALIGN_EPI) { if (wr == 0) PG8_BAR; }
        if constexpr (!Epi::AFTER_DRAIN) { E(acc, cur, wr, wc, fr, fq); S.done(cur); }
        if (!has_next) break;
#pragma unroll
        for (int a = 0; a < 2; ++a)
#pragma unroll
            for (int b = 0; b < 2; ++b)
#pragma unroll
                for (int m = 0; m < 4; ++m)
#pragma unroll
                    for (int n = 0; n < 2; ++n) acc[a][b][m][n] = (f32x4){0.f, 0.f, 0.f, 0.f};
        cur = nxt; cB = nB; ++ui;
        if constexpr (ALIGN_EPI) { if (wr == 1) PG8_BAR; }
    }
    PG8_WAIT_V(0);
    if constexpr (!ALIGN_EPI) { if (wr == 0) PG8_BAR; }
    PG8_BAR;
    if constexpr (Epi::AFTER_DRAIN) { E.fused(acc, cur, wr, wc, fr, fq, lds, wid, lane); S.done(cur); }
#undef PG8_STAGE_A
#undef PG8_SA
#undef PG8_SB
#undef PG8_STAGE
#undef PG8_LDA
#undef PG8_LDB
#undef PG8_MMA
#undef PG8_CAT
#undef PG8_WAIT_V
#undef PG8_WAIT_L
#undef PG8_BAR
#undef PG8_SCHED
}
}

constexpr size_t MiB = 1u << 20;
constexpr size_t WS_CTL = 0, CTL_ZERO_BYTES = 1 * MiB;
constexpr size_t WS_MODP = 1 * MiB;
constexpr size_t WS_MODF = 3 * MiB;
constexpr size_t WS_BIAS = 4 * MiB;
constexpr size_t WS_TOKE = 5 * MiB;
constexpr size_t WS_TOKP = 6 * MiB;
constexpr size_t WS_CNTC = 5 * MiB + 512 * 1024;
constexpr size_t WS_TOKW = 7 * MiB;
constexpr size_t WS_INV = 8 * MiB;
constexpr size_t WS_WIN = 10 * MiB;
constexpr size_t WS_WOUT = 15 * MiB;
constexpr size_t WS_X1 = 32 * MiB;
constexpr size_t WS_XN = 96 * MiB;
constexpr size_t WS_H2 = 128 * MiB;
constexpr size_t WS_PROJ = 160 * MiB;
constexpr size_t WS_O = 232 * MiB;
constexpr size_t WS_WGU = 264 * MiB;
constexpr size_t WS_WD = 392 * MiB;
constexpr size_t WS_ACT = 456 * MiB;
constexpr size_t WS_Y = 600 * MiB;
constexpr size_t WS_END = 744 * MiB;
constexpr int CW_TMO = 0, CW_CODE = 1;
constexpr int CW_CNT = 64;
constexpr int CW_BAR = 4096;
constexpr int CW_KSUM = 16384;
static_assert((CW_KSUM + 64 * 512) * 4 <= (int)CTL_ZERO_BYTES, "CTL region");
constexpr int RING_OFF = 0, RING_BYTES = 131072;
constexpr int LDSCTL_OFF = RING_BYTES, MISC_OFF = LDSCTL_OFF + 320;
constexpr int LDS_TILE_E = LDSCTL_OFF + 512;
constexpr int LDS_NT = LDS_TILE_E + MAXTILES * 4;
constexpr int LDS_TBASE = LDS_NT + 16;
constexpr int LDS_CNTE = LDS_TBASE + 128;
constexpr int LDS_RIDX = LDS_CNTE + 128;
constexpr int LDS_BYTES = 147456;
static_assert(LDS_RIDX % 16 == 0 && LDS_RIDX + 10 * 1024 <= LDS_BYTES, "LDS map");
constexpr int NWAVES = 8;

#define GAS __attribute__((address_space(1)))
#define LAS __attribute__((address_space(3)))
typedef unsigned short bf16;
typedef unsigned v4u __attribute__((ext_vector_type(4)));
typedef float f32x4 __attribute__((ext_vector_type(4)));
typedef short bf16x8 __attribute__((ext_vector_type(8)));
typedef GAS unsigned gu32;
typedef GAS unsigned long long gu64;
#define RLX_AGENT __ATOMIC_RELAXED, __HIP_MEMORY_SCOPE_AGENT
#define LDS_WAIT() asm volatile("s_waitcnt lgkmcnt(0)" ::: "memory")
#define VM_WAIT() asm volatile("s_waitcnt vmcnt(0)" ::: "memory")
__device__ __forceinline__ unsigned long long rt() { return __builtin_amdgcn_s_memrealtime(); }
__device__ __forceinline__ unsigned f2bf(float f) { unsigned u = __builtin_bit_cast(unsigned, f); return (u + 0x7fffu + ((u >> 16) & 1u)) >> 16; }
__device__ __forceinline__ unsigned pk2(float lo, float hi) { return f2bf(lo) | (f2bf(hi) << 16); }

#define XB_TMO      128
#define XB_XCNT(j)  (256  + 64 * (j))
#define XB_XSUB(j)  (1280 + 64 * (j))
#define XB_XGEN(j)  (2304 + 64 * (j))
#define XB_TOP      3328
#define XB_TOPGEN   3392
#define XCD_BAR_WORDS 3456
#define XB_SPIN_CAP (1u << 18)

__device__ __forceinline__ unsigned xb_ld(unsigned* p)              { return __hip_atomic_load(p, __ATOMIC_RELAXED, __HIP_MEMORY_SCOPE_AGENT); }
__device__ __forceinline__ unsigned xb_add(unsigned* p, unsigned v) { return __hip_atomic_fetch_add(p, v, __ATOMIC_RELAXED, __HIP_MEMORY_SCOPE_AGENT); }
__device__ __forceinline__ unsigned xb_xcc_id() { return (unsigned)__builtin_amdgcn_s_getreg((3 << 11) | 20) & 0xFu; }
#define XB_SPIN(cond, bar) do { unsigned _sp = 0; while (cond) { __builtin_amdgcn_s_sleep(1); \
    if ((++_sp & 255u) == 0u) { if (xb_ld(&(bar)[XB_TMO])) break; if (_sp > XB_SPIN_CAP) { atomicAdd(&(bar)[XB_TMO], 1u); break; } } } } while (0)

struct XcdBarrier {
    unsigned* bar; unsigned x;
    volatile LAS unsigned* st;
};

__device__ __forceinline__ XcdBarrier xcd_barrier_post(unsigned* bar, volatile LAS unsigned* st) {
    XcdBarrier b; b.bar = bar; b.x = xb_xcc_id(); b.st = st;
    if (threadIdx.x == 0) (void)xb_add(&bar[XB_XCNT(b.x)], 1u);
    return b;
}
__device__ __forceinline__ void xcd_barrier_complete(unsigned* bar, unsigned x, unsigned& nloc, unsigned& nx) {
    const unsigned G = gridDim.x * gridDim.y * gridDim.z;
    unsigned sum, cnt, mine, sp = 0u;
    for (;;) {
        sum = 0u; cnt = 0u; mine = 0u;
#pragma unroll
        for (unsigned j = 0; j < 16; ++j) { const unsigned c = xb_ld(&bar[XB_XCNT(j)]); sum += c; cnt += (c > 0u) ? 1u : 0u; mine = (j == x) ? c : mine; }
        if (sum == G) break;
        __builtin_amdgcn_s_sleep(1);
        if ((++sp & 255u) == 0u) { if (xb_ld(&bar[XB_TMO])) break; if (sp > XB_SPIN_CAP) { atomicAdd(&bar[XB_TMO], 1u); break; } }
    }
    nloc = mine > 0u ? mine : 1u; nx = cnt > 0u ? cnt : 1u;
}

__device__ __forceinline__ void xcd_barrier(const XcdBarrier& b) {
    asm volatile("s_waitcnt vmcnt(0)" ::: "memory");
    __syncthreads();
    if (threadIdx.x == 0) {
        unsigned* bar = b.bar;
        __builtin_amdgcn_s_waitcnt(0);
        unsigned nloc = b.st[0], nx = b.st[1];
        if (nloc == 0u) { xcd_barrier_complete(bar, b.x, nloc, nx); b.st[0] = nloc; b.st[1] = nx; }
        const unsigned old = xb_add(&bar[XB_XSUB(b.x)], 1u);
        const unsigned gen = old / nloc;
        if (old + 1u == (gen + 1u) * nloc) {
            __builtin_amdgcn_fence(__ATOMIC_RELEASE, "agent");
            asm volatile("s_waitcnt vmcnt(0)" ::: "memory");
            const unsigned og = xb_add(&bar[XB_TOP], 1u);
            const unsigned tg = og / nx;
            if (og + 1u == (tg + 1u) * nx) xb_add(&bar[XB_TOPGEN], 1u);
            else XB_SPIN(xb_ld(&bar[XB_TOPGEN]) == tg, bar);
            __builtin_amdgcn_fence(__ATOMIC_ACQUIRE, "agent");
            xb_add(&bar[XB_XGEN(b.x)], 1u);
            asm volatile("s_waitcnt vmcnt(0)" ::: "memory");
        } else {
            XB_SPIN(xb_ld(&bar[XB_XGEN(b.x)]) == gen, bar);
            __builtin_amdgcn_fence(__ATOMIC_ACQUIRE, "agent");
            asm volatile("s_waitcnt vmcnt(0)" ::: "memory");
        }
    }
    __syncthreads();
}

namespace att {
using bf16x8 = __attribute__((ext_vector_type(8))) short;
using s16x4 = __attribute__((ext_vector_type(4))) short;
using f32x16 = __attribute__((ext_vector_type(16))) float;
using u32x4 = __attribute__((ext_vector_type(4))) unsigned;
typedef unsigned short bf16;
constexpr int PITCH = D_IN, OPITCH = D;
constexpr int NSLOT = 4, SLOTB = 8192;
constexpr int TAB_PAD = 96;
constexpr int LDS_K = 0, LDS_V = NSLOT * SLOTB, LDS_WS = 2 * NSLOT * SLOTB, LDS_OST = LDS_WS + 8 * 64 * 4, LDS_TAB = LDS_OST + 8 * 4096, LDS_KMS = LDS_TAB + (TAB_PAD + SEQ) * 4, LDS_NINF = LDS_KMS + 8 * 64 * 4, LDS_END = LDS_NINF + 64 * 4;
static_assert(LDS_END <= 131072, "attention LDS");
__device__ __forceinline__ int crow(int r, int hi) { return (r & 3) + 8 * (r >> 2) + 4 * hi; }
__device__ __forceinline__ void glds16(const void* gsrc, unsigned lds_dst) { unsigned keep;
  asm volatile("s_mov_b32 %0, m0\n\ts_mov_b32 m0, %2\n\ts_nop 0\n\tglobal_load_lds_dwordx4 %1, off\n\ts_mov_b32 m0, %0" : "=&s"(keep) : "v"(gsrc), "s"(lds_dst) : "memory"); }
typedef float f32x2_t __attribute__((ext_vector_type(2))); typedef __bf16 bf16x2_t __attribute__((ext_vector_type(2)));
__device__ __forceinline__ unsigned cvtpk_s(float lo, float hi) { f32x2_t v = {lo, hi}; bf16x2_t b = __builtin_convertvector(v, bf16x2_t); return __builtin_bit_cast(unsigned, b); }
#define ATT_WAIT_BAR(N) asm volatile("s_waitcnt vmcnt(" #N ") lgkmcnt(0)\n\ts_barrier" ::: "memory")
#define ATT_LBAR() asm volatile("s_waitcnt lgkmcnt(0)\n\ts_barrier" ::: "memory")
typedef float f32x2v __attribute__((ext_vector_type(2)));
__device__ __forceinline__ void bias_loads(f32x2v (&bb)[16], unsigned tba) {
#pragma unroll
  for (int i = 0; i < 16; ++i) { asm volatile("ds_read2_b32 %0, %1 offset0:%c2 offset1:%c3" : "=v"(bb[i]) : "v"(tba), "i"((i >> 3) * 32 + ((2 * i) & 3) + 8 * (((2 * i) & 15) >> 2)), "i"((i >> 3) * 32 + ((2 * i) & 3) + 8 * (((2 * i) & 15) >> 2) + 1) : "memory"); }
}
__device__ __forceinline__ void k_loads(bf16x8 (&kf)[8], unsigned ka) {
#pragma unroll
  for (int i = 0; i < 8; ++i) asm volatile("ds_read_b128 %0, %1 offset:%c2" : "=v"(kf[i]) : "v"(ka), "i"((i >> 1) * 2048 + (i & 1) * 512) : "memory");
}
#define ATT_C16(bb, o) (f32x16){bb[o][0], bb[o][1], bb[o + 1][0], bb[o + 1][1], bb[o + 2][0], bb[o + 2][1], bb[o + 3][0], bb[o + 3][1], bb[o + 4][0], bb[o + 4][1], bb[o + 5][0], bb[o + 5][1], bb[o + 6][0], bb[o + 6][1], bb[o + 7][0], bb[o + 7][1]}
__device__ __forceinline__ void qk_mma(f32x16& p0, f32x16& p1, const bf16x8 (&kf)[8], const bf16x8* qr, const f32x2v (&bb)[16]) {
  p0 = __builtin_amdgcn_mfma_f32_32x32x16_bf16(kf[0], qr[0], ATT_C16(bb, 0), 0, 0, 0); p1 = __builtin_amdgcn_mfma_f32_32x32x16_bf16(kf[1], qr[0], ATT_C16(bb, 8), 0, 0, 0);
#pragma unroll
  for (int d0 = 1; d0 < 4; ++d0) { p0 = __builtin_amdgcn_mfma_f32_32x32x16_bf16(kf[2 * d0], qr[d0], p0, 0, 0, 0); p1 = __builtin_amdgcn_mfma_f32_32x32x16_bf16(kf[2 * d0 + 1], qr[d0], p1, 0, 0, 0); }
}
__device__ __forceinline__ void v_loads(s16x4 (&lo)[2][4], s16x4 (&hi)[2][4], int vb) {
#pragma unroll
  for (int d0 = 0; d0 < 2; ++d0)
#pragma unroll
    for (int ks = 0; ks < 4; ++ks) {
      asm volatile("ds_read_b64_tr_b16 %0,%1 offset:%c2" : "=&v"(lo[d0][ks]) : "v"(vb), "i"(d0 * 4096 + ks * 1024) : "memory");
      asm volatile("ds_read_b64_tr_b16 %0,%1 offset:%c2" : "=&v"(hi[d0][ks]) : "v"(vb), "i"(d0 * 4096 + ks * 1024 + 512) : "memory"); }
}
__device__ __forceinline__ void pv_mma(f32x16* o, const s16x4 (&lo)[2][4], const s16x4 (&hi)[2][4], bf16x8 pa0, bf16x8 pa1, bf16x8 pa2, bf16x8 pa3) {
#define ATT_PK(d, k) (bf16x8){lo[d][k][0], lo[d][k][1], lo[d][k][2], lo[d][k][3], hi[d][k][0], hi[d][k][1], hi[d][k][2], hi[d][k][3]}
#pragma unroll
  for (int d0 = 0; d0 < 2; ++d0) {
    o[d0] = __builtin_amdgcn_mfma_f32_32x32x16_bf16(pa0, ATT_PK(d0, 0), o[d0], 0, 0, 0);
    o[d0] = __builtin_amdgcn_mfma_f32_32x32x16_bf16(pa1, ATT_PK(d0, 1), o[d0], 0, 0, 0);
    o[d0] = __builtin_amdgcn_mfma_f32_32x32x16_bf16(pa2, ATT_PK(d0, 2), o[d0], 0, 0, 0);
    o[d0] = __builtin_amdgcn_mfma_f32_32x32x16_bf16(pa3, ATT_PK(d0, 3), o[d0], 0, 0, 0);
  }
#undef ATT_PK
}
#define ATT_LWAIT(N) do { asm volatile("s_waitcnt lgkmcnt(" #N ")" ::: "memory"); __builtin_amdgcn_sched_barrier(0); } while (0)
struct UnitDesc { int b, qb, moba, qcol, kcol, vcol, ocol, head, fill, fillk, gqa, q0; float sink2; };

__device__ __forceinline__ void attn_unit(const UnitDesc& u, const bf16* P, unsigned char* O, const float* biasT, const float* ksum, const float* sinks, char* shm) {
  int tid_ = threadIdx.x; asm volatile("" : "+v"(tid_));
  const int tid = tid_, lane = tid & 63, r32 = lane & 31, hi = lane >> 5; const int wid = __builtin_amdgcn_readfirstlane(tid >> 6);
  const long rowbase = (long)u.b * SEQ; const int q0 = u.q0;
  const int wg = u.gqa ? (wid & 3) : 0, wrow = u.gqa ? (wid >> 2) * 32 : wid * 32;
  constexpr int TSW = TAB_PAD + 192;
  const unsigned lds0 = (unsigned)(uintptr_t)shm;
  float* wsf = (float*)(shm + LDS_WS) + wid * 64;
  float* tab = (float*)(shm + LDS_TAB); float* kms = (float*)(shm + LDS_KMS);
  const int tlo = u.moba ? 0 : (q0 < 128 ? 0 : (q0 >> 6) - 2), thi = u.gqa ? (q0 >> 6) : u.qb * 4 + 3;
  const bf16* ksrc = P + (rowbase + lane) * PITCH + u.kcol + wid * 8;
  const bf16* vsrc = P + (rowbase + 16 * (wid & 3) + (lane >> 2)) * PITCH + u.vcol + (wid >> 2) * 32 + (lane & 3) * 8;
  const unsigned kdst = lds0 + LDS_K + wid * 1024, vdst = lds0 + LDS_V + wid * 1024;
#define ATT_DMA(t, slot) do { glds16(ksrc + (long)(t) * 64 * PITCH, (unsigned)__builtin_amdgcn_readfirstlane(kdst + (slot))); glds16(vsrc + (long)(t) * 64 * PITCH, (unsigned)__builtin_amdgcn_readfirstlane(vdst + (slot))); } while (0)
  const unsigned ka0 = lds0 + LDS_K + hi * 1024 + r32 * 16;
  const int vb0 = (int)(lds0 + LDS_V) + ((lane >> 4) & 1) * 32 + (lane & 3) * 8 + (4 * hi + ((lane & 15) >> 2)) * 64;
  ATT_DMA(tlo, 0); ATT_DMA(tlo + 1, SLOTB);
  if (u.fill) {
    if (u.gqa) { for (int i = tid; i < 4 * TSW; i += 512) { const int hh = i / TSW, j = i - hh * TSW; tab[i] = (j >= 192) ? 0.f : biasT[(u.head + hh) * SEQ + 191 - j]; } }
    else for (int i = tid; i < TAB_PAD + SEQ; i += 512) tab[i] = (i >= SEQ) ? 0.f : biasT[u.head * SEQ + SEQ - 1 - i];
    if (tid < 64) ((float*)(shm + LDS_NINF))[tid] = -INFINITY;
  }
  if (u.fillk) kms[tid] = ksum[(size_t)(u.b * 8 + (tid >> 6)) * D_MOBA + u.head * HD + (tid & 63)];
  const bf16* Qw = P + (rowbase + q0 + wrow) * PITCH + u.qcol + wg * HD;
  bf16x8 qr[4];
#pragma unroll
  for (int d0 = 0; d0 < 4; ++d0) qr[d0] = *reinterpret_cast<const bf16x8*>(&Qw[(long)r32 * PITCH + d0 * 16 + hi * 8]);
  if (u.fill || u.fillk) ATT_LBAR();
  unsigned selmask = 0u;
  if (u.moba) {
    if (u.qb <= MB_TOPK) selmask = (1u << u.qb) - 1u;
    else {
      float gate[MB_NB - 1];
#pragma unroll
      for (int n = 0; n < MB_NB - 1; ++n) { float s = 0.f;
        if (n < u.qb) {
#pragma unroll
          for (int d0 = 0; d0 < 4; ++d0)
#pragma unroll
            for (int j = 0; j < 8; ++j) s += __uint_as_float((unsigned)(unsigned short)qr[d0][j] << 16) * kms[n * 64 + d0 * 16 + hi * 8 + j];
          s += __shfl_xor(s, 32); }
        gate[n] = s; }
#pragma unroll
      for (int r = 0; r < MB_TOPK; ++r) { int best = -1; float bv = 0.f;
#pragma unroll
        for (int n = 0; n < MB_NB - 1; ++n) if (n < u.qb && !((selmask >> n) & 1u) && (best < 0 || gate[n] > bv)) { best = n; bv = gate[n]; }
        selmask |= 1u << best; }
    }
  }
  const int qrel = wrow + r32, qpos = q0 + qrel;
  const unsigned tabqa = lds0 + LDS_TAB + (unsigned)((wg * TSW + (u.gqa ? 191 : SEQ - 1) - qpos + 4 * hi) * 4), ninfa = lds0 + LDS_NINF;
  float m = -1e30f, l = 0.f; f32x16 o[2]; o[0] = f32x16{}; o[1] = f32x16{};
  const int wq0 = q0 + wrow;
#define ATT_FLAGS(tt, need_, emask_, lsel_) do { lsel_ = true; \
    if (u.moba) { const int n_ = (tt) >> 2; \
      if (n_ < u.qb) { lsel_ = ((selmask >> n_) & 1u) != 0u; need_ = __any(lsel_); emask_ = false; } \
      else { need_ = (64 * (tt) <= wq0 + 31); emask_ = (64 * (tt) + 63 > wq0); } } \
    else { need_ = (64 * (tt) <= wq0 + 31) && (64 * (tt) + 63 >= wq0 - (SWA_W - 1)); emask_ = (64 * (tt) + 63 > wq0) || (wq0 + 31 - 64 * (tt) >= SWA_W); } } while (0)
#define ATT_QK_LOADS(tt, kslot, lsel_) do { bias_loads(bb, (lsel_) ? tabqa + 256u * (unsigned)(tt) : ninfa); k_loads(kf, ka0 + (kslot)); } while (0)
  const int lim = u.moba ? 0x7fffffff : SWA_W;
  int slotp = 3 * SLOTB, slot = 0, slotn = SLOTB, slotf = 2 * SLOTB;
  f32x16 pc0 = {}, pc1 = {}, pn0 = {}, pn1 = {};
  u32x4 pw0 = {}, pw1 = {}, pw2 = {}, pw3 = {};
  bool needC, emaskC, lselC, needN = false, emaskN = false, lselN = true, needP = false;
  asm volatile("" :: "v"(qr[0]), "v"(qr[1]), "v"(qr[2]), "v"(qr[3]));
  ATT_WAIT_BAR(2);
  ATT_FLAGS(tlo, needC, emaskC, lselC);
  if (needC) { f32x2v bb[16]; bf16x8 kf[8]; ATT_QK_LOADS(tlo, slot, lselC); ATT_LWAIT(0); qk_mma(pc0, pc1, kf, qr, bb); }
  for (int t = tlo; t <= thi; ++t) {
    ATT_WAIT_BAR(0);
    if (t + 2 <= thi) ATT_DMA(t + 2, slotf);
    if (t + 1 <= thi) { ATT_FLAGS(t + 1, needN, emaskN, lselN); } else needN = false;
    if (needN) { f32x2v bb[16]; bf16x8 kf[8]; ATT_QK_LOADS(t + 1, slotn, lselN); ATT_LWAIT(0); qk_mma(pn0, pn1, kf, qr, bb); }
    if (needP) { s16x4 vlo[2][4], vhi[2][4]; v_loads(vlo, vhi, vb0 + slotp); ATT_LWAIT(0); pv_mma(o, vlo, vhi, __builtin_bit_cast(bf16x8, pw0), __builtin_bit_cast(bf16x8, pw1), __builtin_bit_cast(bf16x8, pw2), __builtin_bit_cast(bf16x8, pw3)); }
    __builtin_amdgcn_sched_barrier(0);
    if (needC) {
      f32x16 p0 = pc0, p1 = pc1;
      if (emaskC) { const int dq = qpos - 64 * t - 4 * hi;
#pragma unroll
        for (int r = 0; r < 16; ++r) { const int c = (r & 3) + 8 * (r >> 2);
          p0[r] = ((unsigned)(dq - c) < (unsigned)lim) ? p0[r] : -INFINITY; p1[r] = ((unsigned)(dq - c - 32) < (unsigned)lim) ? p1[r] : -INFINITY; } }
      float rm = fmaxf(p0[0], p1[0]);
#pragma unroll
      for (int r = 1; r < 16; ++r) rm = fmaxf(fmaxf(rm, p0[r]), p1[r]);
      rm = fmaxf(rm, __shfl_xor(rm, 32));
      if (__any(rm > m + 8.0f)) {
        const float mnew = fmaxf(m, rm), alpha = __builtin_amdgcn_exp2f(m - mnew);
        l *= alpha; m = mnew;
        if (hi == 0) wsf[r32] = alpha;
        asm volatile("s_waitcnt lgkmcnt(0)" ::: "memory");
#pragma unroll
        for (int r = 0; r < 16; ++r) { const float f = wsf[crow(r, hi)]; o[0][r] *= f; o[1][r] *= f; }
      }
      float ls = 0.f;
#pragma unroll
      for (int r = 0; r < 16; ++r) { p0[r] = __builtin_amdgcn_exp2f(p0[r] - m); p1[r] = __builtin_amdgcn_exp2f(p1[r] - m); ls += p0[r] + p1[r]; }
      l += ls;
#define ATT_PKW(Pv, B) cvtpk_s(Pv[B], Pv[B + 1])
      pw0 = (u32x4){ATT_PKW(p0, 0), ATT_PKW(p0, 2), ATT_PKW(p0, 4), ATT_PKW(p0, 6)}; pw1 = (u32x4){ATT_PKW(p0, 8), ATT_PKW(p0, 10), ATT_PKW(p0, 12), ATT_PKW(p0, 14)};
      pw2 = (u32x4){ATT_PKW(p1, 0), ATT_PKW(p1, 2), ATT_PKW(p1, 4), ATT_PKW(p1, 6)}; pw3 = (u32x4){ATT_PKW(p1, 8), ATT_PKW(p1, 10), ATT_PKW(p1, 12), ATT_PKW(p1, 14)};
#undef ATT_PKW
    }
    needP = needC; pc0 = pn0; pc1 = pn1; needC = needN; emaskC = emaskN; lselC = lselN;
    { const int s_ = slotp; slotp = slot; slot = slotn; slotn = slotf; slotf = s_; }
  }
  if (needP) { s16x4 vlo[2][4], vhi[2][4]; v_loads(vlo, vhi, vb0 + slotp); ATT_LWAIT(0); pv_mma(o, vlo, vhi, __builtin_bit_cast(bf16x8, pw0), __builtin_bit_cast(bf16x8, pw1), __builtin_bit_cast(bf16x8, pw2), __builtin_bit_cast(bf16x8, pw3)); }
#undef ATT_FLAGS
#undef ATT_QK_LOADS
  l += __shfl_xor(l, 32);
  if (!u.moba) l += __builtin_amdgcn_exp2f((u.gqa ? sinks[u.head - NH_M + wg] * LOG2E : u.sink2) - m);
  if (hi == 0) wsf[32 + r32] = l;
  asm volatile("s_waitcnt lgkmcnt(0)" ::: "memory");
  float rli[16];
#pragma unroll
  for (int r = 0; r < 16; ++r) rli[r] = __builtin_amdgcn_rcpf(wsf[32 + crow(r, hi)]);
  unsigned char* Ow = O + (rowbase + q0 + wrow) * OPITCH + u.ocol + wg * HD;
  { unsigned char* stg = (unsigned char*)(shm + LDS_OST) + wid * 2048;
#pragma unroll
    for (int r = 0; r < 16; ++r) { const int orow = crow(r, hi); const float sc = rli[r] * OSCALE;
#pragma unroll
      for (int d0 = 0; d0 < 2; ++d0) { const float v = o[d0][r] * sc; stg[orow * 64 + d0 * 32 + r32] = (unsigned char)(__builtin_amdgcn_cvt_pk_fp8_f32(v, v, 0, false) & 0xff); } }
    asm volatile("s_waitcnt lgkmcnt(0)" ::: "memory");
#pragma unroll
    for (int i = 0; i < 2; ++i) { const int row = i * 16 + (lane >> 2), ch = lane & 3; const u32x4 v = *(const u32x4*)(stg + row * 64 + ch * 16); *(u32x4*)(Ow + (long)row * OPITCH + ch * 16) = v; } }
  ATT_LBAR();
#undef ATT_DMA
}
}

struct Frame {
    LAS unsigned char* lds;
    volatile LAS unsigned* MISC;
    gu32* ctl;
    int tid, lane, wave, vcu, G;
};
__device__ __forceinline__ float wave_sum(float v) {
#pragma unroll
    for (int o = 1; o < 64; o <<= 1) v += __shfl_xor(v, o);
    return v;
}
__device__ __forceinline__ int rel_bucket(int dist) {
    const int n = dist > 0 ? dist : 0;
    if (n < 16) return n;
    const int th[15] = {21, 27, 35, 46, 59, 77, 99, 128, 166, 216, 280, 363, 470, 609, 790};
    int bk = 16;
#pragma unroll
    for (int i = 0; i < 15; ++i) bk += (n >= th[i]) ? 1 : 0;
    return bk;
}
__device__ __forceinline__ void p0_transpose_item(const float* W, int K, int N, bf16* WT, int k0, int n0, int dst_row0, LAS float* scr, int lane) {
    { float v[32]; const float* wp = W + (size_t)(k0 + (lane >> 5)) * N + n0 + (lane & 31);
#pragma unroll
        for (int i = 0; i < 32; ++i) v[i] = __builtin_nontemporal_load(wp + (size_t)(2 * i) * N);
#pragma unroll
        for (int i = 0; i < 32; ++i) scr[(2 * i + (lane >> 5)) * 33 + (lane & 31)] = v[i]; }
    LDS_WAIT(); asm volatile("" ::: "memory");
    const int c = lane & 7;
#pragma unroll
    for (int j = 0; j < 4; ++j) { const int n = (lane >> 3) + 8 * j; const LAS float* s = scr + (8 * c) * 33 + n;
        v4u o; o.x = pk2(s[0 * 33], s[1 * 33]); o.y = pk2(s[2 * 33], s[3 * 33]); o.z = pk2(s[4 * 33], s[5 * 33]); o.w = pk2(s[6 * 33], s[7 * 33]);
        *(GAS v4u*)(WT + (size_t)(dst_row0 + n) * K + k0 + 8 * c) = o; }
    LDS_WAIT(); asm volatile("" ::: "memory");
}
__device__ __forceinline__ void p0_transpose_item_f8(const float* W, int K, int N, unsigned char* WT, int k0, int n0, int dst_row0, LAS float* scr, int lane) {
    v4u o[2][2];
    const int c = lane & 3;
#pragma unroll
    for (int hf = 0; hf < 2; ++hf) {
        { float v[32]; const float* wp = W + (size_t)(k0 + 64 * hf + (lane >> 5)) * N + n0 + (lane & 31);
#pragma unroll
            for (int i = 0; i < 32; ++i) v[i] = __builtin_nontemporal_load(wp + (size_t)(2 * i) * N);
#pragma unroll
            for (int i = 0; i < 32; ++i) scr[(2 * i + (lane >> 5)) * 33 + (lane & 31)] = v[i]; }
        LDS_WAIT(); asm volatile("" ::: "memory");
#pragma unroll
        for (int j = 0; j < 2; ++j) { const int n = (lane >> 2) + 16 * j; const LAS float* s = scr + (16 * c) * 33 + n;
            o[hf][j].x = pg8::pk4_f8(s[0 * 33] * WSCALE, s[1 * 33] * WSCALE, s[2 * 33] * WSCALE, s[3 * 33] * WSCALE); o[hf][j].y = pg8::pk4_f8(s[4 * 33] * WSCALE, s[5 * 33] * WSCALE, s[6 * 33] * WSCALE, s[7 * 33] * WSCALE);
            o[hf][j].z = pg8::pk4_f8(s[8 * 33] * WSCALE, s[9 * 33] * WSCALE, s[10 * 33] * WSCALE, s[11 * 33] * WSCALE); o[hf][j].w = pg8::pk4_f8(s[12 * 33] * WSCALE, s[13 * 33] * WSCALE, s[14 * 33] * WSCALE, s[15 * 33] * WSCALE); }
        LDS_WAIT(); asm volatile("" ::: "memory");
    }
#pragma unroll
    for (int j = 0; j < 2; ++j) { const int n = (lane >> 2) + 16 * j; unsigned char* rp = WT + (size_t)(dst_row0 + n) * K + k0 + 16 * c;
        *(GAS v4u*)(rp) = o[0][j]; *(GAS v4u*)(rp + 64) = o[1][j]; }
}
__device__ __forceinline__ void conv_load_half(f32x4 (&x)[16], const float* src, int N, int hf, int lane) {
    const int q = lane >> 4, m = lane & 15; const float* sp = src + (size_t)(hf * 64 + 4 * q) * N + 4 * m;
#pragma unroll
    for (int g = 0; g < 4; ++g)
#pragma unroll
        for (int i = 0; i < 4; ++i) x[g * 4 + i] = __builtin_nontemporal_load((const f32x4*)(sp + (size_t)(16 * g + i) * N));
}
__device__ __forceinline__ void conv_cvt_half(const f32x4 (&x)[16], LAS unsigned* t8, int hf, int lane) {
    const int q = lane >> 4, m = lane & 15;
#pragma unroll
    for (int g = 0; g < 4; ++g)
#pragma unroll
        for (int j = 0; j < 4; ++j) t8[(4 * m + j) * 33 + hf * 16 + 4 * g + q] = pg8::pk4_f8(x[g * 4 + 0][j] * WSCALE, x[g * 4 + 1][j] * WSCALE, x[g * 4 + 2][j] * WSCALE, x[g * 4 + 3][j] * WSCALE);
}
__device__ __forceinline__ void conv_store(unsigned char* dst, const LAS unsigned* t8, int lane) {
#pragma unroll
    for (int jj = 0; jj < 8; ++jj) { const int n = (lane >> 3) + 8 * jj, c = lane & 7; const LAS unsigned* rp = t8 + n * 33 + 4 * c;
        *(GAS v4u*)(dst + (size_t)n * 1024 + 16 * c) = (v4u){rp[0], rp[1], rp[2], rp[3]}; }
}
struct Args { const float* in[19]; float* out; unsigned char* ws; int ph_lo, ph_hi; };

__device__ __forceinline__ void p0_prologue(Frame& F, const Args& a) {
    LAS float* scr = (LAS float*)(F.lds + RING_OFF + F.wave * 16384);
    const int gw = F.vcu * NWAVES + F.wave, NGW = F.G * NWAVES;
    const float* w_in = a.in[5]; const float* w_out = a.in[7];
    bf16* Win_t = (bf16*)(a.ws + WS_WIN);
    constexpr int I_IN = 16 * (D_IN / 32), I_OUT = 8 * (D / 32), I_MOD = 96 * 8, I_BIAS = 16 * SEQ / 64;
    constexpr int NITEMS = I_IN + I_OUT + I_MOD + I_BIAS;
    for (int k = 0; k * NGW < NITEMS; ++k) {
        const int it = k * NGW + ((k & 1) ? NGW - 1 - gw : gw); if (it >= NITEMS) continue;
        int r = it;
        if (r < I_MOD) {
            const int cc = r % 96, ks = r / 96, j = cc * 64 + F.lane;
            const float* c = a.in[1]; const float* w_ada = a.in[3];
            { const int b = F.lane >> 3, kq = (F.lane & 7) * 16;
#pragma unroll
                for (int i = 0; i < 16; ++i) { const float cv = c[b * D + ks * 128 + kq + i]; scr[b * 128 + kq + i] = cv / (1.f + expf(-cv)); } }
            LDS_WAIT(); asm volatile("" ::: "memory");
            float acc[BATCH];
#pragma unroll
            for (int b = 0; b < BATCH; ++b) acc[b] = 0.f;
            const float* wp = w_ada + (size_t)(ks * 128) * (6 * D) + j;
#pragma unroll 1
            for (int k0 = 0; k0 < 128; k0 += 128) { float w[128];
#pragma unroll
                for (int i = 0; i < 128; ++i) w[i] = __builtin_nontemporal_load(wp + (size_t)(k0 + i) * (6 * D));
#pragma unroll
                for (int i = 0; i < 128; ++i)
#pragma unroll
                    for (int b = 0; b < BATCH; ++b) acc[b] += scr[b * 128 + k0 + i] * w[i]; }
            LDS_WAIT(); asm volatile("" ::: "memory");
            float* mp = (float*)(a.ws + WS_MODP) + (size_t)ks * BATCH * 6 * D;
#pragma unroll
            for (int b = 0; b < BATCH; ++b) mp[(size_t)b * 6 * D + j] = acc[b];
            continue;
        }
        r -= I_MOD;
        if (r < I_BIAS) { const int i = r * 64 + F.lane, h = i / SEQ, d = i % SEQ; ((float*)(a.ws + WS_BIAS))[i] = a.in[9][rel_bucket(d) * 16 + h] * LOG2E; continue; }
        r -= I_BIAS;
        if (r < I_IN) { const int nb = r % (D_IN / 32), kb = r / (D_IN / 32); p0_transpose_item(w_in, D, D_IN, Win_t, kb * 64, nb * 32, nb * 32, scr, F.lane); continue; }
        r -= I_IN;
        { const int nb = r % (D / 32), kb = r / (D / 32); p0_transpose_item_f8(w_out, D, D, a.ws + WS_WOUT, kb * 128, nb * 32, nb * 32, scr, F.lane); }
    }
}
constexpr int CV_GU = NE * 8 * (2 * DFF / 64), CV_DN = NE * 8 * (D / 64), CV_ITEMS = CV_GU + CV_DN;
struct ConvItem { const float* src; unsigned char* dst; int N; };
__device__ __forceinline__ ConvItem conv_addr(const Args& a, int r) {
    const float* w_gu = a.in[14]; const float* w_down = a.in[16]; unsigned char* Wgu_t = a.ws + WS_WGU; unsigned char* Wd_t = a.ws + WS_WD; ConvItem c;
    if (r < CV_GU) { const int per = 8 * (2 * DFF / 64), e = r / per, q = r % per, nb = q % (2 * DFF / 64), kb = q / (2 * DFF / 64), n0 = nb * 64;
        const int drow = (n0 < DFF) ? ((n0 >> 7) * 256 + (n0 & 127)) : (((n0 - DFF) >> 7) * 256 + 128 + ((n0 - DFF) & 127));
        c.src = w_gu + (size_t)e * D * 2 * DFF + (size_t)(kb * 128) * (2 * DFF) + n0; c.N = 2 * DFF; c.dst = Wgu_t + (size_t)e * 2 * DFF * D + (size_t)drow * D + kb * 128; }
    else { const int rr = r - CV_GU, per = 8 * (D / 64), e = rr / per, q = rr % per, nb = q % (D / 64), kb = q / (D / 64), n0 = nb * 64;
        c.src = w_down + (size_t)e * DFF * D + (size_t)(kb * 128) * D + n0; c.N = D; c.dst = Wd_t + (size_t)e * D * DFF + (size_t)n0 * DFF + kb * 128; }
    return c;
}
__device__ __forceinline__ void conv_range(Frame& F, const Args& a, int lo, int hi, int first, int stride) {
    LAS unsigned* scr = (LAS unsigned*)(F.lds + RING_OFF + F.wave * 16384);
    int r = lo + first; if (r >= hi) return;
    ConvItem cur = conv_addr(a, r);
    f32x4 xa[16], xb[16];
    conv_load_half(xa, cur.src, cur.N, 0, F.lane); conv_load_half(xb, cur.src, cur.N, 1, F.lane);
#pragma unroll 1
    for (;;) {
        const int rn = r + stride; const bool more = rn < hi;
        const ConvItem nxt = conv_addr(a, more ? rn : r);
        conv_cvt_half(xa, scr, 0, F.lane); conv_load_half(xa, nxt.src, nxt.N, 0, F.lane);
        conv_cvt_half(xb, scr, 1, F.lane); conv_load_half(xb, nxt.src, nxt.N, 1, F.lane);
        LDS_WAIT(); asm volatile("" ::: "memory");
        conv_store(cur.dst, scr, F.lane);
        LDS_WAIT(); asm volatile("" ::: "memory");
        if (!more) break;
        cur = nxt; r = rn;
    }
}
__device__ __forceinline__ void p1_xn(Frame& F, const Args& a) {
    const float* modp = (const float*)(a.ws + WS_MODP); const float* b_ada = a.in[4]; float* modf = (float*)(a.ws + WS_MODF);
    for (int i = blockIdx.x * 512 + F.tid; i < BATCH * 6 * D; i += F.G * 512) { float s = b_ada[i % (6 * D)];
#pragma unroll
        for (int ks = 0; ks < 8; ++ks) s += modp[(size_t)ks * BATCH * 6 * D + i];
        modf[i] = s; }
    LAS float* tab = (LAS float*)(F.lds + RING_OFF);
    const float* x = a.in[0]; const float* g = a.in[2]; bf16* XN = (bf16*)(a.ws + WS_XN);
    for (int chunk = blockIdx.x; chunk < NTOK / 64; chunk += F.G) {
        const int b = chunk / (SEQ / 64);
        f32x4 v[8][4];
#pragma unroll
        for (int q = 0; q < 8; ++q) { const GAS f32x4* xr = (const GAS f32x4*)(x + (size_t)(chunk * 64 + F.wave + q * NWAVES) * D) + F.lane;
#pragma unroll
            for (int j = 0; j < 4; ++j) v[q][j] = xr[64 * j]; }
        __syncthreads();
        for (int i = F.tid; i < 2 * D; i += 512) { const int col = i & (D - 1), chunkid = (i < D) ? 1 : 0; float s = b_ada[chunkid * D + col];
#pragma unroll
            for (int ks = 0; ks < 8; ++ks) s += modp[(size_t)ks * BATCH * 6 * D + (size_t)b * 6 * D + chunkid * D + col];
            tab[i] = (i < D) ? g[col] * (1.f + s) : s; }
        __syncthreads();
#pragma unroll
        for (int q = 0; q < 8; ++q) { float s = 0.f;
#pragma unroll
            for (int j = 0; j < 4; ++j) s += (v[q][j].x * v[q][j].x + v[q][j].y * v[q][j].y) + (v[q][j].z * v[q][j].z + v[q][j].w * v[q][j].w);
            const float rstd = 1.f / sqrtf(wave_sum(s) * (1.f / D) + EPS);
            GAS unsigned long long* o8 = (GAS unsigned long long*)(XN + (size_t)(chunk * 64 + F.wave + q * NWAVES) * D) + F.lane;
#pragma unroll
            for (int j = 0; j < 4; ++j) { const int col = 4 * F.lane + 256 * j; const f32x4 gs = *(const LAS f32x4*)(tab + col), sh = *(const LAS f32x4*)(tab + D + col);
                const f32x4 h = v[q][j] * rstd * gs + sh;
                o8[64 * j] = (unsigned long long)pk2(h.x, h.y) | ((unsigned long long)pk2(h.z, h.w) << 32); } }
    }
}

__device__ __forceinline__ void p5_router(Frame& F, const Args& a) {
    typedef __attribute__((ext_vector_type(8))) short bx8; typedef __attribute__((ext_vector_type(16))) float fx16;
    const unsigned short* x1 = (const unsigned short*)(a.ws + WS_X1); const float* modf = (const float*)(a.ws + WS_MODF); const float* g_ffn = a.in[11]; const float* w_router = a.in[12]; const float* b_router = a.in[13];
    unsigned char* H2 = a.ws + WS_H2; int* inv = (int*)(a.ws + WS_INV); float* tok_w = (float*)(a.ws + WS_TOKW);
    LAS float* part = (LAS float*)(F.lds + RING_OFF);
    LAS float* ssq = (LAS float*)(F.lds + RING_OFF + 32768);
    LAS float* cpart = (LAS float*)(F.lds + RING_OFF + 32768 + 1024);
    LAS float* lg = (LAS float*)(F.lds + RING_OFF + 57344);
    LAS float* rs = (LAS float*)(F.lds + RING_OFF + 32768 + 3072 + 4352);
    LAS float* gsl = (LAS float*)(F.lds + RING_OFF + 49152);
    LAS float* shl = (LAS float*)(F.lds + RING_OFF + 49152 + 4096);
    const int lane = F.lane, w = F.wave, r32 = lane & 31, hi = lane >> 5;
#pragma unroll 1
    for (int chunk = blockIdx.x; chunk < NTOK / 64; chunk += F.G) {
        const int b = chunk / (SEQ / 64);
        __syncthreads();
        for (int i = F.tid; i < D; i += NWAVES * 64) { gsl[i] = g_ffn[i] * (1.f + modf[(size_t)b * 6 * D + 4 * D + i]); shl[i] = modf[(size_t)b * 6 * D + 3 * D + i]; }
        __syncthreads();
        bx8 ahi[8], alo[8]; float cp = 0.f;
        const float* wrp = w_router + (size_t)(128 * w + 8 * hi) * NE + r32; const LAS float* gsp = gsl + 128 * w + 8 * hi; const LAS float* shp = shl + 128 * w + 8 * hi;
#pragma unroll
        for (int s = 0; s < 8; ++s) {
            unsigned ph[4], pl[4];
#pragma unroll
            for (int j2 = 0; j2 < 4; ++j2) { float v[2];
#pragma unroll
                for (int q = 0; q < 2; ++q) { const int kk = 16 * s + 2 * j2 + q; const float wr_ = wrp[kk * NE]; cp += shp[kk] * wr_; v[q] = gsp[kk] * wr_; }
                const unsigned h0 = f2bf(v[0]), h1 = f2bf(v[1]); ph[j2] = h0 | (h1 << 16);
                pl[j2] = f2bf(v[0] - __uint_as_float(h0 << 16)) | (f2bf(v[1] - __uint_as_float(h1 << 16)) << 16); }
            ahi[s] = __builtin_bit_cast(bx8, (v4u){ph[0], ph[1], ph[2], ph[3]}); alo[s] = __builtin_bit_cast(bx8, (v4u){pl[0], pl[1], pl[2], pl[3]});
        }
        cpart[(w * 2 + hi) * 32 + r32] = cp;
#pragma unroll 1
        for (int pass = 0; pass < 2; ++pass) {
            const int tok = chunk * 64 + pass * 32 + r32;
            const unsigned short* xr = x1 + (size_t)tok * D + 128 * w + 8 * hi;
            float ss = 0.f; fx16 acc = {};
#pragma unroll
            for (int s = 0; s < 8; ++s) {
                const v4u xw = *(const GAS v4u*)(xr + 16 * s);
#pragma unroll
                for (int q = 0; q < 4; ++q) { const float v0 = __uint_as_float(xw[q] << 16), v1 = __uint_as_float(xw[q] & 0xffff0000u); ss += v0 * v0 + v1 * v1; }
                const bx8 bhi = __builtin_bit_cast(bx8, xw);
                acc = __builtin_amdgcn_mfma_f32_32x32x16_bf16(ahi[s], bhi, acc, 0, 0, 0);
                acc = __builtin_amdgcn_mfma_f32_32x32x16_bf16(alo[s], bhi, acc, 0, 0, 0);
            }
            ss += __shfl_xor(ss, 32);
            __syncthreads();
#pragma unroll
            for (int r = 0; r < 16; ++r) part[(w * 32 + ((r & 3) + 8 * (r >> 2) + 4 * hi)) * 32 + r32] = acc[r];
            if (hi == 0) ssq[w * 32 + r32] = ss;
            __syncthreads();
            { const int tk = F.tid & 31, eg = F.tid >> 5;
                float sq = 0.f;
#pragma unroll
                for (int ww = 0; ww < 8; ++ww) sq += ssq[ww * 32 + tk];
                const float rstd = 1.f / sqrtf(sq * (1.f / D) + EPS);
                if (eg == 0) rs[tk] = rstd;
#pragma unroll
                for (int q = 0; q < 2; ++q) { const int e = 2 * eg + q; float sum = 0.f, c = b_router[e];
#pragma unroll
                    for (int ww = 0; ww < 8; ++ww) sum += part[(ww * 32 + e) * 32 + tk];
#pragma unroll
                    for (int ww = 0; ww < 16; ++ww) c += cpart[ww * 32 + e];
                    lg[(pass * 32 + tk) * 33 + e] = rstd * sum + c; } }
            __syncthreads();
            { const float rstd = rs[r32]; unsigned char* hr = H2 + (size_t)tok * D + 128 * w + 8 * hi;
#pragma unroll
                for (int s = 0; s < 8; ++s) { unsigned pk[2]; const v4u xw = *(const GAS v4u*)(xr + 16 * s);
#pragma unroll
                    for (int q = 0; q < 2; ++q) { const f32x4 xv = {__uint_as_float(xw[2 * q] << 16), __uint_as_float(xw[2 * q] & 0xffff0000u), __uint_as_float(xw[2 * q + 1] << 16), __uint_as_float(xw[2 * q + 1] & 0xffff0000u)};
                        const f32x4 g4 = *(const LAS f32x4*)(gsp + 16 * s + 4 * q), h4 = *(const LAS f32x4*)(shp + 16 * s + 4 * q);
                        const f32x4 hv = xv * rstd * g4 + h4; pk[q] = pg8::pk4_f8(hv.x, hv.y, hv.z, hv.w); }
                    *(GAS unsigned long long*)(hr + 16 * s) = (unsigned long long)pk[0] | ((unsigned long long)pk[1] << 32); } }
        }
        __syncthreads();
        if (w == 0) {
            float lgv[NE];
#pragma unroll
            for (int i = 0; i < NE; ++i) lgv[i] = lg[lane * 33 + i];
            int idx[TOPK]; float val[TOPK]; unsigned used = 0;
#pragma unroll
            for (int r = 0; r < TOPK; ++r) { int best = -1; float bv = 0.f;
#pragma unroll
                for (int i = 0; i < NE; ++i) if (!((used >> i) & 1u) && (best < 0 || lgv[i] > bv)) { best = i; bv = lgv[i]; }
                used |= 1u << best; idx[r] = best; val[r] = bv; }
            float wsum = 0.f, wv[TOPK];
#pragma unroll
            for (int r = 0; r < TOPK; ++r) { wv[r] = __expf(val[r] - val[0]); wsum += wv[r]; }
            const int tk = chunk * 64 + lane; const float inv_ws = 1.f / wsum;
            const unsigned selbits = (1u << idx[0]) | (1u << idx[1]) | (1u << idx[2]) | (1u << idx[3]);
            int rk[TOPK] = {0, 0, 0, 0}; int cnt = 0;
#pragma unroll 1
            for (int e = 0; e < NE; ++e) {
                const unsigned long long mm = __ballot((selbits >> e) & 1u);
                const int rnk = __popcll(mm & ((1ull << lane) - 1ull));
#pragma unroll
                for (int r = 0; r < TOPK; ++r) if (idx[r] == e) rk[r] = rnk;
                if (lane == e) cnt = __popcll(mm);
            }
#pragma unroll
            for (int r = 0; r < TOPK; ++r) { inv[((size_t)chunk * NE + idx[r]) * 64 + rk[r]] = tk * 4 + r; tok_w[tk * 4 + r] = wv[r] * inv_ws; }
            if (lane < NE) ((int*)(a.ws + WS_CNTC))[lane * 256 + chunk] = cnt;
        }
    }
}
__device__ __forceinline__ void build_tiles(Frame& F, const Args& a) {
    LAS int* tile_e = (LAS int*)(F.lds + LDS_TILE_E); LAS int* ntl = (LAS int*)(F.lds + LDS_NT); LAS int* tbase = (LAS int*)(F.lds + LDS_TBASE); LAS int* cnte = (LAS int*)(F.lds + LDS_CNTE);
    LAS int* pre = (LAS int*)(F.lds + RING_OFF);
    __syncthreads();
    { const int e = F.tid >> 4, part = F.tid & 15; const int* cp = (const int*)(a.ws + WS_CNTC) + e * 256 + part * 16;
        int v[16]; int sum = 0;
#pragma unroll
        for (int q = 0; q < 4; ++q) { const int4 t4 = *(const int4*)(cp + 4 * q); v[4 * q] = t4.x; v[4 * q + 1] = t4.y; v[4 * q + 2] = t4.z; v[4 * q + 3] = t4.w; }
#pragma unroll
        for (int q = 0; q < 16; ++q) { const int t = v[q]; v[q] = sum; sum += t; }
        int inc = sum;
#pragma unroll
        for (int d = 1; d < 16; d <<= 1) { const int n = __shfl_up(inc, d, 16); if (part >= d) inc += n; }
        const int excl = inc - sum;
#pragma unroll
        for (int q = 0; q < 16; ++q) pre[e * 256 + part * 16 + q] = excl + v[q];
        if (part == 15) cnte[e] = inc; }
    __syncthreads();
    if (F.tid < NE) { const int e = F.tid, nt = (cnte[e] + 255) >> 8; int inc = nt;
#pragma unroll
        for (int d = 1; d < NE; d <<= 1) { const int n = __shfl_up(inc, d, NE); if (e >= d) inc += n; }
        const int base = inc - nt; tbase[e] = base; for (int j = 0; j < nt; ++j) tile_e[base + j] = e;
        if (e == NE - 1) ntl[0] = inc; }
    __syncthreads();
}
__device__ __forceinline__ void p8_final(Frame& F, const Args& a) {
    const unsigned short* x1 = (const unsigned short*)(a.ws + WS_X1); const unsigned char* Y = a.ws + WS_Y; const float* modf = (const float*)(a.ws + WS_MODF);
    const int* tok_slot = (const int*)(a.ws + WS_TOKP); const float* tok_w = (const float*)(a.ws + WS_TOKW);
    const float* gfin = a.in[18];
    const int gw = F.vcu * NWAVES + F.wave, NGW = F.G * NWAVES;
    constexpr int P8R = 4;
    typedef int i32x4 __attribute__((ext_vector_type(4)));
    i32x4 np[P8R]; f32x4 nw[P8R];
#define P8_ROUTE(r0) do { _Pragma("unroll") for (int _q = 0; _q < P8R; ++_q) { const int _r = (r0) + _q * NGW; if (_r < NTOK) { np[_q] = *(const GAS i32x4*)(tok_slot + _r * 4); nw[_q] = *(const GAS f32x4*)(tok_w + _r * 4); } } } while (0)
    P8_ROUTE(gw);
    for (int row0 = gw; row0 < NTOK; row0 += P8R * NGW) {
        i32x4 cp[P8R]; f32x4 cw[P8R];
#pragma unroll
        for (int q = 0; q < P8R; ++q) { cp[q] = np[q]; cw[q] = nw[q]; }
        unsigned yv[P8R][TOPK][4]; pg8::u32x2 xv[P8R][4];
#pragma unroll
        for (int q = 0; q < P8R; ++q) { const int row = row0 + q * NGW; if (row < NTOK) {
#pragma unroll
            for (int k = 0; k < TOPK; ++k) { const int slot = __builtin_amdgcn_readfirstlane(cp[q][k]);
                const GAS unsigned* yr = (const GAS unsigned*)(Y + (size_t)slot * D) + F.lane;
#pragma unroll
                for (int j = 0; j < 4; ++j) yv[q][k][j] = yr[64 * j]; }
            const GAS pg8::u32x2* xr = (const GAS pg8::u32x2*)(x1 + (size_t)row * D) + F.lane;
#pragma unroll
            for (int j = 0; j < 4; ++j) xv[q][j] = xr[64 * j]; } }
        P8_ROUTE(row0 + P8R * NGW);
#pragma unroll
        for (int q = 0; q < P8R; ++q) { const int row = row0 + q * NGW; if (row < NTOK) {
            const int b = row / SEQ; const float* gf = modf + (size_t)b * 6 * D + 5 * D;
            f32x4 acc[4];
#pragma unroll
            for (int j = 0; j < 4; ++j) acc[j] = (f32x4){0.f, 0.f, 0.f, 0.f};
#pragma unroll
            for (int k = 0; k < TOPK; ++k) { const float wk = cw[q][k] * (1.0f / YSCALE);
#pragma unroll
                for (int j = 0; j < 4; ++j) { const int qq = (int)yv[q][k][j]; const auto lo = __builtin_amdgcn_cvt_pk_f32_fp8(qq, false), hi = __builtin_amdgcn_cvt_pk_f32_fp8(qq, true);
                    acc[j].x += wk * lo[0]; acc[j].y += wk * lo[1]; acc[j].z += wk * hi[0]; acc[j].w += wk * hi[1]; } }
            float s = 0.f; f32x4 v[4];
#pragma unroll
            for (int j = 0; j < 4; ++j) { const f32x4 g4 = *(const GAS f32x4*)(gf + 4 * F.lane + 256 * j); const f32x4 x4 = {__uint_as_float(xv[q][j].x << 16), __uint_as_float(xv[q][j].x & 0xffff0000u), __uint_as_float(xv[q][j].y << 16), __uint_as_float(xv[q][j].y & 0xffff0000u)}; v[j] = x4 + g4 * acc[j]; s += (v[j].x * v[j].x + v[j].y * v[j].y) + (v[j].z * v[j].z + v[j].w * v[j].w); }
            const float rstd = 1.f / sqrtf(wave_sum(s) * (1.f / D) + EPS);
            GAS f32x4* orow = (GAS f32x4*)(a.out + (size_t)row * D) + F.lane;
#pragma unroll
            for (int j = 0; j < 4; ++j) { const f32x4 g4 = *(const GAS f32x4*)(gfin + 4 * F.lane + 256 * j); __builtin_nontemporal_store(v[j] * rstd * g4, orow + 64 * j); } } }
    }
#undef P8_ROUTE
}
__device__ __forceinline__ void build_ridx(Frame& F, const Args& a, int nN) {
    const LAS int* tile_e = (const LAS int*)(F.lds + LDS_TILE_E); const LAS int* tbase = (const LAS int*)(F.lds + LDS_TBASE); const LAS int* cnte = (const LAS int*)(F.lds + LDS_CNTE);
    const LAS int* pre = (const LAS int*)(F.lds + RING_OFF); const int ntiles = *(const LAS int*)(F.lds + LDS_NT);
    LAS int* ridx = (LAS int*)(F.lds + LDS_RIDX); const int* lists = (const int*)(a.ws + WS_INV); int* tok_slot = (int*)(a.ws + WS_TOKP);
    int adr[5], slot[5], flag[5];
#pragma unroll
    for (int k = 0; k < 5; ++k) { const int it = F.tid + k * (NWAVES * 64), i = it >> 8, r = it & 255; int t, pn_; flag[k] = 0; adr[k] = 0; slot[k] = 0;
        if (pg8::moe_unit(i, (int)blockIdx.x, F.G, nN, cnte, tbase, ntiles, t, pn_)) {
            const int e = tile_e[t], j = t - tbase[e], c = cnte[e]; int pos = j * 256 + r; const bool real = pos < c; if (!real) pos = 0;
            int lo = 0;
#pragma unroll
            for (int st = 128; st >= 1; st >>= 1) if (pre[e * 256 + lo + st] <= pos) lo += st;
            adr[k] = (lo * NE + e) * 64 + (pos - pre[e * 256 + lo]); slot[k] = t * 256 + r; flag[k] = (pn_ == 0 && real) ? 2 : 1; } }
    int ent[5];
#pragma unroll
    for (int k = 0; k < 5; ++k) ent[k] = flag[k] ? lists[adr[k]] : 0;
#pragma unroll
    for (int k = 0; k < 5; ++k) if (flag[k]) { ridx[F.tid + k * (NWAVES * 64)] = ent[k] >> 2; if (flag[k] == 2) tok_slot[ent[k]] = slot[k]; }
    __syncthreads();
}

__global__ void __launch_bounds__(NWAVES * 64, 2) mega_fwd(Args args) {
    extern __shared__ __attribute__((aligned(16))) unsigned char lds[];
    Frame F;
    F.lds = (LAS unsigned char*)lds;
    F.MISC = (volatile LAS unsigned*)(F.lds + MISC_OFF);
    F.tid = threadIdx.x; F.lane = F.tid & 63; F.wave = __builtin_amdgcn_readfirstlane(F.tid >> 6);
    F.G = gridDim.x; { const int bx = blockIdx.x; F.vcu = (F.G % 8 == 0) ? (bx % 8) * (F.G / 8) + bx / 8 : bx; }
    unsigned char* ws = args.ws;
    F.ctl = (gu32*)(ws + WS_CTL);
    for (int u = F.tid; u < 512 / 4; u += NWAVES * 64) ((LAS unsigned*)(F.lds + LDSCTL_OFF))[u] = 0u;
    __syncthreads();
    XcdBarrier bar = xcd_barrier_post((unsigned*)(F.ctl + CW_BAR), F.MISC + 8);
    const int lo = args.ph_lo, hi = args.ph_hi;
#ifndef PHASE_MASK
#define PHASE_MASK 0x1ff
#endif
#define IN(k) (((PHASE_MASK >> (k)) & 1) && lo <= (k) && (k) < hi)
#define BOTH(k) (IN(k) && IN((k) + 1))
#define GRID_BAR() xcd_barrier(bar)
#define REFRESH() do { int t_ = threadIdx.x; asm volatile("" : "+v"(t_)); F.tid = t_; F.lane = t_ & 63; F.wave = __builtin_amdgcn_readfirstlane(t_ >> 6); } while (0)
    const bool split = (F.G == 256); constexpr int NCONV = 64, NCONV3 = 64;
    const bool is_conv = split && (int)blockIdx.x >= F.G - NCONV, is_conv3 = split && (int)blockIdx.x >= F.G - NCONV3;
    const int NC = split ? F.G - NCONV : F.G, NC3 = split ? F.G - NCONV3 : F.G, cidx = (int)blockIdx.x;
    const int nconvw = (split ? NCONV : F.G) * NWAVES, convw = (split ? (int)blockIdx.x - (F.G - NCONV) : (int)blockIdx.x) * NWAVES;
    const int nconvw3 = (split ? NCONV3 : F.G) * NWAVES, convw3 = (split ? (int)blockIdx.x - (F.G - NCONV3) : (int)blockIdx.x) * NWAVES;
    constexpr int CV_SPLIT = 4096;
    if (IN(0)) { p0_prologue(F, args); if (!split) conv_range(F, args, 0, CV_ITEMS, F.vcu * NWAVES + F.wave, F.G * NWAVES); if (BOTH(0)) GRID_BAR(); }
    if (IN(1)) { REFRESH(); p1_xn(F, args); if (BOTH(1)) GRID_BAR(); }
    if (IN(2)) {
        if (is_conv) { REFRESH(); conv_range(F, args, 0, CV_SPLIT, convw + F.wave, nconvw); }
        else {
            pg8::Gemm g{(const bf16*)(ws + WS_XN), (const bf16*)(ws + WS_WIN), NTOK, D_IN, D}; pg8::StaticOrder S; S.init(NTOK, D_IN, NC, cidx);
            pg8::EpiProj E{(bf16*)(ws + WS_PROJ), args.in[6], (float*)(F.ctl + CW_KSUM)};
            pg8::gemm_phase<pg8::EpiProj, pg8::StaticOrder, false, true>(F.lds + RING_OFF, g, S, E);
        }
        if (BOTH(2)) GRID_BAR();
    }
    if (IN(3)) {
        if (is_conv3) { REFRESH(); conv_range(F, args, CV_SPLIT, CV_ITEMS, convw3 + F.wave, nconvw3); }
        else {
            const float* sinks = args.in[10]; int prev_key = -1;
            for (int round = 0; ; ++round) {
                const int rank = round * NC3 + ((round & 1) ? (((NC3 & 7) == 0) ? ((NC3 - 1 - cidx) ^ 7) : NC3 - 1 - cidx) : cidx); if (rank >= 1024) break;
                att::UnitDesc u;
                if (rank < 512) { const int bh = rank & 63, h = bh & 7; u.b = bh >> 3; u.qb = 7 - (rank >> 6); u.q0 = u.qb * 256; u.gqa = 0; u.moba = 1;
                    u.qcol = h * 64; u.kcol = 512 + h * 64; u.vcol = 1024 + h * 64; u.ocol = h * 64; u.head = h; u.sink2 = 0.f; u.fill = (h != prev_key); prev_key = h; u.fillk = 1; }
                else { const int idx = rank - 512, bk = idx & 15, kvh = bk & 1; u.b = bk >> 1; u.q0 = (31 - (idx >> 4)) * 64; u.qb = u.q0 >> 8; u.gqa = 1; u.moba = 0;
                    u.qcol = 1536 + kvh * 256; u.kcol = 2048 + kvh * 64; u.vcol = 2176 + kvh * 64; u.ocol = 512 + kvh * 256; u.head = 8 + kvh * 4; u.sink2 = 0.f; u.fill = (64 + kvh != prev_key); prev_key = 64 + kvh; u.fillk = 0; }
                att::attn_unit(u, (const bf16*)(ws + WS_PROJ), ws + WS_O, (const float*)(ws + WS_BIAS), (const float*)(F.ctl + CW_KSUM), sinks, (char*)lds + RING_OFF);
            }
        }
        if (BOTH(3)) GRID_BAR();
    }
    if (IN(4)) {
        pg8::Gemm g{(const bf16*)(ws + WS_O), (const bf16*)(ws + WS_WOUT), NTOK, D, D / 2}; pg8::StaticOrder S; S.init(NTOK, D, F.G, (int)blockIdx.x);
        pg8::EpiX1 E{args.in[0], (pg8::bf16_t*)(ws + WS_X1), args.in[8], (const float*)(ws + WS_MODF)};
        pg8::gemm_phase<pg8::EpiX1, pg8::StaticOrder, false, true, true>(F.lds + RING_OFF, g, S, E);
        if (BOTH(4)) GRID_BAR();
    }
    if (IN(5)) { REFRESH(); p5_router(F, args); if (BOTH(5)) GRID_BAR(); }
    if (IN(6)) {
        REFRESH(); build_tiles(F, args); build_ridx(F, args, 2 * DFF / 256);
        pg8::Gemm g{(const bf16*)(ws + WS_H2), (const bf16*)(ws + WS_WGU), MAXSLOTS, 2 * DFF, D / 2};
        pg8::GroupedOrder S{2 * DFF / 256, F.G, (int)blockIdx.x, *(const LAS int*)(F.lds + LDS_NT), (const LAS int*)(F.lds + LDS_TILE_E), (const LAS int*)(F.lds + LDS_RIDX), (size_t)2 * DFF * D, (const LAS int*)(F.lds + LDS_CNTE), (const LAS int*)(F.lds + LDS_TBASE)};
        pg8::EpiSwiglu8 E{ws + WS_ACT, args.in[15]};
        pg8::gemm_phase<pg8::EpiSwiglu8, pg8::GroupedOrder, false, true, true>(F.lds + RING_OFF, g, S, E);
        if (BOTH(6)) GRID_BAR();
    }
    if (IN(7)) {
        REFRESH(); if (!IN(6)) build_tiles(F, args);
        pg8::Gemm g{(const bf16*)(ws + WS_ACT), (const bf16*)(ws + WS_WD), MAXSLOTS, D, DFF / 2};
        pg8::GroupedOrder S{D / 256, F.G, (int)blockIdx.x, *(const LAS int*)(F.lds + LDS_NT), (const LAS int*)(F.lds + LDS_TILE_E), (const LAS int*)nullptr, (size_t)D * DFF, (const LAS int*)(F.lds + LDS_CNTE), (const LAS int*)(F.lds + LDS_TBASE)};
        pg8::EpiDown8 E{ws + WS_Y, args.in[17]};
        pg8::gemm_phase<pg8::EpiDown8, pg8::GroupedOrder, false, true, true>(F.lds + RING_OFF, g, S, E);
        if (BOTH(7)) GRID_BAR();
    }
    if (IN(8)) { REFRESH(); p8_final(F, args); }
#undef IN
#undef BOTH
}

#ifndef MK_PER_PHASE
#define MK_PER_PHASE 0
#endif
extern "C" void kernel_launch(void* const* d_in, const int* in_sizes, int n_in, void* d_out, int out_size, void* d_ws, size_t ws_size, hipStream_t stream) {
    static int grid = 0;
    if (grid == 0) {
        if (n_in != 19 || ws_size < WS_END) { fprintf(stderr, "kernel_launch: unexpected n_in %d / ws %zu\n", n_in, ws_size); grid = -1; return; }
        int dev = 0, cus = 0, per_cu = 0;
        if (hipGetDevice(&dev) != hipSuccess || hipDeviceGetAttribute(&cus, hipDeviceAttributeMultiprocessorCount, dev) != hipSuccess) { grid = -1; return; }
        if (hipFuncSetAttribute((const void*)mega_fwd, hipFuncAttributeMaxDynamicSharedMemorySize, LDS_BYTES) != hipSuccess) { fprintf(stderr, "kernel_launch: hipFuncSetAttribute failed\n"); grid = -1; return; }
        if (hipOccupancyMaxActiveBlocksPerMultiprocessor(&per_cu, (const void*)mega_fwd, NWAVES * 64, LDS_BYTES) != hipSuccess || per_cu < 1) fprintf(stderr, "kernel_launch: occupancy query reports %d\n", per_cu);
        (void)hipGetLastError();
        grid = cus;
    }
    if (grid < 0) return;
    unsigned char* ws = (unsigned char*)d_ws;
    (void)hipMemsetAsync(ws + WS_CTL, 0, CTL_ZERO_BYTES, stream);
    Args a{};
    for (int i = 0; i < 19; ++i) a.in[i] = (const float*)d_in[i];
    a.out = (float*)d_out; a.ws = ws;
#if MK_PER_PHASE
    for (int ph = 0; ph < 9; ++ph) { a.ph_lo = ph; a.ph_hi = ph + 1; hipLaunchKernelGGL(mega_fwd, dim3(grid), dim3(NWAVES * 64), LDS_BYTES, stream, a); }
#else
    a.ph_lo = 0; a.ph_hi = 9; hipLaunchKernelGGL(mega_fwd, dim3(grid), dim3(NWAVES * 64), LDS_BYTES, stream, a);
#endif
}
```

```cpp
#include <hip/hip_runtime.h>
#include <hip/hip_bf16.h>
#include <cstdio>
#include <cstdint>
#include <cmath>

constexpr int D = 1024, BATCH = 8, SEQ = 2048, NTOK = BATCH * SEQ;
constexpr int HD = 64, NH_M = 8, NH_S = 8, NKV_S = 2;
constexpr int D_MOBA = 512, D_SWA_Q = 512, D_SWA_KV = 128, D_IN = 2304;
constexpr int MB_L = 256, MB_NB = SEQ / MB_L, MB_TOPK = 3;
constexpr int SWA_W = 128;
constexpr int NE = 32, TOPK = 4, DFF = 1024;
constexpr float EPS = 1e-5f, NEGF = -1e30f;
constexpr int MAXTILES = 288;
constexpr int MAXSLOTS = MAXTILES * 256;
constexpr float LOG2E = 1.4426950408889634f;
constexpr float OSCALE = 16.0f;
constexpr float YSCALE = 16.0f;
constexpr float WSCALE = 32.0f;
constexpr float QSCALE = 0.125f * LOG2E;

namespace pg8 {
#define PG8_LAS __attribute__((address_space(3)))
typedef unsigned short bf16_t;
typedef short bf16x8 __attribute__((ext_vector_type(8)));
typedef float f32x4 __attribute__((ext_vector_type(4)));
typedef unsigned u32x4 __attribute__((ext_vector_type(4)));
typedef int v4i_t __attribute__((ext_vector_type(4)));
constexpr int BM = 256, BK = 64, HALF = 128, HTB = HALF * BK * 2  , STAGE_BYTES = 8 * HTB, NXCD = 8, WGM = 8;

__host__ __device__ __forceinline__ int lds_byte(int r, int c) { const int st = (r >> 4) * 2 + (c >> 5), rr = r & 15, cc = c & 31, ob = rr * 64 + cc * 2; return st * 1024 + (ob ^ (((ob >> 9) & 1) << 5)); }
__host__ __device__ __forceinline__ void stage_rc(int b, int& R, int& C) { const int st = b / 1024, sb = b % 1024, swz = sb ^ (((sb >> 9) & 1) << 5); R = (st >> 1) * 16 + swz / 64; C = (st & 1) * 32 + (swz % 64) / 2; }
__host__ __device__ __forceinline__ int perm32(int rho) { const int n = rho >> 4, i = rho & 15; return 8 * (i >> 2) + 4 * n + (i & 3); }

struct Unit { int pm, pn, e; };
struct Gemm { const bf16_t* A; const bf16_t* Bt; int M, N, K; };

struct StaticOrder {
    int nM, nN, nwg, G, c;
    __host__ __device__ void init(int M, int N, int G_, int c_) { nM = M / BM; nN = N / BM; nwg = nM * nN; G = G_; c = c_; }
    __host__ __device__ bool next(int i, Unit& u) const {
        const long L = (long)i * G + c; if (L >= nwg) return false;
        int wgid = (int)L; { const int q = nwg / NXCD, r = nwg % NXCD, xcd = wgid % NXCD, off = wgid / NXCD; wgid = (xcd < r ? xcd * (q + 1) : r * (q + 1) + (xcd - r) * q) + off; }
        const int nig = WGM * nN, gid = wgid / nig, fm = gid * WGM, gsz = (nM - fm) < WGM ? (nM - fm) : WGM;
        u.pm = fm + ((wgid % nig) % gsz); u.pn = (wgid % nig) / gsz; u.e = 0; return true;
    }
    __device__ __forceinline__ size_t abase(const Unit& u, int h, int K) const { return (size_t)(u.pm * BM + h * HALF) * K * 2; }
    __device__ __forceinline__ unsigned alane(int, const Unit&, int, int, unsigned voff, int) const { return voff; }
    __device__ __forceinline__ size_t bbase(const Unit& u, size_t tstep) const { return (size_t)u.pn * tstep; }
    __device__ __forceinline__ void a_ready(const Unit&) const {}
    __device__ __forceinline__ void done(const Unit&) const {}
};
__device__ __forceinline__ bool moe_unit(int i, int c, int G, int nN, const PG8_LAS int* cnte, const PG8_LAS int* tbase, int ntiles, int& t, int& pn) {
    if ((G & 7) == 0) {
        const int x = c & 7, rank = c >> 3, W = G >> 3, lo = (x * ntiles) >> 3, hi = ((x + 1) * ntiles) >> 3, v = i * W + rank;
        if (v >= (hi - lo) * nN) return false;
        const int j = v / nN; t = lo + j; pn = v - j * nN; return true;
    }
    const int L = i * G + c; t = L / nN; if (t >= ntiles) return false; pn = L - t * nN; return true;
}
struct GroupedOrder {
    int nN, G, c, ntiles; const PG8_LAS int* tile_e; const PG8_LAS int* ridx; size_t bstride; const PG8_LAS int* cnte; const PG8_LAS int* tbase;
    __device__ __forceinline__ bool next(int i, Unit& u) const {
        int t, pn; if (!moe_unit(i, c, G, nN, cnte, tbase, ntiles, t, pn)) return false;
        u.pm = __builtin_amdgcn_readfirstlane(t); u.pn = __builtin_amdgcn_readfirstlane(pn); u.e = __builtin_amdgcn_readfirstlane(tile_e[t]); return true;
    }
    __device__ __forceinline__ size_t abase(const Unit& u, int h, int K) const { return ridx ? (size_t)0 : (size_t)(u.pm * BM + h * HALF) * K * 2; }
    __device__ __forceinline__ unsigned alane(int ui, const Unit&, int h, int piece, unsigned voff, int K) const {
        if (!ridx) return voff;
        int t_ = (int)threadIdx.x; asm volatile("" : "+v"(t_));
        int R, C; stage_rc(t_ * 16 + piece * 8192, R, C);
        return (unsigned)ridx[ui * BM + h * HALF + R] * (unsigned)K * 2u + (unsigned)C * 2u; }
    __device__ __forceinline__ size_t bbase(const Unit& u, size_t tstep) const { return (size_t)u.e * bstride + (size_t)u.pn * tstep; }
    __device__ __forceinline__ void a_ready(const Unit&) const {}
    __device__ __forceinline__ void done(const Unit&) const {}
};

__device__ __forceinline__ unsigned cvt_pk_bf16(float lo, float hi) { unsigned r; asm volatile("v_cvt_pk_bf16_f32 %0, %1, %2" : "=v"(r) : "v"(lo), "v"(hi)); return r; }

struct EpiProj {
    static constexpr bool PERM = true, AFTER_DRAIN = false;
    bf16_t* O; const float* bias; float* ksum;
    static constexpr float ASC = 1.0f / WSCALE;
    __device__ __forceinline__ void operator()(const f32x4 (&acc)[2][2][4][2], const Unit& u, int wr, int wc, int fr, int fq) const {
        const int row0 = u.pm * BM + wr * 64 + fr, col0 = u.pn * BM + wc * 32 + 8 * fq;
        const float sc = (u.pn < 2 || u.pn == 6 || u.pn == 7) ? QSCALE : 1.0f;
        f32x4 bv[2][2];
#pragma unroll
        for (int bj = 0; bj < 2; ++bj)
#pragma unroll
            for (int n = 0; n < 2; ++n) bv[bj][n] = *(const f32x4*)(bias + col0 + bj * HALF + 4 * n);
#pragma unroll
        for (int ai = 0; ai < 2; ++ai)
#pragma unroll
            for (int m = 0; m < 4; ++m) { bf16_t* rowp = O + (size_t)(row0 + ai * HALF + m * 16) * D_IN + col0;
#pragma unroll
                for (int bj = 0; bj < 2; ++bj) { f32x4 v0 = (acc[ai][bj][m][0] * ASC + bv[bj][0]) * sc, v1 = (acc[ai][bj][m][1] * ASC + bv[bj][1]) * sc;
                    u32x4 w; w.x = cvt_pk_bf16(v0[0], v0[1]); w.y = cvt_pk_bf16(v0[2], v0[3]); w.z = cvt_pk_bf16(v1[0], v1[1]); w.w = cvt_pk_bf16(v1[2], v1[3]);
                    *(u32x4*)(rowp + bj * HALF) = w; } }
        if (u.pn == 2 || u.pn == 3) {
#pragma unroll
            for (int bj = 0; bj < 2; ++bj)
#pragma unroll
                for (int n = 0; n < 2; ++n) {
                    f32x4 s = bv[bj][n] * (8.0f / ASC);
#pragma unroll
                    for (int ai = 0; ai < 2; ++ai)
#pragma unroll
                        for (int m = 0; m < 4; ++m) s += acc[ai][bj][m][n];
                    s *= ASC;
#pragma unroll
                    for (int j = 0; j < 4; ++j) { float t = s[j]; t += __shfl_xor(t, 1); t += __shfl_xor(t, 2); t += __shfl_xor(t, 4); t += __shfl_xor(t, 8);
                        if (fr == 0) atomicAdd(ksum + (size_t)u.pm * D_MOBA + (u.pn - 2) * BM + bj * HALF + wc * 32 + 8 * fq + 4 * n + j, t); }
                }
        }
    }
};
struct EpiX1 {
    static constexpr bool PERM = true, AFTER_DRAIN = false;
    const float* x; bf16_t* x1; const float* bias; const float* modf;
    __device__ __forceinline__ void operator()(const f32x4 (&acc)[2][2][4][2], const Unit& u, int wr, int wc, int fr, int fq) const {
        const int row0 = u.pm * BM + wr * 64 + fr, col0 = u.pn * BM + wc * 32 + 8 * fq;
        const float* ga = modf + (size_t)(u.pm >> 3) * 6 * D + 2 * D;
        f32x4 bv[2][2], gv[2][2];
#pragma unroll
        for (int bj = 0; bj < 2; ++bj)
#pragma unroll
            for (int n = 0; n < 2; ++n) { bv[bj][n] = *(const f32x4*)(bias + col0 + bj * HALF + 4 * n); gv[bj][n] = *(const f32x4*)(ga + col0 + bj * HALF + 4 * n); }
#pragma unroll
        for (int ai = 0; ai < 2; ++ai)
#pragma unroll
            for (int m = 0; m < 4; ++m) { const size_t off = (size_t)(row0 + ai * HALF + m * 16) * D + col0;
#pragma unroll
                for (int bj = 0; bj < 2; ++bj) { const f32x4 xr0 = *(const f32x4*)(x + off + bj * HALF), xr1 = *(const f32x4*)(x + off + bj * HALF + 4);
                    const f32x4 v0 = xr0 + gv[bj][0] * (acc[ai][bj][m][0] * (1.0f / (WSCALE * OSCALE)) + bv[bj][0]), v1 = xr1 + gv[bj][1] * (acc[ai][bj][m][1] * (1.0f / (WSCALE * OSCALE)) + bv[bj][1]);
                    u32x4 w; w.x = cvt_pk_bf16(v0[0], v0[1]); w.y = cvt_pk_bf16(v0[2], v0[3]); w.z = cvt_pk_bf16(v1[0], v1[1]); w.w = cvt_pk_bf16(v1[2], v1[3]);
                    *(u32x4*)(x1 + off + bj * HALF) = w; }
                if (m == 3) asm volatile("" ::: "memory"); }
    }
};
struct EpiSwiglu {
    static constexpr bool PERM = true, AFTER_DRAIN = false;
    bf16_t* act; const float* bias;
    __device__ __forceinline__ void operator()(const f32x4 (&acc)[2][2][4][2], const Unit& u, int wr, int wc, int fr, int fq) const {
        const int row0 = u.pm * BM + wr * 64 + fr, ff0 = u.pn * HALF + wc * 32 + 8 * fq;
        const float* bg = bias + (size_t)u.e * 2 * DFF + ff0;
        f32x4 bgv[2], buv[2];
#pragma unroll
        for (int n = 0; n < 2; ++n) { bgv[n] = *(const f32x4*)(bg + 4 * n); buv[n] = *(const f32x4*)(bg + DFF + 4 * n); }
#pragma unroll
        for (int ai = 0; ai < 2; ++ai)
#pragma unroll
            for (int m = 0; m < 4; ++m) {
                f32x4 o[2];
#pragma unroll
                for (int n = 0; n < 2; ++n) { const f32x4 gq = acc[ai][0][m][n] + bgv[n], uq = acc[ai][1][m][n] + buv[n];
#pragma unroll
                    for (int j = 0; j < 4; ++j) { const float g = fminf(gq[j], 7.0f), uu = fminf(fmaxf(uq[j], -7.0f), 7.0f);
                        const float sg = __builtin_amdgcn_rcpf(1.0f + __builtin_amdgcn_exp2f(-1.702f * LOG2E * g)); o[n][j] = (uu + 1.0f) * (g * sg); } }
                u32x4 w; w.x = cvt_pk_bf16(o[0][0], o[0][1]); w.y = cvt_pk_bf16(o[0][2], o[0][3]); w.z = cvt_pk_bf16(o[1][0], o[1][1]); w.w = cvt_pk_bf16(o[1][2], o[1][3]);
                *(u32x4*)(act + (size_t)(row0 + ai * HALF + m * 16) * DFF + ff0) = w; }
    }
};
struct EpiDown {
    static constexpr bool PERM = true, AFTER_DRAIN = false;
    bf16_t* y; const float* bias;
    __device__ __forceinline__ void operator()(const f32x4 (&acc)[2][2][4][2], const Unit& u, int wr, int wc, int fr, int fq) const {
        const int row0 = u.pm * BM + wr * 64 + fr, col0 = u.pn * BM + wc * 32 + 8 * fq;
        const float* bb = bias + (size_t)u.e * D + col0;
        f32x4 bv[2][2];
#pragma unroll
        for (int bj = 0; bj < 2; ++bj)
#pragma unroll
            for (int n = 0; n < 2; ++n) bv[bj][n] = *(const f32x4*)(bb + bj * HALF + 4 * n);
#pragma unroll
        for (int ai = 0; ai < 2; ++ai)
#pragma unroll
            for (int m = 0; m < 4; ++m) { bf16_t* rowp = y + (size_t)(row0 + ai * HALF + m * 16) * D + col0;
#pragma unroll
                for (int bj = 0; bj < 2; ++bj) { const f32x4 v0 = acc[ai][bj][m][0] + bv[bj][0], v1 = acc[ai][bj][m][1] + bv[bj][1];
                    u32x4 w; w.x = cvt_pk_bf16(v0[0], v0[1]); w.y = cvt_pk_bf16(v0[2], v0[3]); w.z = cvt_pk_bf16(v1[0], v1[1]); w.w = cvt_pk_bf16(v1[2], v1[3]);
                    *(u32x4*)(rowp + bj * HALF) = w; } }
    }
};

__device__ __forceinline__ unsigned pk4_f8(float a, float b, float c, float d) { int r = __builtin_amdgcn_cvt_pk_fp8_f32(a, b, 0, false); r = __builtin_amdgcn_cvt_pk_fp8_f32(c, d, r, true); return (unsigned)r; }
typedef unsigned u32x2 __attribute__((ext_vector_type(2)));
struct EpiSwiglu8 {
    static constexpr bool PERM = true, AFTER_DRAIN = false;
    unsigned char* act; const float* bias;
    __device__ __forceinline__ void operator()(const f32x4 (&acc)[2][2][4][2], const Unit& u, int wr, int wc, int fr, int fq) const {
        const int row0 = u.pm * BM + wr * 64 + fr, ff0 = u.pn * HALF + wc * 32 + 8 * fq;
        const float* bg = bias + (size_t)u.e * 2 * DFF + ff0;
        f32x4 bgv[2], buv[2];
#pragma unroll
        for (int n = 0; n < 2; ++n) { bgv[n] = *(const f32x4*)(bg + 4 * n); buv[n] = *(const f32x4*)(bg + DFF + 4 * n); }
#pragma unroll
        for (int ai = 0; ai < 2; ++ai)
#pragma unroll
            for (int m = 0; m < 4; ++m) {
                f32x4 o[2];
#pragma unroll
                for (int n = 0; n < 2; ++n) { const f32x4 gq = acc[ai][0][m][n] * (1.0f / WSCALE) + bgv[n], uq = acc[ai][1][m][n] * (1.0f / WSCALE) + buv[n];
#pragma unroll
                    for (int j = 0; j < 4; ++j) { const float g = fminf(gq[j], 7.0f), uu = fminf(fmaxf(uq[j], -7.0f), 7.0f);
                        const float sg = __builtin_amdgcn_rcpf(1.0f + __builtin_amdgcn_exp2f(-1.702f * LOG2E * g)); o[n][j] = (uu + 1.0f) * (g * sg); } }
                u32x2 w; w.x = pk4_f8(o[0][0], o[0][1], o[0][2], o[0][3]); w.y = pk4_f8(o[1][0], o[1][1], o[1][2], o[1][3]);
                *(u32x2*)(act + (size_t)(row0 + ai * HALF + m * 16) * DFF + ff0) = w;
                asm volatile("" ::: "memory"); }
    }
};
struct EpiDown8 {
    static constexpr bool PERM = true, AFTER_DRAIN = false;
    unsigned char* y; const float* bias;
    __device__ __forceinline__ void operator()(const f32x4 (&acc)[2][2][4][2], const Unit& u, int wr, int wc, int fr, int fq) const {
        const int row0 = u.pm * BM + wr * 64 + fr, col0 = u.pn * BM + wc * 32 + 8 * fq;
        const float* bb = bias + (size_t)u.e * D + col0;
        f32x4 bv[2][2];
#pragma unroll
        for (int bj = 0; bj < 2; ++bj)
#pragma unroll
            for (int n = 0; n < 2; ++n) bv[bj][n] = *(const f32x4*)(bb + bj * HALF + 4 * n) * YSCALE;
#pragma unroll
        for (int ai = 0; ai < 2; ++ai)
#pragma unroll
            for (int m = 0; m < 4; ++m) { unsigned char* rowp = y + (size_t)(row0 + ai * HALF + m * 16) * D + col0;
#pragma unroll
                for (int bj = 0; bj < 2; ++bj) { const f32x4 v0 = acc[ai][bj][m][0] * (YSCALE / WSCALE) + bv[bj][0], v1 = acc[ai][bj][m][1] * (YSCALE / WSCALE) + bv[bj][1];
                    u32x2 w; w.x = pk4_f8(v0[0], v0[1], v0[2], v0[3]); w.y = pk4_f8(v1[0], v1[1], v1[2], v1[3]);
                    *(u32x2*)(rowp + bj * HALF) = w; }
                asm volatile("" ::: "memory"); }
    }
};

__device__ __forceinline__ void glds16_s(const char* sbase, unsigned voff, unsigned lds_dst) { unsigned keep;
    asm volatile("s_mov_b32 %0, m0\n\ts_mov_b32 m0, %3\n\ts_nop 0\n\tglobal_load_lds_dwordx4 %1, %2\n\ts_mov_b32 m0, %0" : "=&s"(keep) : "v"(voff), "s"(sbase), "s"(lds_dst) : "memory"); }
template <class Epi, class Sched, bool ALIGN_EPI = false, bool SP2 = false, bool F8 = false>
__device__ __forceinline__ void gemm_phase(PG8_LAS unsigned char* lds, const Gemm g, const Sched& S, const Epi& E) {
    int tid_ = threadIdx.x; asm volatile("" : "+v"(tid_));
    const int tid = tid_, wid = __builtin_amdgcn_readfirstlane(tid >> 6), lane = tid & 63, wr = wid >> 2, wc = wid & 3, fr = lane & 15, fq = lane >> 4;
    const int K = g.K, nt = K / BK;
    unsigned voffA[2], voffB[2];
#pragma unroll
    for (int i = 0; i < 2; ++i) { int R, C; stage_rc(tid * 16 + i * 8192, R, C); const int Rb = Epi::PERM ? ((R & ~31) + perm32(R & 31)) : R;
        voffA[i] = (unsigned)(R * K + C) * 2u; voffB[i] = (unsigned)(Rb * K + C) * 2u; }
#define PG8_STAGE_A(bufoff, kptr, UI, U, H) do { const char* _gb = (kptr) + S.abase(U, H, K); _Pragma("unroll") for (int _i = 0; _i < 2; ++_i) \
        glds16_s(_gb, S.alane(UI, U, H, _i, voffA[_i], K), ldsbase + (unsigned)((bufoff) + _i * 8192)); } while (0)
    const size_t kstep = (size_t)(BK * 2);
    const size_t hstep = (size_t)HALF * K * 2;
    const size_t tstep = 2 * hstep;
    const unsigned ldsw = (unsigned)wid * 1024u;
    const unsigned ldsbase = (unsigned)__builtin_amdgcn_readfirstlane((int)((unsigned)(size_t)lds + ldsw));
    const int aoff = lds_byte(wr * 64 + fr, fq * 8), boff = lds_byte(wc * 32 + fr, fq * 8);
#define PG8_SA(b, h) (((b) * 2 + (h)) * HTB)
#define PG8_SB(b, h) ((4 + (b) * 2 + (h)) * HTB)
#define PG8_STAGE(bufoff, gbase, voff) do { _Pragma("unroll") for (int _i = 0; _i < 2; ++_i) \
        glds16_s((const char*)(gbase), (voff)[_i], ldsbase + (unsigned)((bufoff) + _i * 8192)); } while (0)
#define PG8_LDA(dst, b, h) do { _Pragma("unroll") for (int m = 0; m < 4; ++m) _Pragma("unroll") for (int k = 0; k < 2; ++k) dst[m][k] = *(const PG8_LAS bf16x8*)(lds + PG8_SA(b, h) + aoff + m * 2048 + k * 1024); } while (0)
#define PG8_LDB(dst, b, h) do { _Pragma("unroll") for (int n = 0; n < 2; ++n) _Pragma("unroll") for (int k = 0; k < 2; ++k) dst[n][k] = *(const PG8_LAS bf16x8*)(lds + PG8_SB(b, h) + boff + n * 2048 + k * 1024); } while (0)
#define PG8_CAT(x) __builtin_shufflevector(__builtin_bit_cast(v4i_t, x[0]), __builtin_bit_cast(v4i_t, x[1]), 0, 1, 2, 3, 4, 5, 6, 7)
#define PG8_MMA(ai, bj, At, Bt) do { __builtin_amdgcn_s_setprio(1); _Pragma("unroll") for (int m = 0; m < 4; ++m) _Pragma("unroll") for (int n = 0; n < 2; ++n) { \
        if constexpr (F8) { acc[ai][bj][m][n] = __builtin_amdgcn_mfma_scale_f32_16x16x128_f8f6f4(PG8_CAT(Bt[n]), PG8_CAT(At[m]), acc[ai][bj][m][n], 0, 0, 0, 0, 0, 0); } \
        else { _Pragma("unroll") for (int k = 0; k < 2; ++k) acc[ai][bj][m][n] = __builtin_amdgcn_mfma_f32_16x16x32_bf16(Bt[n][k], At[m][k], acc[ai][bj][m][n], 0, 0, 0); } } \
        __builtin_amdgcn_s_setprio(0); } while (0)
#define PG8_WAIT_V(n) asm volatile("s_waitcnt vmcnt(" #n ")" ::: "memory")
#define PG8_WAIT_L(n) asm volatile("s_waitcnt lgkmcnt(" #n ")" ::: "memory")
#define PG8_BAR __builtin_amdgcn_s_barrier()
#define PG8_SCHED __builtin_amdgcn_sched_barrier(0)
    Unit cur, nxt; int ui = 0;
    if (!S.next(0, cur)) return;
    f32x4 acc[2][2][4][2];
#pragma unroll
    for (int a = 0; a < 2; ++a)
#pragma unroll
        for (int b = 0; b < 2; ++b)
#pragma unroll
            for (int m = 0; m < 4; ++m)
#pragma unroll
                for (int n = 0; n < 2; ++n) acc[a][b][m][n] = (f32x4){0.f, 0.f, 0.f, 0.f};
    bf16x8 At[4][2], B0[2][2], B1[2][2];
    const char* const A0 = (const char*)g.A; const char* cB = (const char*)g.Bt + S.bbase(cur, tstep);

    S.a_ready(cur);
    if constexpr (SP2) {
        PG8_STAGE(PG8_SB(0, 0), cB, voffB); PG8_STAGE(PG8_SB(0, 1), cB + hstep, voffB); PG8_STAGE_A(PG8_SA(0, 0), A0, 0, cur, 0); PG8_STAGE_A(PG8_SA(0, 1), A0, 0, cur, 1);
        if (wr == 1) PG8_BAR;
        PG8_WAIT_V(2); PG8_BAR;
        PG8_STAGE(PG8_SB(1, 0), cB + kstep, voffB); PG8_STAGE_A(PG8_SA(1, 0), A0 + kstep, 0, cur, 0); PG8_STAGE(PG8_SB(1, 1), cB + hstep + kstep, voffB);
        PG8_WAIT_V(6); PG8_BAR;
    } else {
        PG8_STAGE(PG8_SB(0, 0), cB, voffB); PG8_STAGE_A(PG8_SA(0, 0), A0, 0, cur, 0); PG8_STAGE(PG8_SB(0, 1), cB + hstep, voffB); PG8_STAGE_A(PG8_SA(0, 1), A0, 0, cur, 1);
        if (wr == 1) PG8_BAR;
        PG8_WAIT_V(4); PG8_BAR;
        PG8_STAGE(PG8_SB(1, 0), cB + kstep, voffB); PG8_STAGE_A(PG8_SA(1, 0), A0 + kstep, 0, cur, 0); PG8_STAGE(PG8_SB(1, 1), cB + hstep + kstep, voffB);
        PG8_WAIT_V(6); PG8_BAR;
    }
    for (;;) {
        const bool has_next = S.next(ui + 1, nxt);
        const char* nB = has_next ? (const char*)g.Bt + S.bbase(nxt, tstep) : cB;
        if (!has_next) nxt = cur;
        const int nui = has_next ? ui + 1 : ui;
#pragma unroll 1
        for (int t = 0; t < nt; t += 2) {
            const bool last = (t == nt - 2);
            const char* a1 = A0 + (size_t)(t + 1) * kstep;
            const char* a2 = last ? A0 : A0 + (size_t)(t + 2) * kstep; const char* b2 = last ? nB : cB + (size_t)(t + 2) * kstep;
            const int lui = last ? nui : ui; Unit lu; lu.pm = last ? nxt.pm : cur.pm; lu.pn = last ? nxt.pn : cur.pn; lu.e = last ? nxt.e : cur.e;
            const char* a3 = a2 + kstep; const char* b3 = b2 + kstep;
            if (last && has_next) S.a_ready(nxt);
            if constexpr (SP2) {
            PG8_LDB(B0, 0, 0); PG8_LDB(B1, 0, 1); PG8_SCHED; PG8_LDA(At, 0, 0); PG8_STAGE_A(PG8_SA(1, 1), a1, ui, cur, 1);
            PG8_WAIT_V(8); PG8_WAIT_L(0); PG8_BAR; PG8_MMA(0, 0, At, B0); PG8_MMA(0, 1, At, B1); PG8_BAR; PG8_SCHED;
            PG8_LDA(At, 0, 1); PG8_STAGE(PG8_SB(0, 0), b2, voffB); PG8_STAGE(PG8_SB(0, 1), b2 + hstep, voffB); PG8_STAGE_A(PG8_SA(0, 0), a2, lui, lu, 0);
            PG8_WAIT_V(8); PG8_WAIT_L(0); PG8_BAR; PG8_MMA(1, 0, At, B0); PG8_MMA(1, 1, At, B1); PG8_BAR; PG8_SCHED;
            PG8_LDB(B0, 1, 0); PG8_LDB(B1, 1, 1); PG8_SCHED; PG8_LDA(At, 1, 0); PG8_STAGE_A(PG8_SA(0, 1), a2, lui, lu, 1);
            PG8_WAIT_V(8); PG8_WAIT_L(0); PG8_BAR; PG8_MMA(0, 0, At, B0); PG8_MMA(0, 1, At, B1); PG8_BAR; PG8_SCHED;
            PG8_LDA(At, 1, 1); PG8_STAGE(PG8_SB(1, 0), b3, voffB); PG8_STAGE(PG8_SB(1, 1), b3 + hstep, voffB); PG8_STAGE_A(PG8_SA(1, 0), a3, lui, lu, 0);
            PG8_WAIT_V(8); PG8_WAIT_L(0); PG8_BAR; PG8_MMA(1, 0, At, B0); PG8_MMA(1, 1, At, B1); PG8_BAR; PG8_SCHED;
            } else {
            PG8_LDB(B0, 0, 0); PG8_SCHED; PG8_LDA(At, 0, 0); PG8_STAGE_A(PG8_SA(1, 1), a1, ui, cur, 1);
            PG8_WAIT_L(8); PG8_BAR; PG8_WAIT_L(0); PG8_MMA(0, 0, At, B0); PG8_BAR; PG8_SCHED;
            PG8_LDB(B1, 0, 1); PG8_STAGE(PG8_SB(0, 0), b2, voffB);
            PG8_BAR; PG8_WAIT_L(0); PG8_MMA(0, 1, At, B1); PG8_BAR;
            PG8_LDA(At, 0, 1); PG8_STAGE_A(PG8_SA(0, 0), a2, lui, lu, 0);
            PG8_BAR; PG8_WAIT_L(0); PG8_MMA(1, 0, At, B0); PG8_BAR; PG8_SCHED;
            PG8_STAGE(PG8_SB(0, 1), b2 + hstep, voffB);
            PG8_WAIT_V(6); PG8_BAR; PG8_MMA(1, 1, At, B1); PG8_BAR;
            PG8_LDB(B0, 1, 0); PG8_SCHED; PG8_LDA(At, 1, 0); PG8_STAGE_A(PG8_SA(0, 1), a2, lui, lu, 1);
            PG8_WAIT_L(8); PG8_BAR; PG8_WAIT_L(0); PG8_MMA(0, 0, At, B0); PG8_BAR; PG8_SCHED;
            PG8_LDB(B1, 1, 1); PG8_STAGE(PG8_SB(1, 0), b3, voffB);
            PG8_BAR; PG8_WAIT_L(0); PG8_MMA(0, 1, At, B1); PG8_BAR;
            PG8_LDA(At, 1, 1); PG8_STAGE_A(PG8_SA(1, 0), a3, lui, lu, 0);
            PG8_BAR; PG8_WAIT_L(0); PG8_MMA(1, 0, At, B0); PG8_BAR; PG8_SCHED;
            PG8_STAGE(PG8_SB(1, 1), b3 + hstep, voffB);
            PG8_WAIT_V(6); PG8_BAR; PG8_MMA(1, 1, At, B1); PG8_BAR;
            }
        }
        if constexpr (ALIGN_EPI) { if (wr == 0) PG8_BAR; }
        if constexpr (!Epi::AFTER_DRAIN) { E(acc, cur, wr, wc, fr, fq); S.done(cur); }
        if (!has_next) break;
#pragma unroll
        for (int a = 0; a < 2; ++a)
#pragma unroll
            for (int b = 0; b < 2; ++b)
#pragma unroll
                for (int m = 0; m < 4; ++m)
#pragma unroll
                    for (int n = 0; n < 2; ++n) acc[a][b][m][n] = (f32x4){0.f, 0.f, 0.f, 0.f};
        cur = nxt; cB = nB; ++ui;
        if constexpr (ALIGN_EPI) { if (wr == 1) PG8_BAR; }
    }
    PG8_WAIT_V(0);
    if constexpr (!ALIGN_EPI) { if (wr == 0) PG8_BAR; }
    PG8_BAR;
    if constexpr (Epi::AFTER_DRAIN) { E.fused(acc, cur, wr, wc, fr, fq, lds, wid, lane); S.done(cur); }
#undef PG8_STAGE_A
#undef PG8_SA
#undef PG8_SB
#undef PG8_STAGE
#undef PG8_LDA
#undef PG8_LDB
#undef PG8_MMA
#undef PG8_CAT
#undef PG8_WAIT_V
#undef PG8_WAIT_L
#undef PG8_BAR
#undef PG8_SCHED
}
}

constexpr size_t MiB = 1u << 20;
constexpr size_t WS_CTL = 0, CTL_ZERO_BYTES = 1 * MiB;
constexpr size_t WS_MODP = 1 * MiB;
constexpr size_t WS_MODF = 3 * MiB;
constexpr size_t WS_BIAS = 4 * MiB;
constexpr size_t WS_TOKE = 5 * MiB;
constexpr size_t WS_TOKP = 6 * MiB;
constexpr size_t WS_CNTC = 5 * MiB + 512 * 1024;
constexpr size_t WS_TOKW = 7 * MiB;
constexpr size_t WS_INV = 8 * MiB;
constexpr size_t WS_WIN = 10 * MiB;
constexpr size_t WS_WOUT = 15 * MiB;
constexpr size_t WS_X1 = 32 * MiB;
constexpr size_t WS_XN = 96 * MiB;
constexpr size_t WS_H2 = 128 * MiB;
constexpr size_t WS_PROJ = 160 * MiB;
constexpr size_t WS_O = 232 * MiB;
constexpr size_t WS_WGU = 264 * MiB;
constexpr size_t WS_WD = 392 * MiB;
constexpr size_t WS_ACT = 456 * MiB;
constexpr size_t WS_Y = 600 * MiB;
constexpr size_t WS_END = 744 * MiB;
constexpr int CW_TMO = 0, CW_CODE = 1;
constexpr int CW_CNT = 64;
constexpr int CW_BAR = 4096;
constexpr int CW_KSUM = 16384;
static_assert((CW_KSUM + 64 * 512) * 4 <= (int)CTL_ZERO_BYTES, "CTL region");
constexpr int RING_OFF = 0, RING_BYTES = 131072;
constexpr int LDSCTL_OFF = RING_BYTES, MISC_OFF = LDSCTL_OFF + 320;
constexpr int LDS_TILE_E = LDSCTL_OFF + 512;
constexpr int LDS_NT = LDS_TILE_E + MAXTILES * 4;
constexpr int LDS_TBASE = LDS_NT + 16;
constexpr int LDS_CNTE = LDS_TBASE + 128;
constexpr int LDS_RIDX = LDS_CNTE + 128;
constexpr int LDS_BYTES = 147456;
static_assert(LDS_RIDX % 16 == 0 && LDS_RIDX + 10 * 1024 <= LDS_BYTES, "LDS map");
constexpr int NWAVES = 8;

#define GAS __attribute__((address_space(1)))
#define LAS __attribute__((address_space(3)))
typedef unsigned short bf16;
typedef unsigned v4u __attribute__((ext_vector_type(4)));
typedef float f32x4 __attribute__((ext_vector_type(4)));
typedef short bf16x8 __attribute__((ext_vector_type(8)));
typedef GAS unsigned gu32;
typedef GAS unsigned long long gu64;
#define RLX_AGENT __ATOMIC_RELAXED, __HIP_MEMORY_SCOPE_AGENT
#define LDS_WAIT() asm volatile("s_waitcnt lgkmcnt(0)" ::: "memory")
#define VM_WAIT() asm volatile("s_waitcnt vmcnt(0)" ::: "memory")
__device__ __forceinline__ unsigned long long rt() { return __builtin_amdgcn_s_memrealtime(); }
__device__ __forceinline__ unsigned f2bf(float f) { unsigned u = __builtin_bit_cast(unsigned, f); return (u + 0x7fffu + ((u >> 16) & 1u)) >> 16; }
__device__ __forceinline__ unsigned pk2(float lo, float hi) { return f2bf(lo) | (f2bf(hi) << 16); }

#define XB_TMO      128
#define XB_XCNT(j)  (256  + 64 * (j))
#define XB_XSUB(j)  (1280 + 64 * (j))
#define XB_XGEN(j)  (2304 + 64 * (j))
#define XB_TOP      3328
#define XB_TOPGEN   3392
#define XCD_BAR_WORDS 3456
#define XB_SPIN_CAP (1u << 18)

__device__ __forceinline__ unsigned xb_ld(unsigned* p)              { return __hip_atomic_load(p, __ATOMIC_RELAXED, __HIP_MEMORY_SCOPE_AGENT); }
__device__ __forceinline__ unsigned xb_add(unsigned* p, unsigned v) { return __hip_atomic_fetch_add(p, v, __ATOMIC_RELAXED, __HIP_MEMORY_SCOPE_AGENT); }
__device__ __forceinline__ unsigned xb_xcc_id() { return (unsigned)__builtin_amdgcn_s_getreg((3 << 11) | 20) & 0xFu; }
#define XB_SPIN(cond, bar) do { unsigned _sp = 0; while (cond) { __builtin_amdgcn_s_sleep(1); \
    if ((++_sp & 255u) == 0u) { if (xb_ld(&(bar)[XB_TMO])) break; if (_sp > XB_SPIN_CAP) { atomicAdd(&(bar)[XB_TMO], 1u); break; } } } } while (0)

struct XcdBarrier {
    unsigned* bar; unsigned x;
    volatile LAS unsigned* st;
};

__device__ __forceinline__ XcdBarrier xcd_barrier_post(unsigned* bar, volatile LAS unsigned* st) {
    XcdBarrier b; b.bar = bar; b.x = xb_xcc_id(); b.st = st;
    if (threadIdx.x == 0) (void)xb_add(&bar[XB_XCNT(b.x)], 1u);
    return b;
}
__device__ __forceinline__ void xcd_barrier_complete(unsigned* bar, unsigned x, unsigned& nloc, unsigned& nx) {
    const unsigned G = gridDim.x * gridDim.y * gridDim.z;
    unsigned sum, cnt, mine, sp = 0u;
    for (;;) {
        sum = 0u; cnt = 0u; mine = 0u;
#pragma unroll
        for (unsigned j = 0; j < 16; ++j) { const unsigned c = xb_ld(&bar[XB_XCNT(j)]); sum += c; cnt += (c > 0u) ? 1u : 0u; mine = (j == x) ? c : mine; }
        if (sum == G) break;
        __builtin_amdgcn_s_sleep(1);
        if ((++sp & 255u) == 0u) { if (xb_ld(&bar[XB_TMO])) break; if (sp > XB_SPIN_CAP) { atomicAdd(&bar[XB_TMO], 1u); break; } }
    }
    nloc = mine > 0u ? mine : 1u; nx = cnt > 0u ? cnt : 1u;
}

__device__ __forceinline__ void xcd_barrier(const XcdBarrier& b) {
    asm volatile("s_waitcnt vmcnt(0)" ::: "memory");
    __syncthreads();
    if (threadIdx.x == 0) {
        unsigned* bar = b.bar;
        __builtin_amdgcn_s_waitcnt(0);
        unsigned nloc = b.st[0], nx = b.st[1];
        if (nloc == 0u) { xcd_barrier_complete(bar, b.x, nloc, nx); b.st[0] = nloc; b.st[1] = nx; }
        const unsigned old = xb_add(&bar[XB_XSUB(b.x)], 1u);
        const unsigned gen = old / nloc;
        if (old + 1u == (gen + 1u) * nloc) {
            __builtin_amdgcn_fence(__ATOMIC_RELEASE, "agent");
            asm volatile("s_waitcnt vmcnt(0)" ::: "memory");
            const unsigned og = xb_add(&bar[XB_TOP], 1u);
            const unsigned tg = og / nx;
            if (og + 1u == (tg + 1u) * nx) xb_add(&bar[XB_TOPGEN], 1u);
            else XB_SPIN(xb_ld(&bar[XB_TOPGEN]) == tg, bar);
            __builtin_amdgcn_fence(__ATOMIC_ACQUIRE, "agent");
            xb_add(&bar[XB_XGEN(b.x)], 1u);
            asm volatile("s_waitcnt vmcnt(0)" ::: "memory");
        } else {
            XB_SPIN(xb_ld(&bar[XB_XGEN(b.x)]) == gen, bar);
            __builtin_amdgcn_fence(__ATOMIC_ACQUIRE, "agent");
            asm volatile("s_waitcnt vmcnt(0)" ::: "memory");
        }
    }
    __syncthreads();
}

namespace att {
using bf16x8 = __attribute__((ext_vector_type(8))) short;
using s16x4 = __attribute__((ext_vector_type(4))) short;
using f32x16 = __attribute__((ext_vector_type(16))) float;
using u32x4 = __attribute__((ext_vector_type(4))) unsigned;
typedef unsigned short bf16;
constexpr int PITCH = D_IN, OPITCH = D;
constexpr int NSLOT = 4, SLOTB = 8192;
constexpr int TAB_PAD = 96;
constexpr int LDS_K = 0, LDS_V = NSLOT * SLOTB, LDS_WS = 2 * NSLOT * SLOTB, LDS_OST = LDS_WS + 8 * 64 * 4, LDS_TAB = LDS_OST + 8 * 4096, LDS_KMS = LDS_TAB + (TAB_PAD + SEQ) * 4, LDS_NINF = LDS_KMS + 8 * 64 * 4, LDS_END = LDS_NINF + 64 * 4;
static_assert(LDS_END <= 131072, "attention LDS");
__device__ __forceinline__ int crow(int r, int hi) { return (r & 3) + 8 * (r >> 2) + 4 * hi; }
__device__ __forceinline__ void glds16(const void* gsrc, unsigned lds_dst) { unsigned keep;
  asm volatile("s_mov_b32 %0, m0\n\ts_mov_b32 m0, %2\n\ts_nop 0\n\tglobal_load_lds_dwordx4 %1, off\n\ts_mov_b32 m0, %0" : "=&s"(keep) : "v"(gsrc), "s"(lds_dst) : "memory"); }
typedef float f32x2_t __attribute__((ext_vector_type(2))); typedef __bf16 bf16x2_t __attribute__((ext_vector_type(2)));
__device__ __forceinline__ unsigned cvtpk_s(float lo, float hi) { f32x2_t v = {lo, hi}; bf16x2_t b = __builtin_convertvector(v, bf16x2_t); return __builtin_bit_cast(unsigned, b); }
#define ATT_WAIT_BAR(N) asm volatile("s_waitcnt vmcnt(" #N ") lgkmcnt(0)\n\ts_barrier" ::: "memory")
#define ATT_LBAR() asm volatile("s_waitcnt lgkmcnt(0)\n\ts_barrier" ::: "memory")
typedef float f32x2v __attribute__((ext_vector_type(2)));
__device__ __forceinline__ void bias_loads(f32x2v (&bb)[16], unsigned tba) {
#pragma unroll
  for (int i = 0; i < 16; ++i) { asm volatile("ds_read2_b32 %0, %1 offset0:%c2 offset1:%c3" : "=v"(bb[i]) : "v"(tba), "i"((i >> 3) * 32 + ((2 * i) & 3) + 8 * (((2 * i) & 15) >> 2)), "i"((i >> 3) * 32 + ((2 * i) & 3) + 8 * (((2 * i) & 15) >> 2) + 1) : "memory"); }
}
__device__ __forceinline__ void k_loads(bf16x8 (&kf)[8], unsigned ka) {
#pragma unroll
  for (int i = 0; i < 8; ++i) asm volatile("ds_read_b128 %0, %1 offset:%c2" : "=v"(kf[i]) : "v"(ka), "i"((i >> 1) * 2048 + (i & 1) * 512) : "memory");
}
#define ATT_C16(bb, o) (f32x16){bb[o][0], bb[o][1], bb[o + 1][0], bb[o + 1][1], bb[o + 2][0], bb[o + 2][1], bb[o + 3][0], bb[o + 3][1], bb[o + 4][0], bb[o + 4][1], bb[o + 5][0], bb[o + 5][1], bb[o + 6][0], bb[o + 6][1], bb[o + 7][0], bb[o + 7][1]}
__device__ __forceinline__ void qk_mma(f32x16& p0, f32x16& p1, const bf16x8 (&kf)[8], const bf16x8* qr, const f32x2v (&bb)[16]) {
  p0 = __builtin_amdgcn_mfma_f32_32x32x16_bf16(kf[0], qr[0], ATT_C16(bb, 0), 0, 0, 0); p1 = __builtin_amdgcn_mfma_f32_32x32x16_bf16(kf[1], qr[0], ATT_C16(bb, 8), 0, 0, 0);
#pragma unroll
  for (int d0 = 1; d0 < 4; ++d0) { p0 = __builtin_amdgcn_mfma_f32_32x32x16_bf16(kf[2 * d0], qr[d0], p0, 0, 0, 0); p1 = __builtin_amdgcn_mfma_f32_32x32x16_bf16(kf[2 * d0 + 1], qr[d0], p1, 0, 0, 0); }
}
__device__ __forceinline__ void v_loads(s16x4 (&lo)[2][4], s16x4 (&hi)[2][4], int vb) {
#pragma unroll
  for (int d0 = 0; d0 < 2; ++d0)
#pragma unroll
    for (int ks = 0; ks < 4; ++ks) {
      asm volatile("ds_read_b64_tr_b16 %0,%1 offset:%c2" : "=&v"(lo[d0][ks]) : "v"(vb), "i"(d0 * 4096 + ks * 1024) : "memory");
      asm volatile("ds_read_b64_tr_b16 %0,%1 offset:%c2" : "=&v"(hi[d0][ks]) : "v"(vb), "i"(d0 * 4096 + ks * 1024 + 512) : "memory"); }
}
__device__ __forceinline__ void pv_mma(f32x16* o, const s16x4 (&lo)[2][4], const s16x4 (&hi)[2][4], bf16x8 pa0, bf16x8 pa1, bf16x8 pa2, bf16x8 pa3) {
#define ATT_PK(d, k) (bf16x8){lo[d][k][0], lo[d][k][1], lo[d][k][2], lo[d][k][3], hi[d][k][0], hi[d][k][1], hi[d][k][2], hi[d][k][3]}
#pragma unroll
  for (int d0 = 0; d0 < 2; ++d0) {
    o[d0] = __builtin_amdgcn_mfma_f32_32x32x16_bf16(pa0, ATT_PK(d0, 0), o[d0], 0, 0, 0);
    o[d0] = __builtin_amdgcn_mfma_f32_32x32x16_bf16(pa1, ATT_PK(d0, 1), o[d0], 0, 0, 0);
    o[d0] = __builtin_amdgcn_mfma_f32_32x32x16_bf16(pa2, ATT_PK(d0, 2), o[d0], 0, 0, 0);
    o[d0] = __builtin_amdgcn_mfma_f32_32x32x16_bf16(pa3, ATT_PK(d0, 3), o[d0], 0, 0, 0);
  }
#undef ATT_PK
}
#define ATT_LWAIT(N) do { asm volatile("s_waitcnt lgkmcnt(" #N ")" ::: "memory"); __builtin_amdgcn_sched_barrier(0); } while (0)
struct UnitDesc { int b, qb, moba, qcol, kcol, vcol, ocol, head, fill, fillk, gqa, q0; float sink2; };

__device__ __forceinline__ void attn_unit(const UnitDesc& u, const bf16* P, unsigned char* O, const float* biasT, const float* ksum, const float* sinks, char* shm) {
  int tid_ = threadIdx.x; asm volatile("" : "+v"(tid_));
  const int tid = tid_, lane = tid & 63, r32 = lane & 31, hi = lane >> 5; const int wid = __builtin_amdgcn_readfirstlane(tid >> 6);
  const long rowbase = (long)u.b * SEQ; const int q0 = u.q0;
  const int wg = u.gqa ? (wid & 3) : 0, wrow = u.gqa ? (wid >> 2) * 32 : wid * 32;
  constexpr int TSW = TAB_PAD + 192;
  const unsigned lds0 = (unsigned)(uintptr_t)shm;
  float* wsf = (float*)(shm + LDS_WS) + wid * 64;
  float* tab = (float*)(shm + LDS_TAB); float* kms = (float*)(shm + LDS_KMS);
  const int tlo = u.moba ? 0 : (q0 < 128 ? 0 : (q0 >> 6) - 2), thi = u.gqa ? (q0 >> 6) : u.qb * 4 + 3;
  const bf16* ksrc = P + (rowbase + lane) * PITCH + u.kcol + wid * 8;
  const bf16* vsrc = P + (rowbase + 16 * (wid & 3) + (lane >> 2)) * PITCH + u.vcol + (wid >> 2) * 32 + (lane & 3) * 8;
  const unsigned kdst = lds0 + LDS_K + wid * 1024, vdst = lds0 + LDS_V + wid * 1024;
#define ATT_DMA(t, slot) do { glds16(ksrc + (long)(t) * 64 * PITCH, (unsigned)__builtin_amdgcn_readfirstlane(kdst + (slot))); glds16(vsrc + (long)(t) * 64 * PITCH, (unsigned)__builtin_amdgcn_readfirstlane(vdst + (slot))); } while (0)
  const unsigned ka0 = lds0 + LDS_K + hi * 1024 + r32 * 16;
  const int vb0 = (int)(lds0 + LDS_V) + ((lane >> 4) & 1) * 32 + (lane & 3) * 8 + (4 * hi + ((lane & 15) >> 2)) * 64;
  ATT_DMA(tlo, 0); ATT_DMA(tlo + 1, SLOTB);
  if (u.fill) {
    if (u.gqa) { for (int i = tid; i < 4 * TSW; i += 512) { const int hh = i / TSW, j = i - hh * TSW; tab[i] = (j >= 192) ? 0.f : biasT[(u.head + hh) * SEQ + 191 - j]; } }
    else for (int i = tid; i < TAB_PAD + SEQ; i += 512) tab[i] = (i >= SEQ) ? 0.f : biasT[u.head * SEQ + SEQ - 1 - i];
    if (tid < 64) ((float*)(shm + LDS_NINF))[tid] = -INFINITY;
  }
  if (u.fillk) kms[tid] = ksum[(size_t)(u.b * 8 + (tid >> 6)) * D_MOBA + u.head * HD + (tid & 63)];
  const bf16* Qw = P + (rowbase + q0 + wrow) * PITCH + u.qcol + wg * HD;
  bf16x8 qr[4];
#pragma unroll
  for (int d0 = 0; d0 < 4; ++d0) qr[d0] = *reinterpret_cast<const bf16x8*>(&Qw[(long)r32 * PITCH + d0 * 16 + hi * 8]);
  if (u.fill || u.fillk) ATT_LBAR();
  unsigned selmask = 0u;
  if (u.moba) {
    if (u.qb <= MB_TOPK) selmask = (1u << u.qb) - 1u;
    else {
      float gate[MB_NB - 1];
#pragma unroll
      for (int n = 0; n < MB_NB - 1; ++n) { float s = 0.f;
        if (n < u.qb) {
#pragma unroll
          for (int d0 = 0; d0 < 4; ++d0)
#pragma unroll
            for (int j = 0; j < 8; ++j) s += __uint_as_float((unsigned)(unsigned short)qr[d0][j] << 16) * kms[n * 64 + d0 * 16 + hi * 8 + j];
          s += __shfl_xor(s, 32); }
        gate[n] = s; }
#pragma unroll
      for (int r = 0; r < MB_TOPK; ++r) { int best = -1; float bv = 0.f;
#pragma unroll
        for (int n = 0; n < MB_NB - 1; ++n) if (n < u.qb && !((selmask >> n) & 1u) && (best < 0 || gate[n] > bv)) { best = n; bv = gate[n]; }
        selmask |= 1u << best; }
    }
  }
  const int qrel = wrow + r32, qpos = q0 + qrel;
  const unsigned tabqa = lds0 + LDS_TAB + (unsigned)((wg * TSW + (u.gqa ? 191 : SEQ - 1) - qpos + 4 * hi) * 4), ninfa = lds0 + LDS_NINF;
  float m = -1e30f, l = 0.f; f32x16 o[2]; o[0] = f32x16{}; o[1] = f32x16{};
  const int wq0 = q0 + wrow;
#define ATT_FLAGS(tt, need_, emask_, lsel_) do { lsel_ = true; \
    if (u.moba) { const int n_ = (tt) >> 2; \
      if (n_ < u.qb) { lsel_ = ((selmask >> n_) & 1u) != 0u; need_ = __any(lsel_); emask_ = false; } \
      else { need_ = (64 * (tt) <= wq0 + 31); emask_ = (64 * (tt) + 63 > wq0); } } \
    else { need_ = (64 * (tt) <= wq0 + 31) && (64 * (tt) + 63 >= wq0 - (SWA_W - 1)); emask_ = (64 * (tt) + 63 > wq0) || (wq0 + 31 - 64 * (tt) >= SWA_W); } } while (0)
#define ATT_QK_LOADS(tt, kslot, lsel_) do { bias_loads(bb, (lsel_) ? tabqa + 256u * (unsigned)(tt) : ninfa); k_loads(kf, ka0 + (kslot)); } while (0)
  const int lim = u.moba ? 0x7fffffff : SWA_W;
  int slotp = 3 * SLOTB, slot = 0, slotn = SLOTB, slotf = 2 * SLOTB;
  f32x16 pc0 = {}, pc1 = {}, pn0 = {}, pn1 = {};
  u32x4 pw0 = {}, pw1 = {}, pw2 = {}, pw3 = {};
  bool needC, emaskC, lselC, needN = false, emaskN = false, lselN = true, needP = false;
  asm volatile("" :: "v"(qr[0]), "v"(qr[1]), "v"(qr[2]), "v"(qr[3]));
  ATT_WAIT_BAR(2);
  ATT_FLAGS(tlo, needC, emaskC, lselC);
  if (needC) { f32x2v bb[16]; bf16x8 kf[8]; ATT_QK_LOADS(tlo, slot, lselC); ATT_LWAIT(0); qk_mma(pc0, pc1, kf, qr, bb); }
  for (int t = tlo; t <= thi; ++t) {
    ATT_WAIT_BAR(0);
    if (t + 2 <= thi) ATT_DMA(t + 2, slotf);
    if (t + 1 <= thi) { ATT_FLAGS(t + 1, needN, emaskN, lselN); } else needN = false;
    if (needN) { f32x2v bb[16]; bf16x8 kf[8]; ATT_QK_LOADS(t + 1, slotn, lselN); ATT_LWAIT(0); qk_mma(pn0, pn1, kf, qr, bb); }
    if (needP) { s16x4 vlo[2][4], vhi[2][4]; v_loads(vlo, vhi, vb0 + slotp); ATT_LWAIT(0); pv_mma(o, vlo, vhi, __builtin_bit_cast(bf16x8, pw0), __builtin_bit_cast(bf16x8, pw1), __builtin_bit_cast(bf16x8, pw2), __builtin_bit_cast(bf16x8, pw3)); }
    __builtin_amdgcn_sched_barrier(0);
    if (needC) {
      f32x16 p0 = pc0, p1 = pc1;
      if (emaskC) { const int dq = qpos - 64 * t - 4 * hi;
#pragma unroll
        for (int r = 0; r < 16; ++r) { const int c = (r & 3) + 8 * (r >> 2);
          p0[r] = ((unsigned)(dq - c) < (unsigned)lim) ? p0[r] : -INFINITY; p1[r] = ((unsigned)(dq - c - 32) < (unsigned)lim) ? p1[r] : -INFINITY; } }
      float rm = fmaxf(p0[0], p1[0]);
#pragma unroll
      for (int r = 1; r < 16; ++r) rm = fmaxf(fmaxf(rm, p0[r]), p1[r]);
      rm = fmaxf(rm, __shfl_xor(rm, 32));
      if (__any(rm > m + 8.0f)) {
        const float mnew = fmaxf(m, rm), alpha = __builtin_amdgcn_exp2f(m - mnew);
        l *= alpha; m = mnew;
        if (hi == 0) wsf[r32] = alpha;
        asm volatile("s_waitcnt lgkmcnt(0)" ::: "memory");
#pragma unroll
        for (int r = 0; r < 16; ++r) { const float f = wsf[crow(r, hi)]; o[0][r] *= f; o[1][r] *= f; }
      }
      float ls = 0.f;
#pragma unroll
      for (int r = 0; r < 16; ++r) { p0[r] = __builtin_amdgcn_exp2f(p0[r] - m); p1[r] = __builtin_amdgcn_exp2f(p1[r] - m); ls += p0[r] + p1[r]; }
      l += ls;
#define ATT_PKW(Pv, B) cvtpk_s(Pv[B], Pv[B + 1])
      pw0 = (u32x4){ATT_PKW(p0, 0), ATT_PKW(p0, 2), ATT_PKW(p0, 4), ATT_PKW(p0, 6)}; pw1 = (u32x4){ATT_PKW(p0, 8), ATT_PKW(p0, 10), ATT_PKW(p0, 12), ATT_PKW(p0, 14)};
      pw2 = (u32x4){ATT_PKW(p1, 0), ATT_PKW(p1, 2), ATT_PKW(p1, 4), ATT_PKW(p1, 6)}; pw3 = (u32x4){ATT_PKW(p1, 8), ATT_PKW(p1, 10), ATT_PKW(p1, 12), ATT_PKW(p1, 14)};
#undef ATT_PKW
    }
    needP = needC; pc0 = pn0; pc1 = pn1; needC = needN; emaskC = emaskN; lselC = lselN;
    { const int s_ = slotp; slotp = slot; slot = slotn; slotn = slotf; slotf = s_; }
  }
  if (needP) { s16x4 vlo[2][4], vhi[2][4]; v_loads(vlo, vhi, vb0 + slotp); ATT_LWAIT(0); pv_mma(o, vlo, vhi, __builtin_bit_cast(bf16x8, pw0), __builtin_bit_cast(bf16x8, pw1), __builtin_bit_cast(bf16x8, pw2), __builtin_bit_cast(bf16x8, pw3)); }
#undef ATT_FLAGS
#undef ATT_QK_LOADS
  l += __shfl_xor(l, 32);
  if (!u.moba) l += __builtin_amdgcn_exp2f((u.gqa ? sinks[u.head - NH_M + wg] * LOG2E : u.sink2) - m);
  if (hi == 0) wsf[32 + r32] = l;
  asm volatile("s_waitcnt lgkmcnt(0)" ::: "memory");
  float rli[16];
#pragma unroll
  for (int r = 0; r < 16; ++r) rli[r] = __builtin_amdgcn_rcpf(wsf[32 + crow(r, hi)]);
  unsigned char* Ow = O + (rowbase + q0 + wrow) * OPITCH + u.ocol + wg * HD;
  { unsigned char* stg = (unsigned char*)(shm + LDS_OST) + wid * 2048;
#pragma unroll
    for (int r = 0; r < 16; ++r) { const int orow = crow(r, hi); const float sc = rli[r] * OSCALE;
#pragma unroll
      for (int d0 = 0; d0 < 2; ++d0) { const float v = o[d0][r] * sc; stg[orow * 64 + d0 * 32 + r32] = (unsigned char)(__builtin_amdgcn_cvt_pk_fp8_f32(v, v, 0, false) & 0xff); } }
    asm volatile("s_waitcnt lgkmcnt(0)" ::: "memory");
#pragma unroll
    for (int i = 0; i < 2; ++i) { const int row = i * 16 + (lane >> 2), ch = lane & 3; const u32x4 v = *(const u32x4*)(stg + row * 64 + ch * 16); *(u32x4*)(Ow + (long)row * OPITCH + ch * 16) = v; } }
  ATT_LBAR();
#undef ATT_DMA
}
}

struct Frame {
    LAS unsigned char* lds;
    volatile LAS unsigned* MISC;
    gu32* ctl;
    int tid, lane, wave, vcu, G;
};
__device__ __forceinline__ float wave_sum(float v) {
#pragma unroll
    for (int o = 1; o < 64; o <<= 1) v += __shfl_xor(v, o);
    return v;
}
__device__ __forceinline__ int rel_bucket(int dist) {
    const int n = dist > 0 ? dist : 0;
    if (n < 16) return n;
    const int th[15] = {21, 27, 35, 46, 59, 77, 99, 128, 166, 216, 280, 363, 470, 609, 790};
    int bk = 16;
#pragma unroll
    for (int i = 0; i < 15; ++i) bk += (n >= th[i]) ? 1 : 0;
    return bk;
}
__device__ __forceinline__ void p0_transpose_item(const float* W, int K, int N, bf16* WT, int k0, int n0, int dst_row0, LAS float* scr, int lane) {
    { float v[32]; const float* wp = W + (size_t)(k0 + (lane >> 5)) * N + n0 + (lane & 31);
#pragma unroll
        for (int i = 0; i < 32; ++i) v[i] = __builtin_nontemporal_load(wp + (size_t)(2 * i) * N);
#pragma unroll
        for (int i = 0; i < 32; ++i) scr[(2 * i + (lane >> 5)) * 33 + (lane & 31)] = v[i]; }
    LDS_WAIT(); asm volatile("" ::: "memory");
    const int c = lane & 7;
#pragma unroll
    for (int j = 0; j < 4; ++j) { const int n = (lane >> 3) + 8 * j; const LAS float* s = scr + (8 * c) * 33 + n;
        v4u o; o.x = pk2(s[0 * 33], s[1 * 33]); o.y = pk2(s[2 * 33], s[3 * 33]); o.z = pk2(s[4 * 33], s[5 * 33]); o.w = pk2(s[6 * 33], s[7 * 33]);
        *(GAS v4u*)(WT + (size_t)(dst_row0 + n) * K + k0 + 8 * c) = o; }
    LDS_WAIT(); asm volatile("" ::: "memory");
}
__device__ __forceinline__ void p0_transpose_item_f8(const float* W, int K, int N, unsigned char* WT, int k0, int n0, int dst_row0, LAS float* scr, int lane) {
    v4u o[2][2];
    const int c = lane & 3;
#pragma unroll
    for (int hf = 0; hf < 2; ++hf) {
        { float v[32]; const float* wp = W + (size_t)(k0 + 64 * hf + (lane >> 5)) * N + n0 + (lane & 31);
#pragma unroll
            for (int i = 0; i < 32; ++i) v[i] = __builtin_nontemporal_load(wp + (size_t)(2 * i) * N);
#pragma unroll
            for (int i = 0; i < 32; ++i) scr[(2 * i + (lane >> 5)) * 33 + (lane & 31)] = v[i]; }
        LDS_WAIT(); asm volatile("" ::: "memory");
#pragma unroll
        for (int j = 0; j < 2; ++j) { const int n = (lane >> 2) + 16 * j; const LAS float* s = scr + (16 * c) * 33 + n;
            o[hf][j].x = pg8::pk4_f8(s[0 * 33] * WSCALE, s[1 * 33] * WSCALE, s[2 * 33] * WSCALE, s[3 * 33] * WSCALE); o[hf][j].y = pg8::pk4_f8(s[4 * 33] * WSCALE, s[5 * 33] * WSCALE, s[6 * 33] * WSCALE, s[7 * 33] * WSCALE);
            o[hf][j].z = pg8::pk4_f8(s[8 * 33] * WSCALE, s[9 * 33] * WSCALE, s[10 * 33] * WSCALE, s[11 * 33] * WSCALE); o[hf][j].w = pg8::pk4_f8(s[12 * 33] * WSCALE, s[13 * 33] * WSCALE, s[14 * 33] * WSCALE, s[15 * 33] * WSCALE); }
        LDS_WAIT(); asm volatile("" ::: "memory");
    }
#pragma unroll
    for (int j = 0; j < 2; ++j) { const int n = (lane >> 2) + 16 * j; unsigned char* rp = WT + (size_t)(dst_row0 + n) * K + k0 + 16 * c;
        *(GAS v4u*)(rp) = o[0][j]; *(GAS v4u*)(rp + 64) = o[1][j]; }
}
__device__ __forceinline__ void conv_load_half(f32x4 (&x)[16], const float* src, int N, int hf, int lane) {
    const int q = lane >> 4, m = lane & 15; const float* sp = src + (size_t)(hf * 64 + 4 * q) * N + 4 * m;
#pragma unroll
    for (int g = 0; g < 4; ++g)
#pragma unroll
        for (int i = 0; i < 4; ++i) x[g * 4 + i] = __builtin_nontemporal_load((const f32x4*)(sp + (size_t)(16 * g + i) * N));
}
__device__ __forceinline__ void conv_cvt_half(const f32x4 (&x)[16], LAS unsigned* t8, int hf, int lane) {
    const int q = lane >> 4, m = lane & 15;
#pragma unroll
    for (int g = 0; g < 4; ++g)
#pragma unroll
        for (int j = 0; j < 4; ++j) t8[(4 * m + j) * 33 + hf * 16 + 4 * g + q] = pg8::pk4_f8(x[g * 4 + 0][j] * WSCALE, x[g * 4 + 1][j] * WSCALE, x[g * 4 + 2][j] * WSCALE, x[g * 4 + 3][j] * WSCALE);
}
__device__ __forceinline__ void conv_store(unsigned char* dst, const LAS unsigned* t8, int lane) {
#pragma unroll
    for (int jj = 0; jj < 8; ++jj) { const int n = (lane >> 3) + 8 * jj, c = lane & 7; const LAS unsigned* rp = t8 + n * 33 + 4 * c;
        *(GAS v4u*)(dst + (size_t)n * 1024 + 16 * c) = (v4u){rp[0], rp[1], rp[2], rp[3]}; }
}
struct Args { const float* in[19]; float* out; unsigned char* ws; int ph_lo, ph_hi; };

__device__ __forceinline__ void p0_prologue(Frame& F, const Args& a) {
    LAS float* scr = (LAS float*)(F.lds + RING_OFF + F.wave * 16384);
    const int gw = F.vcu * NWAVES + F.wave, NGW = F.G * NWAVES;
    const float* w_in = a.in[5]; const float* w_out = a.in[7];
    constexpr int I_IN = 8 * (D_IN / 32), I_OUT = 8 * (D / 32), I_MOD = 96 * 8, I_BIAS = 16 * SEQ / 64;
    constexpr int NITEMS = I_IN + I_OUT + I_MOD + I_BIAS;
    for (int k = 0; k * NGW < NITEMS; ++k) {
        const int it = k * NGW + ((k & 1) ? NGW - 1 - gw : gw); if (it >= NITEMS) continue;
        int r = it;
        if (r < I_MOD) {
            const int cc = r % 96, ks = r / 96, j = cc * 64 + F.lane;
            const float* c = a.in[1]; const float* w_ada = a.in[3];
            { const int b = F.lane >> 3, kq = (F.lane & 7) * 16;
#pragma unroll
                for (int i = 0; i < 16; ++i) { const float cv = c[b * D + ks * 128 + kq + i]; scr[b * 128 + kq + i] = cv / (1.f + expf(-cv)); } }
            LDS_WAIT(); asm volatile("" ::: "memory");
            float acc[BATCH];
#pragma unroll
            for (int b = 0; b < BATCH; ++b) acc[b] = 0.f;
            const float* wp = w_ada + (size_t)(ks * 128) * (6 * D) + j;
#pragma unroll 1
            for (int k0 = 0; k0 < 128; k0 += 128) { float w[128];
#pragma unroll
                for (int i = 0; i < 128; ++i) w[i] = __builtin_nontemporal_load(wp + (size_t)(k0 + i) * (6 * D));
#pragma unroll
                for (int i = 0; i < 128; ++i)
#pragma unroll
                    for (int b = 0; b < BATCH; ++b) acc[b] += scr[b * 128 + k0 + i] * w[i]; }
            LDS_WAIT(); asm volatile("" ::: "memory");
            float* mp = (float*)(a.ws + WS_MODP) + (size_t)ks * BATCH * 6 * D;
#pragma unroll
            for (int b = 0; b < BATCH; ++b) mp[(size_t)b * 6 * D + j] = acc[b];
            continue;
        }
        r -= I_MOD;
        if (r < I_BIAS) { const int i = r * 64 + F.lane, h = i / SEQ, d = i % SEQ; ((float*)(a.ws + WS_BIAS))[i] = a.in[9][rel_bucket(d) * 16 + h] * LOG2E; continue; }
        r -= I_BIAS;
        if (r < I_IN) { const int nb = r % (D_IN / 32), kb = r / (D_IN / 32); p0_transpose_item_f8(w_in, D, D_IN, a.ws + WS_WIN, kb * 128, nb * 32, nb * 32, scr, F.lane); continue; }
        r -= I_IN;
        { const int nb = r % (D / 32), kb = r / (D / 32); p0_transpose_item_f8(w_out, D, D, a.ws + WS_WOUT, kb * 128, nb * 32, nb * 32, scr, F.lane); }
    }
}
constexpr int CV_GU = NE * 8 * (2 * DFF / 64), CV_DN = NE * 8 * (D / 64), CV_ITEMS = CV_GU + CV_DN;
struct ConvItem { const float* src; unsigned char* dst; int N; };
__device__ __forceinline__ ConvItem conv_addr(const Args& a, int r) {
    const float* w_gu = a.in[14]; const float* w_down = a.in[16]; unsigned char* Wgu_t = a.ws + WS_WGU; unsigned char* Wd_t = a.ws + WS_WD; ConvItem c;
    if (r < CV_GU) { const int per = 8 * (2 * DFF / 64), e = r / per, q = r % per, nb = q % (2 * DFF / 64), kb = q / (2 * DFF / 64), n0 = nb * 64;
        const int drow = (n0 < DFF) ? ((n0 >> 7) * 256 + (n0 & 127)) : (((n0 - DFF) >> 7) * 256 + 128 + ((n0 - DFF) & 127));
        c.src = w_gu + (size_t)e * D * 2 * DFF + (size_t)(kb * 128) * (2 * DFF) + n0; c.N = 2 * DFF; c.dst = Wgu_t + (size_t)e * 2 * DFF * D + (size_t)drow * D + kb * 128; }
    else { const int rr = r - CV_GU, per = 8 * (D / 64), e = rr / per, q = rr % per, nb = q % (D / 64), kb = q / (D / 64), n0 = nb * 64;
        c.src = w_down + (size_t)e * DFF * D + (size_t)(kb * 128) * D + n0; c.N = D; c.dst = Wd_t + (size_t)e * D * DFF + (size_t)n0 * DFF + kb * 128; }
    return c;
}
__device__ __forceinline__ void conv_range(Frame& F, const Args& a, int lo, int hi, int first, int stride) {
    LAS unsigned* scr = (LAS unsigned*)(F.lds + RING_OFF + F.wave * 16384);
    int r = lo + first; if (r >= hi) return;
    ConvItem cur = conv_addr(a, r);
    f32x4 xa[16], xb[16];
    conv_load_half(xa, cur.src, cur.N, 0, F.lane); conv_load_half(xb, cur.src, cur.N, 1, F.lane);
#pragma unroll 1
    for (;;) {
        const int rn = r + stride; const bool more = rn < hi;
        const ConvItem nxt = conv_addr(a, more ? rn : r);
        conv_cvt_half(xa, scr, 0, F.lane); conv_load_half(xa, nxt.src, nxt.N, 0, F.lane);
        conv_cvt_half(xb, scr, 1, F.lane); conv_load_half(xb, nxt.src, nxt.N, 1, F.lane);
        LDS_WAIT(); asm volatile("" ::: "memory");
        conv_store(cur.dst, scr, F.lane);
        LDS_WAIT(); asm volatile("" ::: "memory");
        if (!more) break;
        cur = nxt; r = rn;
    }
}
__device__ __forceinline__ void p1_xn(Frame& F, const Args& a) {
    const float* modp = (const float*)(a.ws + WS_MODP); const float* b_ada = a.in[4]; float* modf = (float*)(a.ws + WS_MODF);
    for (int i = blockIdx.x * 512 + F.tid; i < BATCH * 6 * D; i += F.G * 512) { float s = b_ada[i % (6 * D)];
#pragma unroll
        for (int ks = 0; ks < 8; ++ks) s += modp[(size_t)ks * BATCH * 6 * D + i];
        modf[i] = s; }
    LAS float* tab = (LAS float*)(F.lds + RING_OFF);
    const float* x = a.in[0]; const float* g = a.in[2]; unsigned char* XN = a.ws + WS_XN;
    for (int chunk = blockIdx.x; chunk < NTOK / 64; chunk += F.G) {
        const int b = chunk / (SEQ / 64);
        f32x4 v[8][4];
#pragma unroll
        for (int q = 0; q < 8; ++q) { const GAS f32x4* xr = (const GAS f32x4*)(x + (size_t)(chunk * 64 + F.wave + q * NWAVES) * D) + F.lane;
#pragma unroll
            for (int j = 0; j < 4; ++j) v[q][j] = xr[64 * j]; }
        __syncthreads();
        for (int i = F.tid; i < 2 * D; i += 512) { const int col = i & (D - 1), chunkid = (i < D) ? 1 : 0; float s = b_ada[chunkid * D + col];
#pragma unroll
            for (int ks = 0; ks < 8; ++ks) s += modp[(size_t)ks * BATCH * 6 * D + (size_t)b * 6 * D + chunkid * D + col];
            tab[i] = (i < D) ? g[col] * (1.f + s) : s; }
        __syncthreads();
#pragma unroll
        for (int q = 0; q < 8; ++q) { float s = 0.f;
#pragma unroll
            for (int j = 0; j < 4; ++j) s += (v[q][j].x * v[q][j].x + v[q][j].y * v[q][j].y) + (v[q][j].z * v[q][j].z + v[q][j].w * v[q][j].w);
            const float rstd = 1.f / sqrtf(wave_sum(s) * (1.f / D) + EPS);
            GAS unsigned* o4 = (GAS unsigned*)(XN + (size_t)(chunk * 64 + F.wave + q * NWAVES) * D) + F.lane;
#pragma unroll
            for (int j = 0; j < 4; ++j) { const int col = 4 * F.lane + 256 * j; const f32x4 gs = *(const LAS f32x4*)(tab + col), sh = *(const LAS f32x4*)(tab + D + col);
                const f32x4 h = v[q][j] * rstd * gs + sh;
                o4[64 * j] = pg8::pk4_f8(h.x, h.y, h.z, h.w); } }
    }
}

__device__ __forceinline__ void p5_router(Frame& F, const Args& a) {
    typedef __attribute__((ext_vector_type(8))) short bx8; typedef __attribute__((ext_vector_type(16))) float fx16;
    const unsigned short* x1 = (const unsigned short*)(a.ws + WS_X1); const float* modf = (const float*)(a.ws + WS_MODF); const float* g_ffn = a.in[11]; const float* w_router = a.in[12]; const float* b_router = a.in[13];
    unsigned char* H2 = a.ws + WS_H2; int* inv = (int*)(a.ws + WS_INV); float* tok_w = (float*)(a.ws + WS_TOKW);
    LAS float* part = (LAS float*)(F.lds + RING_OFF);
    LAS float* ssq = (LAS float*)(F.lds + RING_OFF + 32768);
    LAS float* cpart = (LAS float*)(F.lds + RING_OFF + 32768 + 1024);
    LAS float* lg = (LAS float*)(F.lds + RING_OFF + 57344);
    LAS float* rs = (LAS float*)(F.lds + RING_OFF + 32768 + 3072 + 4352);
    LAS float* gsl = (LAS float*)(F.lds + RING_OFF + 49152);
    LAS float* shl = (LAS float*)(F.lds + RING_OFF + 49152 + 4096);
    const int lane = F.lane, w = F.wave, r32 = lane & 31, hi = lane >> 5;
#pragma unroll 1
    for (int chunk = blockIdx.x; chunk < NTOK / 64; chunk += F.G) {
        const int b = chunk / (SEQ / 64);
        __syncthreads();
        for (int i = F.tid; i < D; i += NWAVES * 64) { gsl[i] = g_ffn[i] * (1.f + modf[(size_t)b * 6 * D + 4 * D + i]); shl[i] = modf[(size_t)b * 6 * D + 3 * D + i]; }
        __syncthreads();
        bx8 ahi[8], alo[8]; float cp = 0.f;
        const float* wrp = w_router + (size_t)(128 * w + 8 * hi) * NE + r32; const LAS float* gsp = gsl + 128 * w + 8 * hi; const LAS float* shp = shl + 128 * w + 8 * hi;
#pragma unroll
        for (int s = 0; s < 8; ++s) {
            unsigned ph[4], pl[4];
#pragma unroll
            for (int j2 = 0; j2 < 4; ++j2) { float v[2];
#pragma unroll
                for (int q = 0; q < 2; ++q) { const int kk = 16 * s + 2 * j2 + q; const float wr_ = wrp[kk * NE]; cp += shp[kk] * wr_; v[q] = gsp[kk] * wr_; }
                const unsigned h0 = f2bf(v[0]), h1 = f2bf(v[1]); ph[j2] = h0 | (h1 << 16);
                pl[j2] = f2bf(v[0] - __uint_as_float(h0 << 16)) | (f2bf(v[1] - __uint_as_float(h1 << 16)) << 16); }
            ahi[s] = __builtin_bit_cast(bx8, (v4u){ph[0], ph[1], ph[2], ph[3]}); alo[s] = __builtin_bit_cast(bx8, (v4u){pl[0], pl[1], pl[2], pl[3]});
        }
        cpart[(w * 2 + hi) * 32 + r32] = cp;
#pragma unroll 1
        for (int pass = 0; pass < 2; ++pass) {
            const int tok = chunk * 64 + pass * 32 + r32;
            const unsigned short* xr = x1 + (size_t)tok * D + 128 * w + 8 * hi;
            float ss = 0.f; fx16 acc = {};
#pragma unroll
            for (int s = 0; s < 8; ++s) {
                const v4u xw = *(const GAS v4u*)(xr + 16 * s);
#pragma unroll
                for (int q = 0; q < 4; ++q) { const float v0 = __uint_as_float(xw[q] << 16), v1 = __uint_as_float(xw[q] & 0xffff0000u); ss += v0 * v0 + v1 * v1; }
                const bx8 bhi = __builtin_bit_cast(bx8, xw);
                acc = __builtin_amdgcn_mfma_f32_32x32x16_bf16(ahi[s], bhi, acc, 0, 0, 0);
                acc = __builtin_amdgcn_mfma_f32_32x32x16_bf16(alo[s], bhi, acc, 0, 0, 0);
            }
            ss += __shfl_xor(ss, 32);
            __syncthreads();
#pragma unroll
            for (int r = 0; r < 16; ++r) part[(w * 32 + ((r & 3) + 8 * (r >> 2) + 4 * hi)) * 32 + r32] = acc[r];
            if (hi == 0) ssq[w * 32 + r32] = ss;
            __syncthreads();
            { const int tk = F.tid & 31, eg = F.tid >> 5;
                float sq = 0.f;
#pragma unroll
                for (int ww = 0; ww < 8; ++ww) sq += ssq[ww * 32 + tk];
                const float rstd = 1.f / sqrtf(sq * (1.f / D) + EPS);
                if (eg == 0) rs[tk] = rstd;
#pragma unroll
                for (int q = 0; q < 2; ++q) { const int e = 2 * eg + q; float sum = 0.f, c = b_router[e];
#pragma unroll
                    for (int ww = 0; ww < 8; ++ww) sum += part[(ww * 32 + e) * 32 + tk];
#pragma unroll
                    for (int ww = 0; ww < 16; ++ww) c += cpart[ww * 32 + e];
                    lg[(pass * 32 + tk) * 33 + e] = rstd * sum + c; } }
            __syncthreads();
            { const float rstd = rs[r32]; unsigned char* hr = H2 + (size_t)tok * D + 128 * w + 8 * hi;
#pragma unroll
                for (int s = 0; s < 8; ++s) { unsigned pk[2]; const v4u xw = *(const GAS v4u*)(xr + 16 * s);
#pragma unroll
                    for (int q = 0; q < 2; ++q) { const f32x4 xv = {__uint_as_float(xw[2 * q] << 16), __uint_as_float(xw[2 * q] & 0xffff0000u), __uint_as_float(xw[2 * q + 1] << 16), __uint_as_float(xw[2 * q + 1] & 0xffff0000u)};
                        const f32x4 g4 = *(const LAS f32x4*)(gsp + 16 * s + 4 * q), h4 = *(const LAS f32x4*)(shp + 16 * s + 4 * q);
                        const f32x4 hv = xv * rstd * g4 + h4; pk[q] = pg8::pk4_f8(hv.x, hv.y, hv.z, hv.w); }
                    *(GAS unsigned long long*)(hr + 16 * s) = (unsigned long long)pk[0] | ((unsigned long long)pk[1] << 32); } }
        }
        __syncthreads();
        if (w == 0) {
            float lgv[NE];
#pragma unroll
            for (int i = 0; i < NE; ++i) lgv[i] = lg[lane * 33 + i];
            int idx[TOPK]; float val[TOPK]; unsigned used = 0;
#pragma unroll
            for (int r = 0; r < TOPK; ++r) { int best = -1; float bv = 0.f;
#pragma unroll
                for (int i = 0; i < NE; ++i) if (!((used >> i) & 1u) && (best < 0 || lgv[i] > bv)) { best = i; bv = lgv[i]; }
                used |= 1u << best; idx[r] = best; val[r] = bv; }
            float wsum = 0.f, wv[TOPK];
#pragma unroll
            for (int r = 0; r < TOPK; ++r) { wv[r] = __expf(val[r] - val[0]); wsum += wv[r]; }
            const int tk = chunk * 64 + lane; const float inv_ws = 1.f / wsum;
            const unsigned selbits = (1u << idx[0]) | (1u << idx[1]) | (1u << idx[2]) | (1u << idx[3]);
            int rk[TOPK] = {0, 0, 0, 0}; int cnt = 0;
#pragma unroll 1
            for (int e = 0; e < NE; ++e) {
                const unsigned long long mm = __ballot((selbits >> e) & 1u);
                const int rnk = __popcll(mm & ((1ull << lane) - 1ull));
#pragma unroll
                for (int r = 0; r < TOPK; ++r) if (idx[r] == e) rk[r] = rnk;
                if (lane == e) cnt = __popcll(mm);
            }
#pragma unroll
            for (int r = 0; r < TOPK; ++r) { inv[((size_t)chunk * NE + idx[r]) * 64 + rk[r]] = tk * 4 + r; tok_w[tk * 4 + r] = wv[r] * inv_ws; }
            if (lane < NE) ((int*)(a.ws + WS_CNTC))[lane * 256 + chunk] = cnt;
        }
    }
}
__device__ __forceinline__ void build_tiles(Frame& F, const Args& a) {
    LAS int* tile_e = (LAS int*)(F.lds + LDS_TILE_E); LAS int* ntl = (LAS int*)(F.lds + LDS_NT); LAS int* tbase = (LAS int*)(F.lds + LDS_TBASE); LAS int* cnte = (LAS int*)(F.lds + LDS_CNTE);
    LAS int* pre = (LAS int*)(F.lds + RING_OFF);
    __syncthreads();
    { const int e = F.tid >> 4, part = F.tid & 15; const int* cp = (const int*)(a.ws + WS_CNTC) + e * 256 + part * 16;
        int v[16]; int sum = 0;
#pragma unroll
        for (int q = 0; q < 4; ++q) { const int4 t4 = *(const int4*)(cp + 4 * q); v[4 * q] = t4.x; v[4 * q + 1] = t4.y; v[4 * q + 2] = t4.z; v[4 * q + 3] = t4.w; }
#pragma unroll
        for (int q = 0; q < 16; ++q) { const int t = v[q]; v[q] = sum; sum += t; }
        int inc = sum;
#pragma unroll
        for (int d = 1; d < 16; d <<= 1) { const int n = __shfl_up(inc, d, 16); if (part >= d) inc += n; }
        const int excl = inc - sum;
#pragma unroll
        for (int q = 0; q < 16; ++q) pre[e * 256 + part * 16 + q] = excl + v[q];
        if (part == 15) cnte[e] = inc; }
    __syncthreads();
    if (F.tid < NE) { const int e = F.tid, nt = (cnte[e] + 255) >> 8; int inc = nt;
#pragma unroll
        for (int d = 1; d < NE; d <<= 1) { const int n = __shfl_up(inc, d, NE); if (e >= d) inc += n; }
        const int base = inc - nt; tbase[e] = base; for (int j = 0; j < nt; ++j) tile_e[base + j] = e;
        if (e == NE - 1) ntl[0] = inc; }
    __syncthreads();
}
__device__ __forceinline__ void p8_final(Frame& F, const Args& a) {
    const unsigned short* x1 = (const unsigned short*)(a.ws + WS_X1); const unsigned char* Y = a.ws + WS_Y; const float* modf = (const float*)(a.ws + WS_MODF);
    const int* tok_slot = (const int*)(a.ws + WS_TOKP); const float* tok_w = (const float*)(a.ws + WS_TOKW);
    const float* gfin = a.in[18];
    const int gw = F.vcu * NWAVES + F.wave, NGW = F.G * NWAVES;
    constexpr int P8R = 4;
    typedef int i32x4 __attribute__((ext_vector_type(4)));
    i32x4 np[P8R]; f32x4 nw[P8R];
#define P8_ROUTE(r0) do { _Pragma("unroll") for (int _q = 0; _q < P8R; ++_q) { const int _r = (r0) + _q * NGW; if (_r < NTOK) { np[_q] = *(const GAS i32x4*)(tok_slot + _r * 4); nw[_q] = *(const GAS f32x4*)(tok_w + _r * 4); } } } while (0)
    P8_ROUTE(gw);
    for (int row0 = gw; row0 < NTOK; row0 += P8R * NGW) {
        i32x4 cp[P8R]; f32x4 cw[P8R];
#pragma unroll
        for (int q = 0; q < P8R; ++q) { cp[q] = np[q]; cw[q] = nw[q]; }
        unsigned yv[P8R][TOPK][4]; pg8::u32x2 xv[P8R][4];
#pragma unroll
        for (int q = 0; q < P8R; ++q) { const int row = row0 + q * NGW; if (row < NTOK) {
#pragma unroll
            for (int k = 0; k < TOPK; ++k) { const int slot = __builtin_amdgcn_readfirstlane(cp[q][k]);
                const GAS unsigned* yr = (const GAS unsigned*)(Y + (size_t)slot * D) + F.lane;
#pragma unroll
                for (int j = 0; j < 4; ++j) yv[q][k][j] = yr[64 * j]; }
            const GAS pg8::u32x2* xr = (const GAS pg8::u32x2*)(x1 + (size_t)row * D) + F.lane;
#pragma unroll
            for (int j = 0; j < 4; ++j) xv[q][j] = xr[64 * j]; } }
        P8_ROUTE(row0 + P8R * NGW);
#pragma unroll
        for (int q = 0; q < P8R; ++q) { const int row = row0 + q * NGW; if (row < NTOK) {
            const int b = row / SEQ; const float* gf = modf + (size_t)b * 6 * D + 5 * D;
            f32x4 acc[4];
#pragma unroll
            for (int j = 0; j < 4; ++j) acc[j] = (f32x4){0.f, 0.f, 0.f, 0.f};
#pragma unroll
            for (int k = 0; k < TOPK; ++k) { const float wk = cw[q][k] * (1.0f / YSCALE);
#pragma unroll
                for (int j = 0; j < 4; ++j) { const int qq = (int)yv[q][k][j]; const auto lo = __builtin_amdgcn_cvt_pk_f32_fp8(qq, false), hi = __builtin_amdgcn_cvt_pk_f32_fp8(qq, true);
                    acc[j].x += wk * lo[0]; acc[j].y += wk * lo[1]; acc[j].z += wk * hi[0]; acc[j].w += wk * hi[1]; } }
            float s = 0.f; f32x4 v[4];
#pragma unroll
            for (int j = 0; j < 4; ++j) { const f32x4 g4 = *(const GAS f32x4*)(gf + 4 * F.lane + 256 * j); const f32x4 x4 = {__uint_as_float(xv[q][j].x << 16), __uint_as_float(xv[q][j].x & 0xffff0000u), __uint_as_float(xv[q][j].y << 16), __uint_as_float(xv[q][j].y & 0xffff0000u)}; v[j] = x4 + g4 * acc[j]; s += (v[j].x * v[j].x + v[j].y * v[j].y) + (v[j].z * v[j].z + v[j].w * v[j].w); }
            const float rstd = 1.f / sqrtf(wave_sum(s) * (1.f / D) + EPS);
            GAS f32x4* orow = (GAS f32x4*)(a.out + (size_t)row * D) + F.lane;
#pragma unroll
            for (int j = 0; j < 4; ++j) { const f32x4 g4 = *(const GAS f32x4*)(gfin + 4 * F.lane + 256 * j); __builtin_nontemporal_store(v[j] * rstd * g4, orow + 64 * j); } } }
    }
#undef P8_ROUTE
}
__device__ __forceinline__ void build_ridx(Frame& F, const Args& a, int nN) {
    const LAS int* tile_e = (const LAS int*)(F.lds + LDS_TILE_E); const LAS int* tbase = (const LAS int*)(F.lds + LDS_TBASE); const LAS int* cnte = (const LAS int*)(F.lds + LDS_CNTE);
    const LAS int* pre = (const LAS int*)(F.lds + RING_OFF); const int ntiles = *(const LAS int*)(F.lds + LDS_NT);
    LAS int* ridx = (LAS int*)(F.lds + LDS_RIDX); const int* lists = (const int*)(a.ws + WS_INV); int* tok_slot = (int*)(a.ws + WS_TOKP);
    int adr[5], slot[5], flag[5];
#pragma unroll
    for (int k = 0; k < 5; ++k) { const int it = F.tid + k * (NWAVES * 64), i = it >> 8, r = it & 255; int t, pn_; flag[k] = 0; adr[k] = 0; slot[k] = 0;
        if (pg8::moe_unit(i, (int)blockIdx.x, F.G, nN, cnte, tbase, ntiles, t, pn_)) {
            const int e = tile_e[t], j = t - tbase[e], c = cnte[e]; int pos = j * 256 + r; const bool real = pos < c; if (!real) pos = 0;
            int lo = 0;
#pragma unroll
            for (int st = 128; st >= 1; st >>= 1) if (pre[e * 256 + lo + st] <= pos) lo += st;
            adr[k] = (lo * NE + e) * 64 + (pos - pre[e * 256 + lo]); slot[k] = t * 256 + r; flag[k] = (pn_ == 0 && real) ? 2 : 1; } }
    int ent[5];
#pragma unroll
    for (int k = 0; k < 5; ++k) ent[k] = flag[k] ? lists[adr[k]] : 0;
#pragma unroll
    for (int k = 0; k < 5; ++k) if (flag[k]) { ridx[F.tid + k * (NWAVES * 64)] = ent[k] >> 2; if (flag[k] == 2) tok_slot[ent[k]] = slot[k]; }
    __syncthreads();
}

__global__ void __launch_bounds__(NWAVES * 64, 2) mega_fwd(Args args) {
    extern __shared__ __attribute__((aligned(16))) unsigned char lds[];
    Frame F;
    F.lds = (LAS unsigned char*)lds;
    F.MISC = (volatile LAS unsigned*)(F.lds + MISC_OFF);
    F.tid = threadIdx.x; F.lane = F.tid & 63; F.wave = __builtin_amdgcn_readfirstlane(F.tid >> 6);
    F.G = gridDim.x; { const int bx = blockIdx.x; F.vcu = (F.G % 8 == 0) ? (bx % 8) * (F.G / 8) + bx / 8 : bx; }
    unsigned char* ws = args.ws;
    F.ctl = (gu32*)(ws + WS_CTL);
    for (int u = F.tid; u < 512 / 4; u += NWAVES * 64) ((LAS unsigned*)(F.lds + LDSCTL_OFF))[u] = 0u;
    __syncthreads();
    XcdBarrier bar = xcd_barrier_post((unsigned*)(F.ctl + CW_BAR), F.MISC + 8);
    const int lo = args.ph_lo, hi = args.ph_hi;
#ifndef PHASE_MASK
#define PHASE_MASK 0x1ff
#endif
#define IN(k) (((PHASE_MASK >> (k)) & 1) && lo <= (k) && (k) < hi)
#define BOTH(k) (IN(k) && IN((k) + 1))
#define GRID_BAR() xcd_barrier(bar)
#define REFRESH() do { int t_ = threadIdx.x; asm volatile("" : "+v"(t_)); F.tid = t_; F.lane = t_ & 63; F.wave = __builtin_amdgcn_readfirstlane(t_ >> 6); } while (0)
    const bool split = (F.G == 256); constexpr int NCONV = 64, NCONV3 = 80;
    const bool is_conv = split && (int)blockIdx.x >= F.G - NCONV, is_conv3 = split && (int)blockIdx.x >= F.G - NCONV3;
    const int NC = split ? F.G - NCONV : F.G, NC3 = split ? F.G - NCONV3 : F.G, cidx = (int)blockIdx.x;
    const int nconvw = (split ? NCONV : F.G) * NWAVES, convw = (split ? (int)blockIdx.x - (F.G - NCONV) : (int)blockIdx.x) * NWAVES;
    const int nconvw3 = (split ? NCONV3 : F.G) * NWAVES, convw3 = (split ? (int)blockIdx.x - (F.G - NCONV3) : (int)blockIdx.x) * NWAVES;
    constexpr int CV_SPLIT = 1792;
    if (IN(0)) { p0_prologue(F, args); if (!split) conv_range(F, args, 0, CV_ITEMS, F.vcu * NWAVES + F.wave, F.G * NWAVES); if (BOTH(0)) GRID_BAR(); }
    if (IN(1)) { REFRESH(); p1_xn(F, args); if (BOTH(1)) GRID_BAR(); }
    if (IN(2)) {
        if (is_conv) { REFRESH(); conv_range(F, args, 0, CV_SPLIT, convw + F.wave, nconvw); }
        else {
            pg8::Gemm g{(const bf16*)(ws + WS_XN), (const bf16*)(ws + WS_WIN), NTOK, D_IN, D / 2}; pg8::StaticOrder S; S.init(NTOK, D_IN, NC, cidx);
            pg8::EpiProj E{(bf16*)(ws + WS_PROJ), args.in[6], (float*)(F.ctl + CW_KSUM)};
            pg8::gemm_phase<pg8::EpiProj, pg8::StaticOrder, false, true, true>(F.lds + RING_OFF, g, S, E);
        }
        if (BOTH(2)) GRID_BAR();
    }
    if (IN(3)) {
        if (is_conv3) { REFRESH(); conv_range(F, args, CV_SPLIT, CV_ITEMS, convw3 + F.wave, nconvw3); }
        else {
            const float* sinks = args.in[10]; int prev_key = -1;
            for (int round = 0; ; ++round) {
                const int rank = round * NC3 + ((round & 1) ? (((NC3 & 7) == 0) ? ((NC3 - 1 - cidx) ^ 7) : NC3 - 1 - cidx) : cidx); if (rank >= 1024) break;
                att::UnitDesc u;
                if (rank < 512) { const int bh = rank & 63, h = bh & 7; u.b = bh >> 3; u.qb = 7 - (rank >> 6); u.q0 = u.qb * 256; u.gqa = 0; u.moba = 1;
                    u.qcol = h * 64; u.kcol = 512 + h * 64; u.vcol = 1024 + h * 64; u.ocol = h * 64; u.head = h; u.sink2 = 0.f; u.fill = (h != prev_key); prev_key = h; u.fillk = 1; }
                else { const int idx = rank - 512, bk = idx & 15, kvh = bk & 1; u.b = bk >> 1; u.q0 = (31 - (idx >> 4)) * 64; u.qb = u.q0 >> 8; u.gqa = 1; u.moba = 0;
                    u.qcol = 1536 + kvh * 256; u.kcol = 2048 + kvh * 64; u.vcol = 2176 + kvh * 64; u.ocol = 512 + kvh * 256; u.head = 8 + kvh * 4; u.sink2 = 0.f; u.fill = (64 + kvh != prev_key); prev_key = 64 + kvh; u.fillk = 0; }
                att::attn_unit(u, (const bf16*)(ws + WS_PROJ), ws + WS_O, (const float*)(ws + WS_BIAS), (const float*)(F.ctl + CW_KSUM), sinks, (char*)lds + RING_OFF);
            }
        }
        if (BOTH(3)) GRID_BAR();
    }
    if (IN(4)) {
        pg8::Gemm g{(const bf16*)(ws + WS_O), (const bf16*)(ws + WS_WOUT), NTOK, D, D / 2}; pg8::StaticOrder S; S.init(NTOK, D, F.G, (int)blockIdx.x);
        pg8::EpiX1 E{args.in[0], (pg8::bf16_t*)(ws + WS_X1), args.in[8], (const float*)(ws + WS_MODF)};
        pg8::gemm_phase<pg8::EpiX1, pg8::StaticOrder, false, true, true>(F.lds + RING_OFF, g, S, E);
        if (BOTH(4)) GRID_BAR();
    }
    if (IN(5)) { REFRESH(); p5_router(F, args); if (BOTH(5)) GRID_BAR(); }
    if (IN(6)) {
        REFRESH(); build_tiles(F, args); build_ridx(F, args, 2 * DFF / 256);
        pg8::Gemm g{(const bf16*)(ws + WS_H2), (const bf16*)(ws + WS_WGU), MAXSLOTS, 2 * DFF, D / 2};
        pg8::GroupedOrder S{2 * DFF / 256, F.G, (int)blockIdx.x, *(const LAS int*)(F.lds + LDS_NT), (const LAS int*)(F.lds + LDS_TILE_E), (const LAS int*)(F.lds + LDS_RIDX), (size_t)2 * DFF * D, (const LAS int*)(F.lds + LDS_CNTE), (const LAS int*)(F.lds + LDS_TBASE)};
        pg8::EpiSwiglu8 E{ws + WS_ACT, args.in[15]};
        pg8::gemm_phase<pg8::EpiSwiglu8, pg8::GroupedOrder, false, true, true>(F.lds + RING_OFF, g, S, E);
        if (BOTH(6)) GRID_BAR();
    }
    if (IN(7)) {
        REFRESH(); if (!IN(6)) build_tiles(F, args);
        pg8::Gemm g{(const bf16*)(ws + WS_ACT), (const bf16*)(ws + WS_WD), MAXSLOTS, D, DFF / 2};
        pg8::GroupedOrder S{D / 256, F.G, (int)blockIdx.x, *(const LAS int*)(F.lds + LDS_NT), (const LAS int*)(F.lds + LDS_TILE_E), (const LAS int*)nullptr, (size_t)D * DFF, (const LAS int*)(F.lds + LDS_CNTE), (const LAS int*)(F.lds + LDS_TBASE)};
        pg8::EpiDown8 E{ws + WS_Y, args.in[17]};
        pg8::gemm_phase<pg8::EpiDown8, pg8::GroupedOrder, false, true, true>(F.lds + RING_OFF, g, S, E);
        if (BOTH(7)) GRID_BAR();
    }
    if (IN(8)) { REFRESH(); p8_final(F, args); }
#undef IN
#undef BOTH
}

#ifndef MK_PER_PHASE
#define MK_PER_PHASE 0
#endif
extern "C" void kernel_launch(void* const* d_in, const int* in_sizes, int n_in, void* d_out, int out_size, void* d_ws, size_t ws_size, hipStream_t stream) {
    static int grid = 0;
    if (grid == 0) {
        if (n_in != 19 || ws_size < WS_END) { fprintf(stderr, "kernel_launch: unexpected n_in %d / ws %zu\n", n_in, ws_size); grid = -1; return; }
        int dev = 0, cus = 0, per_cu = 0;
        if (hipGetDevice(&dev) != hipSuccess || hipDeviceGetAttribute(&cus, hipDeviceAttributeMultiprocessorCount, dev) != hipSuccess) { grid = -1; return; }
        if (hipFuncSetAttribute((const void*)mega_fwd, hipFuncAttributeMaxDynamicSharedMemorySize, LDS_BYTES) != hipSuccess) { fprintf(stderr, "kernel_launch: hipFuncSetAttribute failed\n"); grid = -1; return; }
        if (hipOccupancyMaxActiveBlocksPerMultiprocessor(&per_cu, (const void*)mega_fwd, NWAVES * 64, LDS_BYTES) != hipSuccess || per_cu < 1) fprintf(stderr, "kernel_launch: occupancy query reports %d\n", per_cu);
        (void)hipGetLastError();
        grid = cus;
    }
    if (grid < 0) return;
    unsigned char* ws = (unsigned char*)d_ws;
    (void)hipMemsetAsync(ws + WS_CTL, 0, CTL_ZERO_BYTES, stream);
    Args a{};
    for (int i = 0; i < 19; ++i) a.in[i] = (const float*)d_in[i];
    a.out = (float*)d_out; a.ws = ws;
#if MK_PER_PHASE
    for (int ph = 0; ph < 9; ++ph) { a.ph_lo = ph; a.ph_hi = ph + 1; hipLaunchKernelGGL(mega_fwd, dim3(grid), dim3(NWAVES * 64), LDS_BYTES, stream, a); }
#else
    a.ph_lo = 0; a.ph_hi = 9; hipLaunchKernelGGL(mega_fwd, dim3(grid), dim3(NWAVES * 64), LDS_BYTES, stream, a);
#endif
}
```
